# Optimizing an MI355X kernel written in HIP

```python
import jax, jax.numpy as jnp
from jax import lax
import numpy as np

D_MODEL = 2048
BATCH = 8
SEQ = 2048
DEPTH = 2

CHUNK = 64
N_PREV_CHUNKS = 8
BAND = (N_PREV_CHUNKS + 1) * CHUNK

D_ATT = D_MODEL // 2
N_HEADS_A = 16
HEAD_DIM_A = D_ATT // N_HEADS_A
MAX_REL = 256
N_REL = CHUNK + MAX_REL

D_CONV = D_MODEL // 2
CONV_WIDTH = 3

D_SGU = D_MODEL // 2
SGU_CHUNK = 128
N_GROUPS_C = 8
GROUP_CH = D_SGU // N_GROUPS_C

N_BRANCH = 3
EPS = 1e-6
NEG_INF = -1e30

SPLIT_SIZES = (D_ATT, D_ATT, D_ATT, D_ATT,
               D_CONV, D_CONV, D_CONV, D_CONV,
               D_SGU, D_SGU, D_SGU,
               N_BRANCH * D_MODEL)
IN_COLS = sum(SPLIT_SIZES)

kernel_name = "hybrid_chunk_attn_conv_gmlp_sandwich"


def _rms_norm(x, g):
    xf = x.astype(jnp.float32)
    r = lax.rsqrt(jnp.mean(xf * xf, axis=-1, keepdims=True) + EPS)
    return (xf * r * g.astype(jnp.float32)).astype(x.dtype)


def _layer_norm(x, g, b):
    xf = x.astype(jnp.float32)
    mu = jnp.mean(xf, axis=-1, keepdims=True)
    var = jnp.mean(jnp.square(xf - mu), axis=-1, keepdims=True)
    y = (xf - mu) * lax.rsqrt(var + EPS) * g.astype(jnp.float32) + b.astype(jnp.float32)
    return y.astype(x.dtype)


def _band_bias(rel_bias):
    q_idx = jnp.arange(CHUNK)[:, None]
    k_idx = jnp.arange(BAND)[None, :]
    dist = q_idx + N_PREV_CHUNKS * CHUNK - k_idx
    idx = jnp.clip(dist, -(CHUNK - 1), MAX_REL) + (CHUNK - 1)
    return rel_bias[:, idx].astype(jnp.float32)


def _chunk_band_attention(q, k, v, rel_bias):
    b, s, h, dh = q.shape
    n_chunks = s // CHUNK
    pad = N_PREV_CHUNKS * CHUNK
    kp = jnp.pad(k, ((0, 0), (pad, 0), (0, 0), (0, 0)))
    vp = jnp.pad(v, ((0, 0), (pad, 0), (0, 0), (0, 0)))
    qc = q.reshape(b, n_chunks, CHUNK, h, dh).transpose(1, 0, 2, 3, 4)
    bias = _band_bias(rel_bias)
    scale = HEAD_DIM_A ** -0.5
    k_off = jnp.arange(BAND)

    def one_chunk(args):
        c, qb = args
        start = c * CHUNK
        kb = lax.dynamic_slice_in_dim(kp, start, BAND, axis=1)
        vb = lax.dynamic_slice_in_dim(vp, start, BAND, axis=1)
        sc = jnp.einsum('bqhd,bkhd->bhqk', qb, kb).astype(jnp.float32) * scale + bias
        valid = (start - pad + k_off) >= 0
        sc = jnp.where(valid[None, None, None, :], sc, NEG_INF)
        p = jax.nn.softmax(sc, axis=-1).astype(vb.dtype)
        return jnp.einsum('bhqk,bkhd->bqhd', p, vb)

    out = lax.map(one_chunk, (jnp.arange(n_chunks), qc))
    return out.transpose(1, 0, 2, 3, 4).reshape(b, s, h * dh)


def _causal_dwconv(x, w):
    return lax.conv_general_dilated(
        x, w[:, None, :].astype(x.dtype), window_strides=(1,),
        padding=[(CONV_WIDTH - 1, 0)], dimension_numbers=('NWC', 'WIO', 'NWC'),
        feature_group_count=x.shape[-1])


def _spatial_gating(u, v, ln_g, ln_b, sp_w, sp_b):
    b, s, _ = v.shape
    vn = _layer_norm(v, ln_g, ln_b)
    vg = vn.reshape(b, s // SGU_CHUNK, SGU_CHUNK, N_GROUPS_C, GROUP_CH)
    mask = jnp.tril(jnp.ones((SGU_CHUNK, SGU_CHUNK), dtype=sp_w.dtype))
    mixed = jnp.einsum('gts,bnsgc->bntgc', sp_w * mask, vg)
    mixed = mixed + sp_b.T[None, None, :, :, None]
    return u * mixed.reshape(b, s, D_SGU)


def _layer(x, pre_g, w_in, rel_bias, conv_w, ln_g, ln_b, sp_w, sp_b,
           w_a, w_b, w_c, w_out, post_g):
    b, s, _ = x.shape
    h = _rms_norm(x, pre_g)
    z = h @ w_in
    points = [int(p) for p in np.cumsum(SPLIT_SIZES)[:-1]]
    (q, k, v, g_a, gate_bb, gate_cc, h_b, g_b,
     u, v_c, g_c, m) = jnp.split(z, points, axis=-1)

    heads = lambda t: t.reshape(b, s, N_HEADS_A, HEAD_DIM_A)
    o_a = _chunk_band_attention(heads(q), heads(k), heads(v), rel_bias)
    y_a = (o_a * jax.nn.silu(g_a)) @ w_a

    o_b = gate_bb * _causal_dwconv(gate_cc * h_b, conv_w)
    y_b = (o_b * jax.nn.silu(g_b)) @ w_b

    o_c = _spatial_gating(jax.nn.gelu(u), jax.nn.gelu(v_c), ln_g, ln_b, sp_w, sp_b)
    y_c = (o_c * jax.nn.silu(g_c)) @ w_c

    gts = jax.nn.sigmoid(m.astype(jnp.float32)).astype(x.dtype)
    gt_a, gt_b, gt_c = jnp.split(gts, N_BRANCH, axis=-1)
    merged = gt_a * y_a + gt_b * y_b + gt_c * y_c
    y = merged @ w_out
    return x + _rms_norm(y, post_g)


def setup_inputs(seed: int = 0) -> dict:
    key = jax.random.key(seed)
    ks = jax.random.split(key, 16)
    L = DEPTH
    nrm = lambda k, shape, sc: jax.random.normal(k, shape, jnp.float32) * sc
    return {
        "x": nrm(ks[0], (BATCH, SEQ, D_MODEL), 1.0),
        "pre_norm": 1.0 + nrm(ks[1], (L, D_MODEL), 0.02),
        "w_in": nrm(ks[2], (L, D_MODEL, IN_COLS), D_MODEL ** -0.5),
        "rel_bias": nrm(ks[3], (L, N_HEADS_A, N_REL), 0.2),
        "conv_w": nrm(ks[4], (L, CONV_WIDTH, D_CONV), 0.5),
        "sgu_ln_g": 1.0 + nrm(ks[5], (L, D_SGU), 0.02),
        "sgu_ln_b": nrm(ks[6], (L, D_SGU), 0.02),
        "spatial_w": nrm(ks[7], (L, N_GROUPS_C, SGU_CHUNK, SGU_CHUNK), SGU_CHUNK ** -0.5),
        "spatial_b": 1.0 + nrm(ks[8], (L, N_GROUPS_C, SGU_CHUNK), 0.1),
        "w_branch_a": nrm(ks[9], (L, D_ATT, D_MODEL), D_ATT ** -0.5),
        "w_branch_b": nrm(ks[10], (L, D_CONV, D_MODEL), D_CONV ** -0.5),
        "w_branch_c": nrm(ks[11], (L, D_SGU, D_MODEL), D_SGU ** -0.5),
        "w_out": nrm(ks[12], (L, D_MODEL, D_MODEL), D_MODEL ** -0.5),
        "post_norm": 1.0 + nrm(ks[13], (L, D_MODEL), 0.02),
    }


def reference(x, pre_norm, w_in, rel_bias, conv_w, sgu_ln_g, sgu_ln_b,
              spatial_w, spatial_b, w_branch_a, w_branch_b, w_branch_c,
              w_out, post_norm):
    for i in range(DEPTH):
        x = _layer(x, pre_norm[i], w_in[i], rel_bias[i], conv_w[i],
                   sgu_ln_g[i], sgu_ln_b[i], spatial_w[i], spatial_b[i],
                   w_branch_a[i], w_branch_b[i], w_branch_c[i],
                   w_out[i], post_norm[i])
    return x
```

```cpp
#include <hip/hip_runtime.h>
#include <hip/hip_cooperative_groups.h>
#include <cstdio>
#include <cstdint>
namespace cg = cooperative_groups;

#define LAS __attribute__((address_space(3)))
typedef unsigned short bf16_t;
typedef short bf16x8 __attribute__((ext_vector_type(8)));
typedef float f32x4 __attribute__((ext_vector_type(4)));
typedef float f32x2 __attribute__((ext_vector_type(2)));
typedef float f32x16 __attribute__((ext_vector_type(16)));
typedef unsigned u32x4 __attribute__((ext_vector_type(4)));
typedef unsigned u32x2 __attribute__((ext_vector_type(2)));
typedef __bf16 bf16x2_t __attribute__((ext_vector_type(2)));

#ifndef MK_N_LAUNCHES
#define MK_N_LAUNCHES 1
#endif

constexpr int MT = 16384;
constexpr int SEQ = 2048;
constexpr int DM = 2048;
constexpr int NIN = 17408;
constexpr int DH = 1024;
constexpr int NREL = 320;
constexpr float LOG2E = 1.4426950408889634f;
constexpr float QSCALE = 0.125f * LOG2E;
constexpr float EPSN = 1e-6f;

constexpr size_t MiB = 1u << 20;
constexpr size_t WS_WIN = 2 * MiB;
constexpr size_t WS_WBR = 138 * MiB;
constexpr size_t WS_WOUT = 162 * MiB;
constexpr size_t WS_H = 178 * MiB;
constexpr size_t WS_SEG = 242 * MiB;
constexpr size_t WS_GATES = 594 * MiB;
constexpr size_t WS_O = 786 * MiB;
constexpr size_t WS_SGUW = 882 * MiB;
constexpr size_t WS_END = 884 * MiB;
constexpr size_t SEGB = 32 * MiB;
constexpr size_t WS_MERGED32 = WS_SEG;
constexpr size_t WS_MERGED16 = WS_SEG + 4 * SEGB;
constexpr size_t WS_Y = WS_SEG + 6 * SEGB;

constexpr int LDS_BYTES = 147456;

__device__ __forceinline__ unsigned pk2(float lo, float hi) { f32x2 v = {lo, hi}; bf16x2_t b = __builtin_convertvector(v, bf16x2_t); return __builtin_bit_cast(unsigned, b); }
__device__ __forceinline__ float bflo(unsigned u) { return __uint_as_float(u << 16); }
__device__ __forceinline__ float bfhi(unsigned u) { return __uint_as_float(u & 0xffff0000u); }
__device__ __forceinline__ float fast_sigmoid(float w) { return __builtin_amdgcn_rcpf(1.0f + __builtin_amdgcn_exp2f(-w * LOG2E)); }
__device__ __forceinline__ float wave_sum(float v) {
#pragma unroll
    for (int o = 1; o < 64; o <<= 1) v += __shfl_xor(v, o);
    return v;
}
#define MFMA32(a, b, c) __builtin_amdgcn_mfma_f32_32x32x16_bf16((a), (b), (c), 0, 0, 0)

namespace pg8 {
constexpr int BM = 256, BK = 64, HALF = 128, HTB = HALF * BK * 2, STAGE_BYTES = 8 * HTB, NXCD = 8, WGM = 8;
__device__ __forceinline__ int lds_byte(int r, int c) { const int st = (r >> 4) * 2 + (c >> 5), rr = r & 15, cc = c & 31, ob = rr * 64 + cc * 2; return st * 1024 + (ob ^ (((ob >> 9) & 1) << 5)); }
__device__ __forceinline__ void stage_rc(int b, int& R, int& C) { const int st = b / 1024, sb = b % 1024, swz = sb ^ (((sb >> 9) & 1) << 5); R = (st >> 1) * 16 + swz / 64; C = (st & 1) * 32 + (swz % 64) / 2; }
__device__ __forceinline__ int perm32(int rho) { const int n = rho >> 4, i = rho & 15; return 8 * (i >> 2) + 4 * n + (i & 3); }

struct Unit { int pm, pn, z; };
struct Gemm { const bf16_t* A; const bf16_t* Bt; int M, N, K; size_t zA, zB; };

template <int NZ> struct TileOrder {
    int nM, nN, nwg, G, c;
    __device__ void init(int M, int N, int G_, int c_) { nM = M / BM; nN = N / BM; nwg = nM * nN; G = G_; c = c_; }
    __device__ bool next(int i, Unit& u) const {
        const int ti = i / NZ; u.z = i - ti * NZ;
        const long L = (long)ti * G + c; if (L >= nwg) return false;
        int wgid = (int)L; { const int q = nwg / NXCD, r = nwg % NXCD, xcd = wgid % NXCD, off = wgid / NXCD; wgid = (xcd < r ? xcd * (q + 1) : r * (q + 1) + (xcd - r) * q) + off; }
        const int nig = WGM * nN, gid = wgid / nig, fm = gid * WGM, gsz = (nM - fm) < WGM ? (nM - fm) : WGM;
        u.pm = fm + ((wgid % nig) % gsz); u.pn = (wgid % nig) / gsz; return true;
    }
};


struct EpiIn {
    static constexpr bool PERM = true;
    unsigned char* seg;
    bf16_t* gates;
    __device__ __forceinline__ void operator()(const f32x4 (&acc)[2][2][4][2], const Unit& u, int wr, int wc, int fr, int fq) const {
        const int colt = u.pn * BM;
        const int row0 = u.pm * BM + wr * 64 + fr;
        int mode;
        bool transposed = false; float sc = 1.f; bf16_t* base; int ldc; int c0;
        if (colt < 11 * DH) {
            const int s = colt >> 10; c0 = colt & 1023; base = (bf16_t*)(seg + (size_t)s * SEGB); ldc = DH;
            mode = (s == 3 || s == 7 || s == 10) ? 1 : ((s == 8 || s == 9) ? 2 : 0);
            transposed = (s == 2 || s == 9);
            if (s == 0) sc = QSCALE;
        } else { c0 = colt - 11 * DH; base = gates; ldc = 3 * DM; mode = 3; }
        const int col0 = c0 + wc * 32 + 8 * fq;
#pragma unroll
        for (int ai = 0; ai < 2; ++ai)
#pragma unroll
            for (int m = 0; m < 4; ++m) {
                const int row = row0 + ai * HALF + m * 16;
#pragma unroll
                for (int bj = 0; bj < 2; ++bj) {
                    float v[8];
#pragma unroll
                    for (int e = 0; e < 4; ++e) { v[e] = acc[ai][bj][m][0][e]; v[4 + e] = acc[ai][bj][m][1][e]; }
                    if (mode == 0) {
#pragma unroll
                        for (int e = 0; e < 8; ++e) v[e] *= sc;
                    } else {
#pragma unroll
                        for (int e = 0; e < 8; ++e) {
                            const float x = v[e];
                            const float w = (mode == 2) ? 1.5957691216057308f * (x + 0.044715f * x * x * x) : x;
                            const float sg = fast_sigmoid(w);
                            v[e] = (mode == 3) ? sg : x * sg;
                        }
                    }
                    if (!transposed) {
                        u32x4 w; w.x = pk2(v[0], v[1]); w.y = pk2(v[2], v[3]); w.z = pk2(v[4], v[5]); w.w = pk2(v[6], v[7]);
                        *(u32x4*)(base + (size_t)row * ldc + col0 + bj * HALF) = w;
                    } else {
#pragma unroll
                        for (int e = 0; e < 8; e += 2) {
                            const unsigned w = pk2(v[e], v[e + 1]);
                            base[(size_t)(col0 + bj * HALF + e) * MT + row] = (bf16_t)(w & 0xffffu);
                            base[(size_t)(col0 + bj * HALF + e + 1) * MT + row] = (bf16_t)(w >> 16);
                        }
                    }
                }
            }
    }
};

struct EpiPlain {
    static constexpr bool PERM = true;
    bf16_t* O; int ldc;
    __device__ __forceinline__ void operator()(const f32x4 (&acc)[2][2][4][2], const Unit& u, int wr, int wc, int fr, int fq) const {
        const int row0 = u.pm * BM + wr * 64 + fr, col0 = u.pn * BM + wc * 32 + 8 * fq;
#pragma unroll
        for (int ai = 0; ai < 2; ++ai)
#pragma unroll
            for (int m = 0; m < 4; ++m) { bf16_t* rowp = O + (size_t)(row0 + ai * HALF + m * 16) * ldc + col0;
#pragma unroll
                for (int bj = 0; bj < 2; ++bj) { const f32x4 v0 = acc[ai][bj][m][0], v1 = acc[ai][bj][m][1];
                    u32x4 w; w.x = pk2(v0[0], v0[1]); w.y = pk2(v0[2], v0[3]); w.z = pk2(v1[0], v1[1]); w.w = pk2(v1[2], v1[3]);
                    *(u32x4*)(rowp + bj * HALF) = w; } }
    }
};

struct EpiMerge {
    static constexpr bool PERM = true;
    const bf16_t* gates; float* part; bf16_t* out;
    __device__ __forceinline__ void operator()(const f32x4 (&acc)[2][2][4][2], const Unit& u, int wr, int wc, int fr, int fq) const {
        const int row0 = u.pm * BM + wr * 64 + fr, col0 = u.pn * BM + wc * 32 + 8 * fq;
        const int z = u.z;
#pragma unroll
        for (int ai = 0; ai < 2; ++ai)
#pragma unroll
            for (int m = 0; m < 4; ++m) {
                const size_t row = (size_t)(row0 + ai * HALF + m * 16);
#pragma unroll
                for (int bj = 0; bj < 2; ++bj) {
                    const int col = col0 + bj * HALF;
                    const u32x4 g = *(const u32x4*)(gates + row * (3 * DM) + z * DM + col);
                    f32x4 v0 = acc[ai][bj][m][0], v1 = acc[ai][bj][m][1];
                    v0[0] *= bflo(g.x); v0[1] *= bfhi(g.x); v0[2] *= bflo(g.y); v0[3] *= bfhi(g.y);
                    v1[0] *= bflo(g.z); v1[1] *= bfhi(g.z); v1[2] *= bflo(g.w); v1[3] *= bfhi(g.w);
                    float* pp = part + row * DM + col;
                    if (z > 0) { const f32x4 p0 = __builtin_nontemporal_load((const f32x4*)pp), p1 = __builtin_nontemporal_load((const f32x4*)(pp + 4)); v0 += p0; v1 += p1; }
                    if (z < 2) { *(f32x4*)pp = v0; *(f32x4*)(pp + 4) = v1; }
                    else { u32x4 w; w.x = pk2(v0[0], v0[1]); w.y = pk2(v0[2], v0[3]); w.z = pk2(v1[0], v1[1]); w.w = pk2(v1[2], v1[3]);
                           *(u32x4*)(out + row * DM + col) = w; }
                }
            }
    }
};

template <class Epi, class Sched, bool ALIGN_EPI>
__device__ __forceinline__ void gemm_phase(LAS unsigned char* lds, const Gemm g, const Sched& S, const Epi& E) {
    const int tid = threadIdx.x, wid = __builtin_amdgcn_readfirstlane(tid >> 6), lane = tid & 63, wr = wid >> 2, wc = wid & 3, fr = lane & 15, fq = lane >> 4;
    const int K = g.K, nt = K / BK;
    unsigned voffA[2], voffB[2];
#pragma unroll
    for (int i = 0; i < 2; ++i) { int R, C; stage_rc(tid * 16 + i * 8192, R, C); const int Rb = Epi::PERM ? ((R & ~31) + perm32(R & 31)) : R;
        voffA[i] = (unsigned)(R * K + C) * 2u; voffB[i] = (unsigned)(Rb * K + C) * 2u; }
    const size_t kstep = (size_t)(BK * 2);
    const size_t hstep = (size_t)HALF * K * 2;
    const size_t tstep = 2 * hstep;
    const unsigned ldsw = (unsigned)wid * 1024u;
    const int aoff = lds_byte(wr * 64 + fr, fq * 8), boff = lds_byte(wc * 32 + fr, fq * 8);
#define PG8_SA(b, h) (((b) * 2 + (h)) * HTB)
#define PG8_SB(b, h) ((4 + (b) * 2 + (h)) * HTB)
#define PG8_STAGE(bufoff, gbase, voff) do { _Pragma("unroll") for (int _i = 0; _i < 2; ++_i) \
        __builtin_amdgcn_global_load_lds((const unsigned*)((const char*)(gbase) + (voff)[_i]), (LAS unsigned*)(lds + (bufoff) + ldsw + _i * 8192), 16, 0, 0); } while (0)
#define PG8_LDA(dst, b, h) do { _Pragma("unroll") for (int m = 0; m < 4; ++m) _Pragma("unroll") for (int k = 0; k < 2; ++k) dst[m][k] = *(const LAS bf16x8*)(lds + PG8_SA(b, h) + aoff + m * 2048 + k * 1024); } while (0)
#define PG8_LDB(dst, b, h) do { _Pragma("unroll") for (int n = 0; n < 2; ++n) _Pragma("unroll") for (int k = 0; k < 2; ++k) dst[n][k] = *(const LAS bf16x8*)(lds + PG8_SB(b, h) + boff + n * 2048 + k * 1024); } while (0)
#define PG8_MMA(ai, bj, At, Bt) do { __builtin_amdgcn_s_setprio(1); _Pragma("unroll") for (int m = 0; m < 4; ++m) _Pragma("unroll") for (int n = 0; n < 2; ++n) _Pragma("unroll") for (int k = 0; k < 2; ++k) \
        acc[ai][bj][m][n] = __builtin_amdgcn_mfma_f32_16x16x32_bf16(Bt[n][k], At[m][k], acc[ai][bj][m][n], 0, 0, 0); __builtin_amdgcn_s_setprio(0); } while (0)
#define PG8_WAIT_V(n) asm volatile("s_waitcnt vmcnt(" #n ")" ::: "memory")
#define PG8_WAIT_L(n) asm volatile("s_waitcnt lgkmcnt(" #n ")" ::: "memory")
#define PG8_BAR __builtin_amdgcn_s_barrier()
#define PG8_SCHED __builtin_amdgcn_sched_barrier(0)
    Unit cur, nxt; int ui = 0;
    if (!S.next(0, cur)) return;
    f32x4 acc[2][2][4][2];
#pragma unroll
    for (int a = 0; a < 2; ++a)
#pragma unroll
        for (int b = 0; b < 2; ++b)
#pragma unroll
            for (int m = 0; m < 4; ++m)
#pragma unroll
                for (int n = 0; n < 2; ++n) acc[a][b][m][n] = (f32x4){0.f, 0.f, 0.f, 0.f};
    bf16x8 At[4][2], B0[2][2], B1[2][2];
    const char* cA = (const char*)g.A + (size_t)cur.z * g.zA + (size_t)cur.pm * tstep; const char* cB = (const char*)g.Bt + (size_t)cur.z * g.zB + (size_t)cur.pn * tstep;
    PG8_STAGE(PG8_SB(0, 0), cB, voffB); PG8_STAGE(PG8_SB(0, 1), cB + hstep, voffB); PG8_STAGE(PG8_SA(0, 0), cA, voffA); PG8_STAGE(PG8_SA(0, 1), cA + hstep, voffA);
    if (wr == 1) PG8_BAR;
    PG8_WAIT_V(2); PG8_BAR;
    PG8_STAGE(PG8_SB(1, 0), cB + kstep, voffB); PG8_STAGE(PG8_SA(1, 0), cA + kstep, voffA); PG8_STAGE(PG8_SB(1, 1), cB + hstep + kstep, voffB);
    PG8_WAIT_V(6); PG8_BAR;
    for (;;) {
        const bool has_next = S.next(ui + 1, nxt);
        const char* nA = has_next ? (const char*)g.A + (size_t)nxt.z * g.zA + (size_t)nxt.pm * tstep : cA;
        const char* nB = has_next ? (const char*)g.Bt + (size_t)nxt.z * g.zB + (size_t)nxt.pn * tstep : cB;
        for (int t = 0; t < nt; t += 2) {
            const bool last = (t == nt - 2);
            const char* a1 = cA + (size_t)(t + 1) * kstep;
            const char* a2 = last ? nA : cA + (size_t)(t + 2) * kstep; const char* b2 = last ? nB : cB + (size_t)(t + 2) * kstep;
            const char* a3 = a2 + kstep; const char* b3 = b2 + kstep;
            PG8_LDB(B0, 0, 0); PG8_LDB(B1, 0, 1); PG8_SCHED; PG8_LDA(At, 0, 0); PG8_STAGE(PG8_SA(1, 1), a1 + hstep, voffA);
            PG8_WAIT_V(8); PG8_WAIT_L(0); PG8_BAR; PG8_MMA(0, 0, At, B0); PG8_MMA(0, 1, At, B1); PG8_BAR; PG8_SCHED;
            PG8_LDA(At, 0, 1); PG8_STAGE(PG8_SB(0, 0), b2, voffB); PG8_STAGE(PG8_SB(0, 1), b2 + hstep, voffB); PG8_STAGE(PG8_SA(0, 0), a2, voffA);
            PG8_WAIT_V(8); PG8_WAIT_L(0); PG8_BAR; PG8_MMA(1, 0, At, B0); PG8_MMA(1, 1, At, B1); PG8_BAR; PG8_SCHED;
            PG8_LDB(B0, 1, 0); PG8_LDB(B1, 1, 1); PG8_SCHED; PG8_LDA(At, 1, 0); PG8_STAGE(PG8_SA(0, 1), a2 + hstep, voffA);
            PG8_WAIT_V(8); PG8_WAIT_L(0); PG8_BAR; PG8_MMA(0, 0, At, B0); PG8_MMA(0, 1, At, B1); PG8_BAR; PG8_SCHED;
            PG8_LDA(At, 1, 1); PG8_STAGE(PG8_SB(1, 0), b3, voffB); PG8_STAGE(PG8_SB(1, 1), b3 + hstep, voffB); PG8_STAGE(PG8_SA(1, 0), a3, voffA);
            PG8_WAIT_V(8); PG8_WAIT_L(0); PG8_BAR; PG8_MMA(1, 0, At, B0); PG8_MMA(1, 1, At, B1); PG8_BAR; PG8_SCHED;
        }
        if constexpr (ALIGN_EPI) { if (wr == 0) PG8_BAR; }
        E(acc, cur, wr, wc, fr, fq);
        if (!has_next) break;
#pragma unroll
        for (int a = 0; a < 2; ++a)
#pragma unroll
            for (int b = 0; b < 2; ++b)
#pragma unroll
                for (int m = 0; m < 4; ++m)
#pragma unroll
                    for (int n = 0; n < 2; ++n) acc[a][b][m][n] = (f32x4){0.f, 0.f, 0.f, 0.f};
        cur = nxt; cA = nA; cB = nB; ++ui;
        if constexpr (ALIGN_EPI) { if (wr == 1) PG8_BAR; }
    }
    PG8_WAIT_V(0);
    if constexpr (!ALIGN_EPI) { if (wr == 0) PG8_BAR; }
    PG8_BAR;
#undef PG8_SA
#undef PG8_SB
#undef PG8_STAGE
#undef PG8_LDA
#undef PG8_LDB
#undef PG8_MMA
#undef PG8_WAIT_V
#undef PG8_WAIT_L
#undef PG8_BAR
#undef PG8_SCHED
}
}

__device__ __forceinline__ void transpose_item(const float* __restrict__ W, int K, int N, bf16_t* __restrict__ WT, LAS float* scr, int item, int lane) {
    const int nblk = N / 32, kb = item / nblk, nb = item - kb * nblk, k0 = 64 * kb, n0 = 32 * nb;
#pragma unroll 8
    for (int i = 0; i < 32; ++i) { const int kk = 2 * i + (lane >> 5); scr[kk * 33 + (lane & 31)] = W[(size_t)(k0 + kk) * N + n0 + (lane & 31)]; }
    asm volatile("s_waitcnt lgkmcnt(0)" ::: "memory");
    const int c = lane & 7;
#pragma unroll
    for (int j = 0; j < 4; ++j) { const int n = (lane >> 3) + 8 * j; const LAS float* s = scr + (8 * c) * 33 + n;
        u32x4 o; o.x = pk2(s[0 * 33], s[1 * 33]); o.y = pk2(s[2 * 33], s[3 * 33]); o.z = pk2(s[4 * 33], s[5 * 33]); o.w = pk2(s[6 * 33], s[7 * 33]);
        *(u32x4*)(WT + (size_t)(n0 + n) * K + k0 + 8 * c) = o; }
    asm volatile("s_waitcnt lgkmcnt(0)" ::: "memory");
}

template <bool HAS_Y, bool WRITE_H>
__device__ __forceinline__ void row_pass(const float* __restrict__ xin, const bf16_t* __restrict__ Y, const float* __restrict__ post_g, float* xout,
                                         const float* __restrict__ pre_g, bf16_t* __restrict__ H, int gw, int NGW, int lane) {
    for (int row = gw; row < MT; row += NGW) {
        float xv[4][8];
#pragma unroll
        for (int j = 0; j < 4; ++j) { const int col = (j * 64 + lane) * 8; const f32x4 a = *(const f32x4*)(xin + (size_t)row * DM + col), b = *(const f32x4*)(xin + (size_t)row * DM + col + 4);
#pragma unroll
            for (int e = 0; e < 4; ++e) { xv[j][e] = a[e]; xv[j][4 + e] = b[e]; } }
        if constexpr (HAS_Y) {
            float yv[4][8]; float ss = 0.f;
#pragma unroll
            for (int j = 0; j < 4; ++j) { const int col = (j * 64 + lane) * 8; const u32x4 w = *(const u32x4*)(Y + (size_t)row * DM + col);
                yv[j][0] = bflo(w.x); yv[j][1] = bfhi(w.x); yv[j][2] = bflo(w.y); yv[j][3] = bfhi(w.y); yv[j][4] = bflo(w.z); yv[j][5] = bfhi(w.z); yv[j][6] = bflo(w.w); yv[j][7] = bfhi(w.w);
#pragma unroll
                for (int e = 0; e < 8; ++e) ss += yv[j][e] * yv[j][e]; }
            const float r = 1.0f / sqrtf(wave_sum(ss) * (1.0f / DM) + EPSN);
#pragma unroll
            for (int j = 0; j < 4; ++j) { const int col = (j * 64 + lane) * 8; const f32x4 ga = *(const f32x4*)(post_g + col), gb = *(const f32x4*)(post_g + col + 4);
#pragma unroll
                for (int e = 0; e < 4; ++e) { xv[j][e] += yv[j][e] * r * ga[e]; xv[j][4 + e] += yv[j][4 + e] * r * gb[e]; }
                *(f32x4*)(xout + (size_t)row * DM + col) = (f32x4){xv[j][0], xv[j][1], xv[j][2], xv[j][3]};
                *(f32x4*)(xout + (size_t)row * DM + col + 4) = (f32x4){xv[j][4], xv[j][5], xv[j][6], xv[j][7]}; }
        }
        if constexpr (WRITE_H) {
            float ss = 0.f;
#pragma unroll
            for (int j = 0; j < 4; ++j)
#pragma unroll
                for (int e = 0; e < 8; ++e) ss += xv[j][e] * xv[j][e];
            const float r = 1.0f / sqrtf(wave_sum(ss) * (1.0f / DM) + EPSN);
#pragma unroll
            for (int j = 0; j < 4; ++j) { const int col = (j * 64 + lane) * 8; const f32x4 ga = *(const f32x4*)(pre_g + col), gb = *(const f32x4*)(pre_g + col + 4);
                u32x4 w; w.x = pk2(xv[j][0] * r * ga[0], xv[j][1] * r * ga[1]); w.y = pk2(xv[j][2] * r * ga[2], xv[j][3] * r * ga[3]);
                w.z = pk2(xv[j][4] * r * gb[0], xv[j][5] * r * gb[1]); w.w = pk2(xv[j][6] * r * gb[2], xv[j][7] * r * gb[3]);
                *(u32x4*)(H + (size_t)row * DM + col) = w; }
        }
    }
}

__device__ __forceinline__ void attn_item(const bf16_t* __restrict__ Q, const bf16_t* __restrict__ Kb, const bf16_t* __restrict__ VT, const bf16_t* __restrict__ GA,
                                          bf16_t* __restrict__ OA, const float* __restrict__ rb, int b, int c, int h, int half, int lane) {
    const int r = lane & 31, hh = lane >> 5;
    const int tokq = b * SEQ + c * 64 + half * 32;
    const int qloc = half * 32 + r;
    bf16x8 qf[4];
    { const bf16_t* qp = Q + (size_t)(tokq + r) * DH + h * 64 + 8 * hh;
#pragma unroll
      for (int d0 = 0; d0 < 4; ++d0) qf[d0] = *(const bf16x8*)(qp + d0 * 16); }
    f32x16 o0, o1;
#pragma unroll
    for (int i = 0; i < 16; ++i) { o0[i] = 0.f; o1[i] = 0.f; }
    float mrun = -1e30f, lrun = 0.f;
    const int pr = (r & ~12) | ((r & 4) << 1) | ((r & 8) >> 1);
    const float cfar = rb[NREL - 1] * LOG2E;
    const int jmin = c >= 8 ? 0 : 8 - c;
    for (int j = jmin; j <= 8; ++j) {
        const int ktok = b * SEQ + (c - 8 + j) * 64;
        const bf16_t* kp = Kb + (size_t)(ktok + pr) * DH + h * 64 + 8 * hh;
        f32x16 s0, s1;
#pragma unroll
        for (int i = 0; i < 16; ++i) { s0[i] = 0.f; s1[i] = 0.f; }
#pragma unroll
        for (int d0 = 0; d0 < 4; ++d0) {
            const bf16x8 k0 = *(const bf16x8*)(kp + d0 * 16), k1 = *(const bf16x8*)(kp + (size_t)32 * DH + d0 * 16);
            s0 = MFMA32(k0, qf[d0], s0); s1 = MFMA32(k1, qf[d0], s1);
        }
        if (j <= 3) {
#pragma unroll
            for (int i = 0; i < 16; ++i) { s0[i] += cfar; s1[i] += cfar; }
        } else {
            const int base = qloc + 64 * (8 - j) + 63;
#pragma unroll
            for (int i = 0; i < 16; ++i) {
                const int key = (i & 3) + 4 * ((i >> 2) & 1) + 8 * hh + 16 * (i >> 3);
                int i0 = base - key, i1 = base - key - 32;
                i0 = i0 > NREL - 1 ? NREL - 1 : i0; i1 = i1 > NREL - 1 ? NREL - 1 : i1;
                s0[i] += rb[i0] * LOG2E; s1[i] += rb[i1] * LOG2E;
            }
        }
        float tmax = fmaxf(s0[0], s1[0]);
#pragma unroll
        for (int i = 1; i < 16; ++i) tmax = fmaxf(tmax, fmaxf(s0[i], s1[i]));
        tmax = fmaxf(tmax, __shfl_xor(tmax, 32));
        const float mnew = fmaxf(mrun, tmax);
        const float alpha = __builtin_amdgcn_exp2f(mrun - mnew);
        mrun = mnew;
        float ls = 0.f;
#pragma unroll
        for (int i = 0; i < 16; ++i) { s0[i] = __builtin_amdgcn_exp2f(s0[i] - mnew); s1[i] = __builtin_amdgcn_exp2f(s1[i] - mnew); ls += s0[i] + s1[i]; }
        lrun = lrun * alpha + ls;
#pragma unroll
        for (int i = 0; i < 16; ++i) { o0[i] *= alpha; o1[i] *= alpha; }
        const bf16_t* vp = VT + (size_t)(h * 64 + r) * MT + ktok + 8 * hh;
#pragma unroll
        for (int s = 0; s < 2; ++s) {
            u32x4 pa, pb;
            pa.x = pk2(s0[8 * s + 0], s0[8 * s + 1]); pa.y = pk2(s0[8 * s + 2], s0[8 * s + 3]); pa.z = pk2(s0[8 * s + 4], s0[8 * s + 5]); pa.w = pk2(s0[8 * s + 6], s0[8 * s + 7]);
            pb.x = pk2(s1[8 * s + 0], s1[8 * s + 1]); pb.y = pk2(s1[8 * s + 2], s1[8 * s + 3]); pb.z = pk2(s1[8 * s + 4], s1[8 * s + 5]); pb.w = pk2(s1[8 * s + 6], s1[8 * s + 7]);
            const bf16x8 va0 = *(const bf16x8*)(vp + 16 * s), va1 = *(const bf16x8*)(vp + (size_t)32 * MT + 16 * s);
            const bf16x8 vb0 = *(const bf16x8*)(vp + 32 + 16 * s), vb1 = *(const bf16x8*)(vp + (size_t)32 * MT + 32 + 16 * s);
            o0 = MFMA32(va0, __builtin_bit_cast(bf16x8, pa), o0); o1 = MFMA32(va1, __builtin_bit_cast(bf16x8, pa), o1);
            o0 = MFMA32(vb0, __builtin_bit_cast(bf16x8, pb), o0); o1 = MFMA32(vb1, __builtin_bit_cast(bf16x8, pb), o1);
        }
    }
    const float l = lrun + __shfl_xor(lrun, 32);
    const float inv = 1.0f / l;
    const size_t rowoff = (size_t)(tokq + r) * DH + h * 64 + 4 * hh;
#pragma unroll
    for (int g = 0; g < 4; ++g) {
#pragma unroll
        for (int db = 0; db < 2; ++db) {
            const size_t a = rowoff + db * 32 + 8 * g;
            const u32x2 gg = *(const u32x2*)(GA + a);
            const f32x16& o = db ? o1 : o0;
            u32x2 w; w.x = pk2(o[4 * g + 0] * inv * bflo(gg.x), o[4 * g + 1] * inv * bfhi(gg.x)); w.y = pk2(o[4 * g + 2] * inv * bflo(gg.y), o[4 * g + 3] * inv * bfhi(gg.y));
            *(u32x2*)(OA + a) = w;
        }
    }
}

__device__ __forceinline__ void unpack8(const u32x4 w, float* v) { v[0] = bflo(w.x); v[1] = bfhi(w.x); v[2] = bflo(w.y); v[3] = bfhi(w.y); v[4] = bflo(w.z); v[5] = bfhi(w.z); v[6] = bflo(w.w); v[7] = bfhi(w.w); }
__device__ __forceinline__ void conv_unit(const bf16_t* __restrict__ BB, const bf16_t* __restrict__ CC, const bf16_t* __restrict__ HB, const bf16_t* __restrict__ GB,
                                          bf16_t* __restrict__ OB, const float* __restrict__ cw, int unit, int tid) {
    const int cgp = tid & 127, sub = tid >> 7, ch = cgp * 8;
    const int t0 = unit * 32 + sub * 8;
    float w0[8], w1[8], w2[8];
#pragma unroll
    for (int e = 0; e < 8; ++e) { w0[e] = cw[ch + e]; w1[e] = cw[DH + ch + e]; w2[e] = cw[2 * DH + ch + e]; }
    float p2[8], p1[8];
#pragma unroll
    for (int e = 0; e < 8; ++e) { p2[e] = 0.f; p1[e] = 0.f; }
    const int tpos = t0 & (SEQ - 1);
    if (tpos >= 2) { float a[8], b[8]; unpack8(*(const u32x4*)(CC + (size_t)(t0 - 2) * DH + ch), a); unpack8(*(const u32x4*)(HB + (size_t)(t0 - 2) * DH + ch), b);
#pragma unroll
        for (int e = 0; e < 8; ++e) p2[e] = a[e] * b[e]; }
    if (tpos >= 1) { float a[8], b[8]; unpack8(*(const u32x4*)(CC + (size_t)(t0 - 1) * DH + ch), a); unpack8(*(const u32x4*)(HB + (size_t)(t0 - 1) * DH + ch), b);
#pragma unroll
        for (int e = 0; e < 8; ++e) p1[e] = a[e] * b[e]; }
#pragma unroll
    for (int i = 0; i < 8; ++i) {
        const size_t off = (size_t)(t0 + i) * DH + ch;
        float a[8], b[8], g1[8], g2[8], o[8];
        unpack8(*(const u32x4*)(CC + off), a); unpack8(*(const u32x4*)(HB + off), b); unpack8(*(const u32x4*)(BB + off), g1); unpack8(*(const u32x4*)(GB + off), g2);
#pragma unroll
        for (int e = 0; e < 8; ++e) { const float cur = a[e] * b[e]; o[e] = g1[e] * (w0[e] * p2[e] + w1[e] * p1[e] + w2[e] * cur) * g2[e]; p2[e] = p1[e]; p1[e] = cur; }
        u32x4 w; w.x = pk2(o[0], o[1]); w.y = pk2(o[2], o[3]); w.z = pk2(o[4], o[5]); w.w = pk2(o[6], o[7]);
        *(u32x4*)(OB + off) = w;
    }
}

__device__ __forceinline__ void sgu_unit(const bf16_t* __restrict__ VCT, const bf16_t* __restrict__ U, const bf16_t* __restrict__ GC, bf16_t* __restrict__ OC,
                                         const bf16_t* __restrict__ Wbf, const float* __restrict__ spb, const float* __restrict__ lng, const float* __restrict__ lnb,
                                         int b, int n, int gh, LAS unsigned char* lds, int tid) {
    const int lane = tid & 63, w = __builtin_amdgcn_readfirstlane(tid >> 6), r = lane & 31, hh = lane >> 5;
    const int tok0 = b * SEQ + n * 128;
    LAS float* part = (LAS float*)lds;
    LAS float* stat = part + 8 * 128 * 2;
    {
        const bf16_t* p = VCT + (size_t)(w * 128) * MT + tok0 + 2 * lane;
        float s0 = 0.f, s1 = 0.f, q0 = 0.f, q1 = 0.f;
#pragma unroll 16
        for (int cch = 0; cch < 128; ++cch) { const unsigned v = *(const unsigned*)(p + (size_t)cch * MT); const float a = bflo(v), bq = bfhi(v); s0 += a; q0 += a * a; s1 += bq; q1 += bq * bq; }
        part[(w * 128 + 2 * lane) * 2 + 0] = s0; part[(w * 128 + 2 * lane) * 2 + 1] = q0;
        part[(w * 128 + 2 * lane + 1) * 2 + 0] = s1; part[(w * 128 + 2 * lane + 1) * 2 + 1] = q1;
    }
    __syncthreads();
    if (tid < 128) {
        float S = 0.f, SS = 0.f;
#pragma unroll
        for (int ww = 0; ww < 8; ++ww) { S += part[(ww * 128 + tid) * 2]; SS += part[(ww * 128 + tid) * 2 + 1]; }
        const float mean = S * (1.0f / DH); const float var = fmaxf(SS * (1.0f / DH) - mean * mean, 0.f);
        stat[tid * 2] = mean; stat[tid * 2 + 1] = 1.0f / sqrtf(var + EPSN);
    }
    __syncthreads();
    const int cb = w & 3; const int hi2 = w >> 2;
    const int tbA = hi2 ? 1 : 0, tbB = hi2 ? 2 : 3;
    for (int gi = 0; gi < 4; ++gi) {
        const int g = gh * 4 + gi;
        const int ch = g * 128 + cb * 32 + r;
        const float gg = lng[ch], bb = lnb[ch];
        const bf16_t* ap = VCT + (size_t)ch * MT + tok0 + 8 * hh;
        const bf16_t* wp = Wbf + (size_t)g * 16384 + 8 * hh;
        f32x16 accA, accB;
#pragma unroll
        for (int i = 0; i < 16; ++i) { accA[i] = 0.f; accB[i] = 0.f; }
#pragma unroll
        for (int s0 = 0; s0 < 128; s0 += 16) {
            if (s0 < (tbB + 1) * 32) {
                const u32x4 raw = *(const u32x4*)(ap + s0);
                float v[8]; unpack8(raw, v);
#pragma unroll
                for (int jj = 0; jj < 8; ++jj) { const float mean = stat[(s0 + 8 * hh + jj) * 2], rstd = stat[(s0 + 8 * hh + jj) * 2 + 1]; v[jj] = (v[jj] - mean) * rstd * gg + bb; }
                u32x4 af; af.x = pk2(v[0], v[1]); af.y = pk2(v[2], v[3]); af.z = pk2(v[4], v[5]); af.w = pk2(v[6], v[7]);
                const bf16x8 bB = *(const bf16x8*)(wp + (size_t)(tbB * 32 + r) * 128 + s0);
                accB = MFMA32(__builtin_bit_cast(bf16x8, af), bB, accB);
                if (s0 < (tbA + 1) * 32) {
                    const bf16x8 bA = *(const bf16x8*)(wp + (size_t)(tbA * 32 + r) * 128 + s0);
                    accA = MFMA32(__builtin_bit_cast(bf16x8, af), bA, accA);
                }
            }
        }
#pragma unroll
        for (int which = 0; which < 2; ++which) {
            const int tb = which ? tbB : tbA; const f32x16& acc = which ? accB : accA;
            const int t = tb * 32 + r; const float sb = spb[g * 128 + t];
            const size_t rowoff = (size_t)(tok0 + t) * DH + g * 128 + cb * 32 + 4 * hh;
#pragma unroll
            for (int q = 0; q < 4; ++q) {
                const size_t a = rowoff + 8 * q;
                const u32x2 uu = *(const u32x2*)(U + a), gc = *(const u32x2*)(GC + a);
                u32x2 o; o.x = pk2(bflo(uu.x) * (acc[4 * q + 0] + sb) * bflo(gc.x), bfhi(uu.x) * (acc[4 * q + 1] + sb) * bfhi(gc.x));
                o.y = pk2(bflo(uu.y) * (acc[4 * q + 2] + sb) * bflo(gc.y), bfhi(uu.y) * (acc[4 * q + 3] + sb) * bfhi(gc.y));
                *(u32x2*)(OC + a) = o;
            }
        }
    }
    __syncthreads();
}

struct Args { const float* in[14]; float* out; unsigned char* ws; int ph_lo, ph_hi; };
constexpr int NPH = 11;

__device__ __forceinline__ void phase_prologue(const Args& args, LAS unsigned char* lds) {
    const int tid = threadIdx.x, lane = tid & 63, wave = __builtin_amdgcn_readfirstlane(tid >> 6);
    const int G = gridDim.x, blk = blockIdx.x, gw = blk * 8 + wave, NGW = G * 8;
    unsigned char* ws = args.ws;
    LAS float* scr = (LAS float*)(lds + wave * 16384);
    constexpr int I_IN = (DM / 64) * (NIN / 32), I_BR = (DH / 64) * (DM / 32), I_OUT = (DM / 64) * (DM / 32);
    constexpr int PER_L = I_IN + 3 * I_BR + I_OUT;
    for (int it = gw; it < 2 * PER_L; it += NGW) {
        const int l = it / PER_L; int r = it - l * PER_L;
        if (r < I_IN) { transpose_item(args.in[2] + (size_t)l * DM * NIN, DM, NIN, (bf16_t*)(ws + WS_WIN + (size_t)l * 68 * MiB), scr, r, lane); continue; } r -= I_IN;
        if (r < 3 * I_BR) { const int br = r / I_BR; r -= br * I_BR; const float* src = (br == 0 ? args.in[9] : (br == 1 ? args.in[10] : args.in[11])) + (size_t)l * DH * DM;
            transpose_item(src, DH, DM, (bf16_t*)(ws + WS_WBR + (size_t)(l * 3 + br) * 4 * MiB), scr, r, lane); continue; } r -= 3 * I_BR;
        transpose_item(args.in[12] + (size_t)l * DM * DM, DM, DM, (bf16_t*)(ws + WS_WOUT + (size_t)l * 8 * MiB), scr, r, lane);
    }
    { bf16_t* wb = (bf16_t*)(ws + WS_SGUW); const float* sp_w = args.in[7];
      for (int e = blk * 512 + tid; e < 2 * 8 * 128 * 128; e += G * 512) { const int t = (e >> 7) & 127, s = e & 127; const unsigned p = pk2(sp_w[e], 0.f); wb[e] = (s <= t) ? (bf16_t)(p & 0xffffu) : (bf16_t)0; } }
    row_pass<false, true>(args.in[0], nullptr, nullptr, nullptr, args.in[1], (bf16_t*)(ws + WS_H), gw, NGW, lane);
}

template <int L> __device__ __forceinline__ void phase_in(const Args& args, LAS unsigned char* lds) {
    unsigned char* ws = args.ws;
    pg8::Gemm g{(const bf16_t*)(ws + WS_H), (const bf16_t*)(ws + WS_WIN + (size_t)L * 68 * MiB), MT, NIN, DM, 0, 0};
    pg8::TileOrder<1> S; S.init(MT, NIN, gridDim.x, blockIdx.x);
    pg8::EpiIn E{ws + WS_SEG, (bf16_t*)(ws + WS_GATES)};
    pg8::gemm_phase<pg8::EpiIn, pg8::TileOrder<1>, true>(lds, g, S, E);
}

template <int L> __device__ __forceinline__ void phase_mix(const Args& args, LAS unsigned char* lds) {
    const int tid = threadIdx.x, lane = tid & 63, wave = __builtin_amdgcn_readfirstlane(tid >> 6);
    const int G = gridDim.x, blk = blockIdx.x;
    unsigned char* ws = args.ws;
    const bf16_t* segb = (const bf16_t*)(ws + WS_SEG);
    bf16_t* OA = (bf16_t*)(ws + WS_O);
    constexpr size_t SE = (size_t)MT * DH;
    for (int u = blk; u < 1024 + 512 + 256; u += G) {
        if (u < 1024) {
            const int hg = u & 3, b = (u >> 2) & 7, c = u >> 5;
            const int h = hg * 4 + (wave >> 1), half = wave & 1;
            attn_item(segb, segb + SE, segb + 2 * SE, segb + 3 * SE, OA, args.in[3] + (size_t)(L * 16 + h) * NREL, b, c, h, half, lane);
        } else if (u < 1536) {
            conv_unit(segb + 4 * SE, segb + 5 * SE, segb + 6 * SE, segb + 7 * SE, OA + SE, args.in[4] + (size_t)L * 3 * DH, u - 1024, tid);
        } else {
            const int su = u - 1536; const int gh = su & 1, n = (su >> 1) & 15, b = su >> 5;
            sgu_unit(segb + 9 * SE, segb + 8 * SE, segb + 10 * SE, OA + 2 * SE, (const bf16_t*)(ws + WS_SGUW) + (size_t)L * 8 * 16384, args.in[8] + (size_t)L * 8 * 128,
                     args.in[5] + (size_t)L * DH, args.in[6] + (size_t)L * DH, b, n, gh, lds, tid);
        }
    }
}

template <int L> __device__ __forceinline__ void phase_br(const Args& args, LAS unsigned char* lds) {
    unsigned char* ws = args.ws;
    pg8::Gemm g{(const bf16_t*)(ws + WS_O), (const bf16_t*)(ws + WS_WBR + (size_t)L * 12 * MiB), MT, DM, DH, (size_t)32 * MiB, (size_t)4 * MiB};
    pg8::TileOrder<3> S; S.init(MT, DM, gridDim.x, blockIdx.x);
    pg8::EpiMerge E{(const bf16_t*)(ws + WS_GATES), (float*)(ws + WS_MERGED32), (bf16_t*)(ws + WS_MERGED16)};
    pg8::gemm_phase<pg8::EpiMerge, pg8::TileOrder<3>, true>(lds, g, S, E);
}

template <int L> __device__ __forceinline__ void phase_out(const Args& args, LAS unsigned char* lds) {
    unsigned char* ws = args.ws;
    pg8::Gemm g{(const bf16_t*)(ws + WS_MERGED16), (const bf16_t*)(ws + WS_WOUT + (size_t)L * 8 * MiB), MT, DM, DM, 0, 0};
    pg8::TileOrder<1> S; S.init(MT, DM, gridDim.x, blockIdx.x);
    pg8::EpiPlain E{(bf16_t*)(ws + WS_Y), DM};
    pg8::gemm_phase<pg8::EpiPlain, pg8::TileOrder<1>, true>(lds, g, S, E);
}

template <int L> __device__ __forceinline__ void phase_row(const Args& args) {
    const int tid = threadIdx.x, lane = tid & 63, wave = __builtin_amdgcn_readfirstlane(tid >> 6);
    const int gw = blockIdx.x * 8 + wave, NGW = gridDim.x * 8;
    unsigned char* ws = args.ws;
    if (L == 0) row_pass<true, true>(args.in[0], (const bf16_t*)(ws + WS_Y), args.in[13], args.out, args.in[1] + DM, (bf16_t*)(ws + WS_H), gw, NGW, lane);
    else row_pass<true, false>(args.out, (const bf16_t*)(ws + WS_Y), args.in[13] + DM, args.out, nullptr, nullptr, gw, NGW, lane);
}

__global__ void __launch_bounds__(512, 2) mk_fwd(const Args args) {
    extern __shared__ __attribute__((aligned(16))) unsigned char lds_raw[];
    LAS unsigned char* lds = (LAS unsigned char*)lds_raw;
    const int lo = args.ph_lo, hi = args.ph_hi;
#define IN(k) (lo <= (k) && (k) < hi)
#define SEAM(k) do { if (IN((k) + 1)) cg::this_grid().sync(); } while (0)
    if (IN(0)) { phase_prologue(args, lds); SEAM(0); }
    if (IN(1)) { phase_in<0>(args, lds); SEAM(1); }
    if (IN(2)) { phase_mix<0>(args, lds); SEAM(2); }
    if (IN(3)) { phase_br<0>(args, lds); SEAM(3); }
    if (IN(4)) { phase_out<0>(args, lds); SEAM(4); }
    if (IN(5)) { phase_row<0>(args); SEAM(5); }
    if (IN(6)) { phase_in<1>(args, lds); SEAM(6); }
    if (IN(7)) { phase_mix<1>(args, lds); SEAM(7); }
    if (IN(8)) { phase_br<1>(args, lds); SEAM(8); }
    if (IN(9)) { phase_out<1>(args, lds); SEAM(9); }
    if (IN(10)) { phase_row<1>(args); }
#undef IN
#undef SEAM
}

extern "C" void kernel_launch(void* const* d_in, const int* in_sizes, int n_in, void* d_out, int out_size, void* d_ws, size_t ws_size, hipStream_t stream) {
    static int grid = 0;
    if (grid == 0) {
        if (n_in != 14 || out_size != MT * DM || ws_size < WS_END) { fprintf(stderr, "kernel_launch: unexpected shapes (n_in %d out %d ws %zu)\n", n_in, out_size, ws_size); grid = -1; return; }
        int dev = 0, cus = 0, per_cu = 0;
        hipGetDevice(&dev);
        hipDeviceGetAttribute(&cus, hipDeviceAttributeMultiprocessorCount, dev);
        if (hipFuncSetAttribute((const void*)mk_fwd, hipFuncAttributeMaxDynamicSharedMemorySize, LDS_BYTES) != hipSuccess) { fprintf(stderr, "kernel_launch: hipFuncSetAttribute failed\n"); grid = -1; return; }
        if (hipOccupancyMaxActiveBlocksPerMultiprocessor(&per_cu, (const void*)mk_fwd, 512, LDS_BYTES) != hipSuccess || per_cu < 1) { fprintf(stderr, "kernel_launch: occupancy query says %d\n", per_cu); per_cu = 1; }
        (void)hipGetLastError();
        grid = cus * 1;
    }
    if (grid < 0) return;
    Args a{};
    for (int i = 0; i < 14; ++i) a.in[i] = (const float*)d_in[i];
    a.out = (float*)d_out; a.ws = (unsigned char*)d_ws;
#if MK_N_LAUNCHES == 1
    a.ph_lo = 0; a.ph_hi = NPH;
    void* kargs[] = {&a};
    hipError_t e = hipLaunchCooperativeKernel((const void*)mk_fwd, dim3(grid), dim3(512), kargs, LDS_BYTES, stream);
    if (e != hipSuccess) fprintf(stderr, "cooperative launch failed: %s (grid %d)\n", hipGetErrorString(e), grid);
#else
    for (int p = 0; p < NPH; ++p) { a.ph_lo = p; a.ph_hi = p + 1; hipLaunchKernelGGL(mk_fwd, dim3(grid), dim3(512), LDS_BYTES, stream, a); }
#endif
}
```

```cpp
#include <hip/hip_runtime.h>
#include <hip/hip_cooperative_groups.h>
#include <cstdio>
#include <cstdint>
namespace cg = cooperative_groups;

#define LAS __attribute__((address_space(3)))
typedef unsigned short bf16_t;
typedef short bf16x8 __attribute__((ext_vector_type(8)));
typedef float f32x4 __attribute__((ext_vector_type(4)));
typedef float f32x2 __attribute__((ext_vector_type(2)));
typedef float f32x16 __attribute__((ext_vector_type(16)));
typedef unsigned u32x4 __attribute__((ext_vector_type(4)));
typedef unsigned u32x2 __attribute__((ext_vector_type(2)));
typedef __bf16 bf16x2_t __attribute__((ext_vector_type(2)));

#ifndef MK_N_LAUNCHES
#define MK_N_LAUNCHES 1
#endif

constexpr int MT = 16384;
constexpr int SEQ = 2048;
constexpr int DM = 2048;
constexpr int NIN = 17408;
constexpr int DH = 1024;
constexpr int NREL = 320;
constexpr int PT = MT + 64;
constexpr float LOG2E = 1.4426950408889634f;
constexpr float QSCALE = 0.125f * LOG2E;
constexpr float EPSN = 1e-6f;

constexpr size_t MiB = 1u << 20;
constexpr size_t WS_WIN = 2 * MiB;
constexpr size_t WS_WBR = 138 * MiB;
constexpr size_t WS_WOUT = 162 * MiB;
constexpr size_t WS_H = 178 * MiB;
constexpr size_t WS_SEG = 242 * MiB;
constexpr size_t WS_GATES = 594 * MiB;
constexpr size_t WS_O = 786 * MiB;
constexpr size_t WS_SGUW = 882 * MiB;
constexpr size_t WS_VT = 884 * MiB;
constexpr size_t WS_VCT = 918 * MiB;
constexpr size_t WS_END = 952 * MiB;
constexpr size_t SEGB = 32 * MiB;
constexpr size_t WS_MERGED32 = WS_SEG;
constexpr size_t WS_MERGED16 = WS_SEG + 4 * SEGB;
constexpr size_t WS_Y = WS_SEG + 6 * SEGB;

constexpr int LDS_BYTES = 163840;

__device__ __forceinline__ unsigned pk2(float lo, float hi) { f32x2 v = {lo, hi}; bf16x2_t b = __builtin_convertvector(v, bf16x2_t); return __builtin_bit_cast(unsigned, b); }
__device__ __forceinline__ float bflo(unsigned u) { return __uint_as_float(u << 16); }
__device__ __forceinline__ float bfhi(unsigned u) { return __uint_as_float(u & 0xffff0000u); }
__device__ __forceinline__ float fast_sigmoid(float w) { return __builtin_amdgcn_rcpf(1.0f + __builtin_amdgcn_exp2f(-w * LOG2E)); }
__device__ __forceinline__ float wave_sum(float v) {
#pragma unroll
    for (int o = 1; o < 64; o <<= 1) v += __shfl_xor(v, o);
    return v;
}
#define MFMA32(a, b, c) __builtin_amdgcn_mfma_f32_32x32x16_bf16((a), (b), (c), 0, 0, 0)

namespace pg8 {
constexpr int BM = 256, BK = 64, HALF = 128, HTB = HALF * BK * 2, STAGE_BYTES = 8 * HTB, NXCD = 8, WGM = 8;
__device__ __forceinline__ int lds_byte(int r, int c) { const int st = (r >> 4) * 2 + (c >> 5), rr = r & 15, cc = c & 31, ob = rr * 64 + cc * 2; return st * 1024 + (ob ^ (((ob >> 9) & 1) << 5)); }
__device__ __forceinline__ void stage_rc(int b, int& R, int& C) { const int st = b / 1024, sb = b % 1024, swz = sb ^ (((sb >> 9) & 1) << 5); R = (st >> 1) * 16 + swz / 64; C = (st & 1) * 32 + (swz % 64) / 2; }
__device__ __forceinline__ int perm32(int rho) { const int n = rho >> 4, i = rho & 15; return 8 * (i >> 2) + 4 * n + (i & 3); }

struct Unit { int pm, pn, z; };
struct Gemm { const bf16_t* A; const bf16_t* Bt; int M, N, K; size_t zA, zB; };

template <int NZ> struct TileOrder {
    int nM, nN, nwg, G, c;
    __device__ void init(int M, int N, int G_, int c_) { nM = M / BM; nN = N / BM; nwg = nM * nN; G = G_; c = c_; }
    __device__ bool next(int i, Unit& u) const {
        const int ti = i / NZ; u.z = i - ti * NZ;
        const long L = (long)ti * G + c; if (L >= nwg) return false;
        int wgid = (int)L; { const int q = nwg / NXCD, r = nwg % NXCD, xcd = wgid % NXCD, off = wgid / NXCD; wgid = (xcd < r ? xcd * (q + 1) : r * (q + 1) + (xcd - r) * q) + off; }
        const int nig = WGM * nN, gid = wgid / nig, fm = gid * WGM, gsz = (nM - fm) < WGM ? (nM - fm) : WGM;
        u.pm = fm + ((wgid % nig) % gsz); u.pn = (wgid % nig) / gsz; return true;
    }
};


struct EpiIn {
    static constexpr bool PERM = true;
    unsigned char* seg;
    bf16_t* gates;
    bf16_t* vt; bf16_t* vct;
    __device__ __forceinline__ bool reset(const Unit&) const { return true; }
    __device__ __forceinline__ void operator()(const f32x4 (&acc)[2][2][4][2], const Unit& u, int wr, int wc, int fr, int fq) const {
        const int colt = u.pn * BM;
        const int row0 = u.pm * BM + wr * 64 + fr;
        int mode;
        bool transposed = false; float sc = 1.f; bf16_t* base; int ldc; int c0;
        if (colt < 11 * DH) {
            const int s = colt >> 10; c0 = colt & 1023; base = (bf16_t*)(seg + (size_t)s * SEGB); ldc = DH;
            mode = (s == 3 || s == 7 || s == 10) ? 1 : ((s == 8 || s == 9) ? 2 : 0);
            transposed = (s == 2 || s == 9);
            if (s == 2) base = vt; else if (s == 9) base = vct;
            if (s == 0) sc = QSCALE;
        } else { c0 = colt - 11 * DH; base = gates; ldc = 3 * DM; mode = 3; }
        const int col0 = c0 + wc * 32 + 8 * fq;
#pragma unroll
        for (int ai = 0; ai < 2; ++ai)
#pragma unroll
            for (int m = 0; m < 4; ++m) {
                const int row = row0 + ai * HALF + m * 16;
#pragma unroll
                for (int bj = 0; bj < 2; ++bj) {
                    float v[8];
#pragma unroll
                    for (int e = 0; e < 4; ++e) { v[e] = acc[ai][bj][m][0][e]; v[4 + e] = acc[ai][bj][m][1][e]; }
                    if (mode == 0) {
#pragma unroll
                        for (int e = 0; e < 8; ++e) v[e] *= sc;
                    } else {
#pragma unroll
                        for (int e = 0; e < 8; ++e) {
                            const float x = v[e];
                            const float w = (mode == 2) ? 1.5957691216057308f * (x + 0.044715f * x * x * x) : x;
                            const float sg = fast_sigmoid(w);
                            v[e] = (mode == 3) ? fmaxf(sg, 9.5367431640625e-07f) : x * sg;
                        }
                    }
                    if (!transposed) {
                        u32x4 w; w.x = pk2(v[0], v[1]); w.y = pk2(v[2], v[3]); w.z = pk2(v[4], v[5]); w.w = pk2(v[6], v[7]);
                        *(u32x4*)(base + (size_t)row * ldc + col0 + bj * HALF) = w;
                    } else {
#pragma unroll
                        for (int e = 0; e < 8; e += 2) {
                            const unsigned w = pk2(v[e], v[e + 1]);
                            base[(size_t)(col0 + bj * HALF + e) * PT + row] = (bf16_t)(w & 0xffffu);
                            base[(size_t)(col0 + bj * HALF + e + 1) * PT + row] = (bf16_t)(w >> 16);
                        }
                    }
                }
            }
    }
};

struct EpiPlain {
    static constexpr bool PERM = true;
    bf16_t* O; int ldc;
    __device__ __forceinline__ bool reset(const Unit&) const { return true; }
    __device__ __forceinline__ void operator()(const f32x4 (&acc)[2][2][4][2], const Unit& u, int wr, int wc, int fr, int fq) const {
        const int row0 = u.pm * BM + wr * 64 + fr, col0 = u.pn * BM + wc * 32 + 8 * fq;
#pragma unroll
        for (int ai = 0; ai < 2; ++ai)
#pragma unroll
            for (int m = 0; m < 4; ++m) { bf16_t* rowp = O + (size_t)(row0 + ai * HALF + m * 16) * ldc + col0;
#pragma unroll
                for (int bj = 0; bj < 2; ++bj) { const f32x4 v0 = acc[ai][bj][m][0], v1 = acc[ai][bj][m][1];
                    u32x4 w; w.x = pk2(v0[0], v0[1]); w.y = pk2(v0[2], v0[3]); w.z = pk2(v1[0], v1[1]); w.w = pk2(v1[2], v1[3]);
                    *(u32x4*)(rowp + bj * HALF) = w; } }
    }
};

struct EpiMerge {
    static constexpr bool PERM = true;
    const bf16_t* __restrict__ gates; bf16_t* __restrict__ out;
    __device__ __forceinline__ bool reset(const Unit& u) const { return u.z == 2; }
    __device__ __forceinline__ void operator()(f32x4 (&acc)[2][2][4][2], const Unit& u, int wr, int wc, int fr, int fq) const {
        const int row0 = u.pm * BM + wr * 64 + fr, col0 = u.pn * BM + wc * 32 + 8 * fq;
        const int z = u.z;
        const bf16_t* gz = gates + (size_t)row0 * (3 * DM) + z * DM + col0;
        if (z < 2) {
#pragma unroll
            for (int ai = 0; ai < 2; ++ai) {
                u32x4 gn[4][2], gd[4][2];
#pragma unroll
                for (int m = 0; m < 4; ++m)
#pragma unroll
                    for (int bj = 0; bj < 2; ++bj) { const bf16_t* p = gz + (size_t)(ai * HALF + m * 16) * (3 * DM) + bj * HALF; gn[m][bj] = *(const u32x4*)p; gd[m][bj] = *(const u32x4*)(p + DM); }
#pragma unroll
                for (int m = 0; m < 4; ++m)
#pragma unroll
                    for (int bj = 0; bj < 2; ++bj) {
                        const u32x4 a = gn[m][bj], d = gd[m][bj];
                        f32x4& v0 = acc[ai][bj][m][0]; f32x4& v1 = acc[ai][bj][m][1];
                        v0[0] *= bflo(a.x) * __builtin_amdgcn_rcpf(bflo(d.x)); v0[1] *= bfhi(a.x) * __builtin_amdgcn_rcpf(bfhi(d.x));
                        v0[2] *= bflo(a.y) * __builtin_amdgcn_rcpf(bflo(d.y)); v0[3] *= bfhi(a.y) * __builtin_amdgcn_rcpf(bfhi(d.y));
                        v1[0] *= bflo(a.z) * __builtin_amdgcn_rcpf(bflo(d.z)); v1[1] *= bfhi(a.z) * __builtin_amdgcn_rcpf(bfhi(d.z));
                        v1[2] *= bflo(a.w) * __builtin_amdgcn_rcpf(bflo(d.w)); v1[3] *= bfhi(a.w) * __builtin_amdgcn_rcpf(bfhi(d.w));
                    }
            }
        } else {
#pragma unroll
            for (int ai = 0; ai < 2; ++ai) {
                u32x4 gn[4][2];
#pragma unroll
                for (int m = 0; m < 4; ++m)
#pragma unroll
                    for (int bj = 0; bj < 2; ++bj) gn[m][bj] = *(const u32x4*)(gz + (size_t)(ai * HALF + m * 16) * (3 * DM) + bj * HALF);
#pragma unroll
                for (int m = 0; m < 4; ++m)
#pragma unroll
                    for (int bj = 0; bj < 2; ++bj) {
                        const u32x4 a = gn[m][bj];
                        const f32x4 v0 = acc[ai][bj][m][0], v1 = acc[ai][bj][m][1];
                        u32x4 w; w.x = pk2(v0[0] * bflo(a.x), v0[1] * bfhi(a.x)); w.y = pk2(v0[2] * bflo(a.y), v0[3] * bfhi(a.y));
                        w.z = pk2(v1[0] * bflo(a.z), v1[1] * bfhi(a.z)); w.w = pk2(v1[2] * bflo(a.w), v1[3] * bfhi(a.w));
                        *(u32x4*)(out + (size_t)(row0 + ai * HALF + m * 16) * DM + col0 + bj * HALF) = w;
                    }
            }
        }
    }
};

template <class Epi, class Sched, bool ALIGN_EPI>
__device__ __forceinline__ void gemm_phase(LAS unsigned char* lds, const Gemm g, const Sched& S, const Epi& E) {
    const int tid = threadIdx.x, wid = __builtin_amdgcn_readfirstlane(tid >> 6), lane = tid & 63, wr = wid >> 2, wc = wid & 3, fr = lane & 15, fq = lane >> 4;
    const int K = g.K, nt = K / BK;
    unsigned voffA[2], voffB[2];
#pragma unroll
    for (int i = 0; i < 2; ++i) { int R, C; stage_rc(tid * 16 + i * 8192, R, C); const int Rb = Epi::PERM ? ((R & ~31) + perm32(R & 31)) : R;
        voffA[i] = (unsigned)(R * K + C) * 2u; voffB[i] = (unsigned)(Rb * K + C) * 2u; }
    const size_t kstep = (size_t)(BK * 2);
    const size_t hstep = (size_t)HALF * K * 2;
    const size_t tstep = 2 * hstep;
    const unsigned ldsw = (unsigned)wid * 1024u;
    const int aoff = lds_byte(wr * 64 + fr, fq * 8), boff = lds_byte(wc * 32 + fr, fq * 8);
#define PG8_SA(b, h) (((b) * 2 + (h)) * HTB)
#define PG8_SB(b, h) ((4 + (b) * 2 + (h)) * HTB)
#define PG8_STAGE(bufoff, gbase, voff) do { _Pragma("unroll") for (int _i = 0; _i < 2; ++_i) \
        __builtin_amdgcn_global_load_lds((const unsigned*)((const char*)(gbase) + (voff)[_i]), (LAS unsigned*)(lds + (bufoff) + ldsw + _i * 8192), 16, 0, 0); } while (0)
#define PG8_LDA(dst, b, h) do { _Pragma("unroll") for (int m = 0; m < 4; ++m) _Pragma("unroll") for (int k = 0; k < 2; ++k) dst[m][k] = *(const LAS bf16x8*)(lds + PG8_SA(b, h) + aoff + m * 2048 + k * 1024); } while (0)
#define PG8_LDB(dst, b, h) do { _Pragma("unroll") for (int n = 0; n < 2; ++n) _Pragma("unroll") for (int k = 0; k < 2; ++k) dst[n][k] = *(const LAS bf16x8*)(lds + PG8_SB(b, h) + boff + n * 2048 + k * 1024); } while (0)
#define PG8_MMA(ai, bj, At, Bt) do { __builtin_amdgcn_s_setprio(1); _Pragma("unroll") for (int m = 0; m < 4; ++m) _Pragma("unroll") for (int n = 0; n < 2; ++n) _Pragma("unroll") for (int k = 0; k < 2; ++k) \
        acc[ai][bj][m][n] = __builtin_amdgcn_mfma_f32_16x16x32_bf16(Bt[n][k], At[m][k], acc[ai][bj][m][n], 0, 0, 0); __builtin_amdgcn_s_setprio(0); } while (0)
#define PG8_WAIT_V(n) asm volatile("s_waitcnt vmcnt(" #n ")" ::: "memory")
#define PG8_WAIT_L(n) asm volatile("s_waitcnt lgkmcnt(" #n ")" ::: "memory")
#define PG8_BAR __builtin_amdgcn_s_barrier()
#define PG8_SCHED __builtin_amdgcn_sched_barrier(0)
    Unit cur, nxt; int ui = 0;
    if (!S.next(0, cur)) return;
    f32x4 acc[2][2][4][2];
#pragma unroll
    for (int a = 0; a < 2; ++a)
#pragma unroll
        for (int b = 0; b < 2; ++b)
#pragma unroll
            for (int m = 0; m < 4; ++m)
#pragma unroll
                for (int n = 0; n < 2; ++n) acc[a][b][m][n] = (f32x4){0.f, 0.f, 0.f, 0.f};
    bf16x8 At[4][2], B0[2][2], B1[2][2];
    const char* cA = (const char*)g.A + (size_t)cur.z * g.zA + (size_t)cur.pm * tstep; const char* cB = (const char*)g.Bt + (size_t)cur.z * g.zB + (size_t)cur.pn * tstep;
    PG8_STAGE(PG8_SB(0, 0), cB, voffB); PG8_STAGE(PG8_SB(0, 1), cB + hstep, voffB); PG8_STAGE(PG8_SA(0, 0), cA, voffA); PG8_STAGE(PG8_SA(0, 1), cA + hstep, voffA);
    if (wr == 1) PG8_BAR;
    PG8_WAIT_V(2); PG8_BAR;
    PG8_STAGE(PG8_SB(1, 0), cB + kstep, voffB); PG8_STAGE(PG8_SA(1, 0), cA + kstep, voffA); PG8_STAGE(PG8_SB(1, 1), cB + hstep + kstep, voffB);
    PG8_WAIT_V(6); PG8_BAR;
    for (;;) {
        const bool has_next = S.next(ui + 1, nxt);
        const char* nA = has_next ? (const char*)g.A + (size_t)nxt.z * g.zA + (size_t)nxt.pm * tstep : cA;
        const char* nB = has_next ? (const char*)g.Bt + (size_t)nxt.z * g.zB + (size_t)nxt.pn * tstep : cB;
        for (int t = 0; t < nt; t += 2) {
            const bool last = (t == nt - 2);
            const char* a1 = cA + (size_t)(t + 1) * kstep;
            const char* a2 = last ? nA : cA + (size_t)(t + 2) * kstep; const char* b2 = last ? nB : cB + (size_t)(t + 2) * kstep;
            const char* a3 = a2 + kstep; const char* b3 = b2 + kstep;
            PG8_LDB(B0, 0, 0); PG8_LDB(B1, 0, 1); PG8_SCHED; PG8_LDA(At, 0, 0); PG8_STAGE(PG8_SA(1, 1), a1 + hstep, voffA);
            PG8_WAIT_V(8); PG8_WAIT_L(0); PG8_BAR; PG8_MMA(0, 0, At, B0); PG8_MMA(0, 1, At, B1); PG8_BAR; PG8_SCHED;
            PG8_LDA(At, 0, 1); PG8_STAGE(PG8_SB(0, 0), b2, voffB); PG8_STAGE(PG8_SB(0, 1), b2 + hstep, voffB); PG8_STAGE(PG8_SA(0, 0), a2, voffA);
            PG8_WAIT_V(8); PG8_WAIT_L(0); PG8_BAR; PG8_MMA(1, 0, At, B0); PG8_MMA(1, 1, At, B1); PG8_BAR; PG8_SCHED;
            PG8_LDB(B0, 1, 0); PG8_LDB(B1, 1, 1); PG8_SCHED; PG8_LDA(At, 1, 0); PG8_STAGE(PG8_SA(0, 1), a2 + hstep, voffA);
            PG8_WAIT_V(8); PG8_WAIT_L(0); PG8_BAR; PG8_MMA(0, 0, At, B0); PG8_MMA(0, 1, At, B1); PG8_BAR; PG8_SCHED;
            PG8_LDA(At, 1, 1); PG8_STAGE(PG8_SB(1, 0), b3, voffB); PG8_STAGE(PG8_SB(1, 1), b3 + hstep, voffB); PG8_STAGE(PG8_SA(1, 0), a3, voffA);
            PG8_WAIT_V(8); PG8_WAIT_L(0); PG8_BAR; PG8_MMA(1, 0, At, B0); PG8_MMA(1, 1, At, B1); PG8_BAR; PG8_SCHED;
        }
        if constexpr (ALIGN_EPI) { if (wr == 0) PG8_BAR; }
        E(acc, cur, wr, wc, fr, fq);
        if (!has_next) break;
        if (E.reset(cur)) {
#pragma unroll
        for (int a = 0; a < 2; ++a)
#pragma unroll
            for (int b = 0; b < 2; ++b)
#pragma unroll
                for (int m = 0; m < 4; ++m)
#pragma unroll
                    for (int n = 0; n < 2; ++n) acc[a][b][m][n] = (f32x4){0.f, 0.f, 0.f, 0.f};
        }
        cur = nxt; cA = nA; cB = nB; ++ui;
        if constexpr (ALIGN_EPI) { if (wr == 1) PG8_BAR; }
    }
    PG8_WAIT_V(0);
    if constexpr (!ALIGN_EPI) { if (wr == 0) PG8_BAR; }
    PG8_BAR;
#undef PG8_SA
#undef PG8_SB
#undef PG8_STAGE
#undef PG8_LDA
#undef PG8_LDB
#undef PG8_MMA
#undef PG8_WAIT_V
#undef PG8_WAIT_L
#undef PG8_BAR
#undef PG8_SCHED
}
}

__device__ __forceinline__ void transpose_item(const float* __restrict__ W, int K, int N, bf16_t* __restrict__ WT, LAS float* scr, int item, int lane) {
    const int nblk = N / 32, kb = item / nblk, nb = item - kb * nblk, k0 = 64 * kb, n0 = 32 * nb;
    float tv[32];
#pragma unroll
    for (int i = 0; i < 32; ++i) { const int kk = 2 * i + (lane >> 5); tv[i] = W[(size_t)(k0 + kk) * N + n0 + (lane & 31)]; }
#pragma unroll
    for (int i = 0; i < 32; ++i) { const int kk = 2 * i + (lane >> 5); scr[kk * 33 + (lane & 31)] = tv[i]; }
    asm volatile("s_waitcnt lgkmcnt(0)" ::: "memory");
    const int c = lane & 7;
#pragma unroll
    for (int j = 0; j < 4; ++j) { const int n = (lane >> 3) + 8 * j; const LAS float* s = scr + (8 * c) * 33 + n;
        u32x4 o; o.x = pk2(s[0 * 33], s[1 * 33]); o.y = pk2(s[2 * 33], s[3 * 33]); o.z = pk2(s[4 * 33], s[5 * 33]); o.w = pk2(s[6 * 33], s[7 * 33]);
        *(u32x4*)(WT + (size_t)(n0 + n) * K + k0 + 8 * c) = o; }
    asm volatile("s_waitcnt lgkmcnt(0)" ::: "memory");
}

template <bool HAS_Y, bool WRITE_H>
__device__ __forceinline__ void row_pass(const float* __restrict__ xin, const bf16_t* __restrict__ Y, const float* __restrict__ post_g, float* xout,
                                         const float* __restrict__ pre_g, bf16_t* __restrict__ H, int gw, int NGW, int lane) {
    for (int row = gw; row < MT; row += NGW) {
        float xv[4][8];
#pragma unroll
        for (int j = 0; j < 4; ++j) { const int col = (j * 64 + lane) * 8; const f32x4 a = *(const f32x4*)(xin + (size_t)row * DM + col), b = *(const f32x4*)(xin + (size_t)row * DM + col + 4);
#pragma unroll
            for (int e = 0; e < 4; ++e) { xv[j][e] = a[e]; xv[j][4 + e] = b[e]; } }
        if constexpr (HAS_Y) {
            float yv[4][8]; float ss = 0.f;
#pragma unroll
            for (int j = 0; j < 4; ++j) { const int col = (j * 64 + lane) * 8; const u32x4 w = *(const u32x4*)(Y + (size_t)row * DM + col);
                yv[j][0] = bflo(w.x); yv[j][1] = bfhi(w.x); yv[j][2] = bflo(w.y); yv[j][3] = bfhi(w.y); yv[j][4] = bflo(w.z); yv[j][5] = bfhi(w.z); yv[j][6] = bflo(w.w); yv[j][7] = bfhi(w.w);
#pragma unroll
                for (int e = 0; e < 8; ++e) ss += yv[j][e] * yv[j][e]; }
            const float r = 1.0f / sqrtf(wave_sum(ss) * (1.0f / DM) + EPSN);
#pragma unroll
            for (int j = 0; j < 4; ++j) { const int col = (j * 64 + lane) * 8; const f32x4 ga = *(const f32x4*)(post_g + col), gb = *(const f32x4*)(post_g + col + 4);
#pragma unroll
                for (int e = 0; e < 4; ++e) { xv[j][e] += yv[j][e] * r * ga[e]; xv[j][4 + e] += yv[j][4 + e] * r * gb[e]; }
                *(f32x4*)(xout + (size_t)row * DM + col) = (f32x4){xv[j][0], xv[j][1], xv[j][2], xv[j][3]};
                *(f32x4*)(xout + (size_t)row * DM + col + 4) = (f32x4){xv[j][4], xv[j][5], xv[j][6], xv[j][7]}; }
        }
        if constexpr (WRITE_H) {
            float ss = 0.f;
#pragma unroll
            for (int j = 0; j < 4; ++j)
#pragma unroll
                for (int e = 0; e < 8; ++e) ss += xv[j][e] * xv[j][e];
            const float r = 1.0f / sqrtf(wave_sum(ss) * (1.0f / DM) + EPSN);
#pragma unroll
            for (int j = 0; j < 4; ++j) { const int col = (j * 64 + lane) * 8; const f32x4 ga = *(const f32x4*)(pre_g + col), gb = *(const f32x4*)(pre_g + col + 4);
                u32x4 w; w.x = pk2(xv[j][0] * r * ga[0], xv[j][1] * r * ga[1]); w.y = pk2(xv[j][2] * r * ga[2], xv[j][3] * r * ga[3]);
                w.z = pk2(xv[j][4] * r * gb[0], xv[j][5] * r * gb[1]); w.w = pk2(xv[j][6] * r * gb[2], xv[j][7] * r * gb[3]);
                *(u32x4*)(H + (size_t)row * DM + col) = w; }
        }
    }
}

constexpr int ATP = 144;
constexpr int ATT_WAVE_LDS = 2 * 64 * ATP;
__device__ __forceinline__ void attn_item(const bf16_t* __restrict__ Q, const bf16_t* __restrict__ Kb, const bf16_t* __restrict__ VT, const bf16_t* __restrict__ GA,
                                          bf16_t* __restrict__ OA, const LAS float* btab, LAS unsigned char* wl, int b, int c, int h, int half, int lane) {
    const int r = lane & 31, hh = lane >> 5;
    const int rl = lane >> 3, cl = lane & 7;
    const int tokq = b * SEQ + c * 64 + half * 32;
    const int qloc = half * 32 + r;
    const int pr = (r & ~12) | ((r & 4) << 1) | ((r & 8) >> 1);
    const int jmin = c >= 8 ? 0 : 8 - c;
    const int tk0 = b * SEQ + (c - 8 + jmin) * 64;
    const bf16_t* kg = Kb + (size_t)(tk0 + rl) * DH + h * 64 + cl * 8;
    const bf16_t* vg = VT + (size_t)(h * 64 + rl) * PT + tk0 + cl * 8;
    LAS unsigned char* Kt = wl; LAS unsigned char* Vt = wl + 64 * ATP;
    const int stoff = rl * ATP + cl * 16;
    u32x4 kr[8], vr[8];
#pragma unroll
    for (int i = 0; i < 8; ++i) { kr[i] = *(const u32x4*)(kg + (size_t)(8 * i) * DH); vr[i] = *(const u32x4*)(vg + (size_t)(8 * i) * PT); }
    bf16x8 qf[4];
    { const bf16_t* qp = Q + (size_t)(tokq + r) * DH + h * 64 + 8 * hh;
#pragma unroll
      for (int d0 = 0; d0 < 4; ++d0) qf[d0] = *(const bf16x8*)(qp + d0 * 16); }
#pragma unroll
    for (int i = 0; i < 8; ++i) { *(LAS u32x4*)(Kt + stoff + 8 * i * ATP) = kr[i]; *(LAS u32x4*)(Vt + stoff + 8 * i * ATP) = vr[i]; }
    { const int adv = (jmin + 1 <= 8) ? 1 : 0; kg += (size_t)adv * 64 * DH; vg += adv * 64; }
#pragma unroll
    for (int i = 0; i < 8; ++i) { kr[i] = *(const u32x4*)(kg + (size_t)(8 * i) * DH); vr[i] = *(const u32x4*)(vg + (size_t)(8 * i) * PT); }
    f32x16 o0, o1;
#pragma unroll
    for (int i = 0; i < 16; ++i) { o0[i] = 0.f; o1[i] = 0.f; }
    float mrun = -1e30f, lrun = 0.f;
    const float cfar = btab[NREL - 1];
    const LAS unsigned char* kfp = Kt + pr * ATP + 16 * hh;
    const LAS unsigned char* vfp = Vt + r * ATP + 16 * hh;
    for (int j = jmin; j <= 8; ++j) {
        f32x16 s0, s1;
#pragma unroll
        for (int i = 0; i < 16; ++i) { s0[i] = 0.f; s1[i] = 0.f; }
#pragma unroll
        for (int d0 = 0; d0 < 4; ++d0) {
            const bf16x8 k0 = *(const LAS bf16x8*)(kfp + d0 * 32), k1 = *(const LAS bf16x8*)(kfp + 32 * ATP + d0 * 32);
            s0 = MFMA32(k0, qf[d0], s0); s1 = MFMA32(k1, qf[d0], s1);
        }
        if (j <= 3) {
#pragma unroll
            for (int i = 0; i < 16; ++i) { s0[i] += cfar; s1[i] += cfar; }
        } else {
            const int base = qloc + 64 * (8 - j) + 63 - 8 * hh;
#pragma unroll
            for (int i = 0; i < 16; ++i) {
                const int key = (i & 3) + 4 * ((i >> 2) & 1) + 16 * (i >> 3);
                int i0 = base - key, i1 = base - key - 32;
                i0 = i0 > NREL - 1 ? NREL - 1 : i0; i1 = i1 > NREL - 1 ? NREL - 1 : i1;
                s0[i] += btab[i0]; s1[i] += btab[i1];
            }
        }
        float tmax = fmaxf(s0[0], s1[0]);
#pragma unroll
        for (int i = 1; i < 16; ++i) tmax = fmaxf(tmax, fmaxf(s0[i], s1[i]));
        tmax = fmaxf(tmax, __shfl_xor(tmax, 32));
        const float mnew = fmaxf(mrun, tmax);
        const float alpha = __builtin_amdgcn_exp2f(mrun - mnew);
        mrun = mnew;
        float ls = 0.f;
#pragma unroll
        for (int i = 0; i < 16; ++i) { s0[i] = __builtin_amdgcn_exp2f(s0[i] - mnew); s1[i] = __builtin_amdgcn_exp2f(s1[i] - mnew); ls += s0[i] + s1[i]; }
        lrun = lrun * alpha + ls;
#pragma unroll
        for (int i = 0; i < 16; ++i) { o0[i] *= alpha; o1[i] *= alpha; }
#pragma unroll
        for (int s = 0; s < 2; ++s) {
            u32x4 pa, pb;
            pa.x = pk2(s0[8 * s + 0], s0[8 * s + 1]); pa.y = pk2(s0[8 * s + 2], s0[8 * s + 3]); pa.z = pk2(s0[8 * s + 4], s0[8 * s + 5]); pa.w = pk2(s0[8 * s + 6], s0[8 * s + 7]);
            pb.x = pk2(s1[8 * s + 0], s1[8 * s + 1]); pb.y = pk2(s1[8 * s + 2], s1[8 * s + 3]); pb.z = pk2(s1[8 * s + 4], s1[8 * s + 5]); pb.w = pk2(s1[8 * s + 6], s1[8 * s + 7]);
            const bf16x8 va0 = *(const LAS bf16x8*)(vfp + 32 * s), va1 = *(const LAS bf16x8*)(vfp + 32 * ATP + 32 * s);
            const bf16x8 vb0 = *(const LAS bf16x8*)(vfp + 64 + 32 * s), vb1 = *(const LAS bf16x8*)(vfp + 32 * ATP + 64 + 32 * s);
            o0 = MFMA32(va0, __builtin_bit_cast(bf16x8, pa), o0); o1 = MFMA32(va1, __builtin_bit_cast(bf16x8, pa), o1);
            o0 = MFMA32(vb0, __builtin_bit_cast(bf16x8, pb), o0); o1 = MFMA32(vb1, __builtin_bit_cast(bf16x8, pb), o1);
        }
#pragma unroll
        for (int i = 0; i < 8; ++i) { *(LAS u32x4*)(Kt + stoff + 8 * i * ATP) = kr[i]; *(LAS u32x4*)(Vt + stoff + 8 * i * ATP) = vr[i]; }
        { const int adv = (j + 2 <= 8) ? 1 : 0; kg += (size_t)adv * 64 * DH; vg += adv * 64; }
#pragma unroll
        for (int i = 0; i < 8; ++i) { kr[i] = *(const u32x4*)(kg + (size_t)(8 * i) * DH); vr[i] = *(const u32x4*)(vg + (size_t)(8 * i) * PT); }
    }
    const float l = lrun + __shfl_xor(lrun, 32);
    const float inv = 1.0f / l;
    LAS unsigned char* Ot = wl;
#pragma unroll
    for (int g = 0; g < 4; ++g) {
#pragma unroll
        for (int db = 0; db < 2; ++db) {
            const f32x16& o = db ? o1 : o0;
            u32x2 w; w.x = pk2(o[4 * g + 0] * inv, o[4 * g + 1] * inv); w.y = pk2(o[4 * g + 2] * inv, o[4 * g + 3] * inv);
            *(LAS u32x2*)(Ot + r * ATP + (db * 32 + 8 * g + 4 * hh) * 2) = w;
        }
    }
#pragma unroll
    for (int i = 0; i < 4; ++i) {
        const int row = rl + 8 * i;
        const size_t a = (size_t)(tokq + row) * DH + h * 64 + cl * 8;
        const u32x4 gg = *(const u32x4*)(GA + a);
        const u32x4 ov = *(const LAS u32x4*)(Ot + row * ATP + cl * 16);
        u32x4 w; w.x = pk2(bflo(ov.x) * bflo(gg.x), bfhi(ov.x) * bfhi(gg.x)); w.y = pk2(bflo(ov.y) * bflo(gg.y), bfhi(ov.y) * bfhi(gg.y));
        w.z = pk2(bflo(ov.z) * bflo(gg.z), bfhi(ov.z) * bfhi(gg.z)); w.w = pk2(bflo(ov.w) * bflo(gg.w), bfhi(ov.w) * bfhi(gg.w));
        *(u32x4*)(OA + a) = w;
    }
}

__device__ __forceinline__ void unpack8(const u32x4 w, float* v) { v[0] = bflo(w.x); v[1] = bfhi(w.x); v[2] = bflo(w.y); v[3] = bfhi(w.y); v[4] = bflo(w.z); v[5] = bfhi(w.z); v[6] = bflo(w.w); v[7] = bfhi(w.w); }
__device__ __forceinline__ void conv_unit(const bf16_t* __restrict__ BB, const bf16_t* __restrict__ CC, const bf16_t* __restrict__ HB, const bf16_t* __restrict__ GB,
                                          bf16_t* __restrict__ OB, const float* __restrict__ cw, int unit, int tid) {
    const int cgp = tid & 127, sub = tid >> 7, ch = cgp * 8;
    const int t0 = unit * 32 + sub * 8;
    float w0[8], w1[8], w2[8];
#pragma unroll
    for (int e = 0; e < 8; ++e) { w0[e] = cw[ch + e]; w1[e] = cw[DH + ch + e]; w2[e] = cw[2 * DH + ch + e]; }
    float p2[8], p1[8];
#pragma unroll
    for (int e = 0; e < 8; ++e) { p2[e] = 0.f; p1[e] = 0.f; }
    const int tpos = t0 & (SEQ - 1);
    if (tpos >= 2) { float a[8], b[8]; unpack8(*(const u32x4*)(CC + (size_t)(t0 - 2) * DH + ch), a); unpack8(*(const u32x4*)(HB + (size_t)(t0 - 2) * DH + ch), b);
#pragma unroll
        for (int e = 0; e < 8; ++e) p2[e] = a[e] * b[e]; }
    if (tpos >= 1) { float a[8], b[8]; unpack8(*(const u32x4*)(CC + (size_t)(t0 - 1) * DH + ch), a); unpack8(*(const u32x4*)(HB + (size_t)(t0 - 1) * DH + ch), b);
#pragma unroll
        for (int e = 0; e < 8; ++e) p1[e] = a[e] * b[e]; }
#pragma unroll
    for (int i = 0; i < 8; ++i) {
        const size_t off = (size_t)(t0 + i) * DH + ch;
        float a[8], b[8], g1[8], g2[8], o[8];
        unpack8(*(const u32x4*)(CC + off), a); unpack8(*(const u32x4*)(HB + off), b); unpack8(*(const u32x4*)(BB + off), g1); unpack8(*(const u32x4*)(GB + off), g2);
#pragma unroll
        for (int e = 0; e < 8; ++e) { const float cur = a[e] * b[e]; o[e] = g1[e] * (w0[e] * p2[e] + w1[e] * p1[e] + w2[e] * cur) * g2[e]; p2[e] = p1[e]; p1[e] = cur; }
        u32x4 w; w.x = pk2(o[0], o[1]); w.y = pk2(o[2], o[3]); w.z = pk2(o[4], o[5]); w.w = pk2(o[6], o[7]);
        *(u32x4*)(OB + off) = w;
    }
}

template <int tbA, int tbB>
__device__ __forceinline__ void sgu_groups(const bf16_t* __restrict__ VCT, const bf16_t* __restrict__ U, const bf16_t* __restrict__ GC, bf16_t* __restrict__ OC,
                                           const bf16_t* __restrict__ Wbf, const float* __restrict__ spb, const float* __restrict__ lng, const float* __restrict__ lnb,
                                           int tok0, int gh, int cb, int r, int hh, const LAS float* stat) {
    for (int gi = 0; gi < 4; ++gi) {
        const int g = gh * 4 + gi;
        const int ch = g * 128 + cb * 32 + r;
        const float gg = lng[ch], bb = lnb[ch];
        const bf16_t* ap = VCT + (size_t)ch * PT + tok0 + 8 * hh;
        const bf16_t* wp = Wbf + (size_t)g * 16384 + 8 * hh;
        constexpr int NSB = (tbB + 1) * 2, NSA = (tbA + 1) * 2;
        int so = 0; asm volatile("" : "+v"(so));
        u32x4 raw[NSB]; bf16x8 wB[NSB], wA[NSA];
#pragma unroll
        for (int k = 0; k < NSB; ++k) { raw[k] = *(const u32x4*)(ap + 16 * k); wB[k] = *(const bf16x8*)(wp + (size_t)(tbB * 32 + r) * 128 + 16 * k); }
#pragma unroll
        for (int k = 0; k < NSA; ++k) wA[k] = *(const bf16x8*)(wp + (size_t)(tbA * 32 + r) * 128 + 16 * k);
        f32x16 accA, accB;
#pragma unroll
        for (int i = 0; i < 16; ++i) { accA[i] = 0.f; accB[i] = 0.f; }
#pragma unroll
        for (int k = 0; k < NSB; ++k) {
            float v[8]; unpack8(raw[k], v);
#pragma unroll
            for (int jj = 0; jj < 8; ++jj) { const float mean = stat[(16 * k + 8 * hh + jj) * 2 + so], rstd = stat[(16 * k + 8 * hh + jj) * 2 + 1 + so]; v[jj] = (v[jj] - mean) * rstd * gg + bb; }
            u32x4 af; af.x = pk2(v[0], v[1]); af.y = pk2(v[2], v[3]); af.z = pk2(v[4], v[5]); af.w = pk2(v[6], v[7]);
            accB = MFMA32(__builtin_bit_cast(bf16x8, af), wB[k], accB);
            if (k < NSA) accA = MFMA32(__builtin_bit_cast(bf16x8, af), wA[k < NSA ? k : 0], accA);
        }
        u32x2 uu[2][4], gc[2][4]; float sb[2];
#pragma unroll
        for (int which = 0; which < 2; ++which) { const int t = (which ? tbB : tbA) * 32 + r; sb[which] = spb[g * 128 + t];
            const size_t rowoff = (size_t)(tok0 + t) * DH + g * 128 + cb * 32 + 4 * hh;
#pragma unroll
            for (int q = 0; q < 4; ++q) { uu[which][q] = *(const u32x2*)(U + rowoff + 8 * q); gc[which][q] = *(const u32x2*)(GC + rowoff + 8 * q); } }
#pragma unroll
        for (int which = 0; which < 2; ++which) {
            const int tb = which ? tbB : tbA; const f32x16& acc = which ? accB : accA;
            const int t = tb * 32 + r; const float sbv = sb[which];
            const size_t rowoff = (size_t)(tok0 + t) * DH + g * 128 + cb * 32 + 4 * hh;
#pragma unroll
            for (int q = 0; q < 4; ++q) {
                const u32x2 u2 = uu[which][q], g2 = gc[which][q];
                u32x2 o; o.x = pk2(bflo(u2.x) * (acc[4 * q + 0] + sbv) * bflo(g2.x), bfhi(u2.x) * (acc[4 * q + 1] + sbv) * bfhi(g2.x));
                o.y = pk2(bflo(u2.y) * (acc[4 * q + 2] + sbv) * bflo(g2.y), bfhi(u2.y) * (acc[4 * q + 3] + sbv) * bfhi(g2.y));
                *(u32x2*)(OC + rowoff + 8 * q) = o;
            }
        }
    }
}

__device__ __forceinline__ void sgu_unit(const bf16_t* __restrict__ VCT, const bf16_t* __restrict__ U, const bf16_t* __restrict__ GC, bf16_t* __restrict__ OC,
                                         const bf16_t* __restrict__ Wbf, const float* __restrict__ spb, const float* __restrict__ lng, const float* __restrict__ lnb,
                                         int b, int n, int gh, LAS unsigned char* lds, int tid) {
    const int lane = tid & 63, w = __builtin_amdgcn_readfirstlane(tid >> 6), r = lane & 31, hh = lane >> 5;
    const int tok0 = b * SEQ + n * 128;
    __syncthreads();
    LAS float* part = (LAS float*)lds;
    LAS float* stat = part + 8 * 128 * 2;
    {
        const int tl = lane & 15, cq = lane >> 4;
        const bf16_t* p = VCT + (size_t)(w * 128 + cq) * PT + tok0 + 8 * tl;
        float sm[8], sq[8];
#pragma unroll
        for (int e = 0; e < 8; ++e) { sm[e] = 0.f; sq[e] = 0.f; }
#pragma unroll 8
        for (int c4 = 0; c4 < 32; ++c4) { float v[8]; unpack8(*(const u32x4*)(p + (size_t)(c4 * 4) * PT), v);
#pragma unroll
            for (int e = 0; e < 8; ++e) { sm[e] += v[e]; sq[e] += v[e] * v[e]; } }
#pragma unroll
        for (int e = 0; e < 8; ++e) { sm[e] += __shfl_xor(sm[e], 16); sm[e] += __shfl_xor(sm[e], 32); sq[e] += __shfl_xor(sq[e], 16); sq[e] += __shfl_xor(sq[e], 32); }
        if (cq == 0) {
#pragma unroll
            for (int e = 0; e < 8; ++e) { part[(w * 128 + 8 * tl + e) * 2 + 0] = sm[e]; part[(w * 128 + 8 * tl + e) * 2 + 1] = sq[e]; }
        }
    }
    __syncthreads();
    if (tid < 128) {
        float S = 0.f, SS = 0.f;
#pragma unroll
        for (int ww = 0; ww < 8; ++ww) { S += part[(ww * 128 + tid) * 2]; SS += part[(ww * 128 + tid) * 2 + 1]; }
        const float mean = S * (1.0f / DH); const float var = fmaxf(SS * (1.0f / DH) - mean * mean, 0.f);
        stat[tid * 2] = mean; stat[tid * 2 + 1] = 1.0f / sqrtf(var + EPSN);
    }
    __syncthreads();
    if ((w >> 2) == 0) sgu_groups<0, 3>(VCT, U, GC, OC, Wbf, spb, lng, lnb, tok0, gh, w & 3, r, hh, stat);
    else sgu_groups<1, 2>(VCT, U, GC, OC, Wbf, spb, lng, lnb, tok0, gh, w & 3, r, hh, stat);
    __syncthreads();
}

#ifndef X_ATT
#define X_ATT 0
#endif
#ifndef X_CONV
#define X_CONV 0
#endif
#ifndef X_SGU
#define X_SGU 0
#endif
struct Args { const float* in[14]; float* out; unsigned char* ws; int ph_lo, ph_hi; };
constexpr int NPH = 11;

__device__ __forceinline__ void phase_prologue(const Args& args, LAS unsigned char* lds) {
    const int tid = threadIdx.x, lane = tid & 63, wave = __builtin_amdgcn_readfirstlane(tid >> 6);
    const int G = gridDim.x, blk = blockIdx.x, gw = blk * 8 + wave, NGW = G * 8;
    unsigned char* ws = args.ws;
    LAS float* scr = (LAS float*)(lds + wave * 16384);
    constexpr int I_IN = (DM / 64) * (NIN / 32), I_BR = (DH / 64) * (DM / 32), I_OUT = (DM / 64) * (DM / 32);
    constexpr int PER_L = I_IN + 3 * I_BR + I_OUT;
    for (int it = gw; it < 2 * PER_L; it += NGW) {
        const int l = it / PER_L; int r = it - l * PER_L;
        if (r < I_IN) { transpose_item(args.in[2] + (size_t)l * DM * NIN, DM, NIN, (bf16_t*)(ws + WS_WIN + (size_t)l * 68 * MiB), scr, r, lane); continue; } r -= I_IN;
        if (r < 3 * I_BR) { const int br = r / I_BR; r -= br * I_BR; const float* src = (br == 0 ? args.in[9] : (br == 1 ? args.in[10] : args.in[11])) + (size_t)l * DH * DM;
            transpose_item(src, DH, DM, (bf16_t*)(ws + WS_WBR + (size_t)(l * 3 + br) * 4 * MiB), scr, r, lane); continue; } r -= 3 * I_BR;
        transpose_item(args.in[12] + (size_t)l * DM * DM, DM, DM, (bf16_t*)(ws + WS_WOUT + (size_t)l * 8 * MiB), scr, r, lane);
    }
    { bf16_t* wb = (bf16_t*)(ws + WS_SGUW); const float* sp_w = args.in[7];
      for (int e = blk * 512 + tid; e < 2 * 8 * 128 * 128; e += G * 512) { const int t = (e >> 7) & 127, s = e & 127; const unsigned p = pk2(sp_w[e], 0.f); wb[e] = (s <= t) ? (bf16_t)(p & 0xffffu) : (bf16_t)0; } }
    row_pass<false, true>(args.in[0], nullptr, nullptr, nullptr, args.in[1], (bf16_t*)(ws + WS_H), gw, NGW, lane);
}

template <int L> __device__ __forceinline__ void phase_in(const Args& args, LAS unsigned char* lds) {
    unsigned char* ws = args.ws;
    pg8::Gemm g{(const bf16_t*)(ws + WS_H), (const bf16_t*)(ws + WS_WIN + (size_t)L * 68 * MiB), MT, NIN, DM, 0, 0};
    pg8::TileOrder<1> S; S.init(MT, NIN, gridDim.x, blockIdx.x);
    pg8::EpiIn E{ws + WS_SEG, (bf16_t*)(ws + WS_GATES), (bf16_t*)(ws + WS_VT), (bf16_t*)(ws + WS_VCT)};
    pg8::gemm_phase<pg8::EpiIn, pg8::TileOrder<1>, true>(lds, g, S, E);
}

template <int L> __device__ __forceinline__ void phase_mix(const Args& args, LAS unsigned char* lds) {
    const int tid = threadIdx.x, lane = tid & 63, wave = __builtin_amdgcn_readfirstlane(tid >> 6);
    const int G = gridDim.x, blk = blockIdx.x;
    unsigned char* ws = args.ws;
    const bf16_t* segb = (const bf16_t*)(ws + WS_SEG);
    bf16_t* OA = (bf16_t*)(ws + WS_O);
    constexpr size_t SE = (size_t)MT * DH;
    LAS float* btab = (LAS float*)(lds + 8 * ATT_WAVE_LDS + wave * 1280);
    LAS unsigned char* wl = lds + wave * ATT_WAVE_LDS;
    int cur_h = -1;
    constexpr int XA = (L == 0 ? X_ATT : 0) * 1024, XC = (L == 0 ? X_CONV : 0) * 512, XS = (L == 0 ? X_SGU : 0) * 256;
    for (int uu = blk; uu < 1792 + XA + XC + XS; uu += G) {
        int u = uu;
        if (uu >= 1792) { const int x = uu - 1792; u = x < XA ? (x & 1023) : (x < XA + XC ? 1024 + ((x - XA) & 511) : 1536 + ((x - XA - XC) & 255)); }
        if (u < 1024) {
            const int hg = u & 3, b = (u >> 2) & 7, c = u >> 5;
            const int h = hg * 4 + (wave >> 1), half = wave & 1;
            if (h != cur_h) { const float* rb = args.in[3] + (size_t)(L * 16 + h) * NREL;
#pragma unroll
                for (int i = 0; i < 5; ++i) btab[i * 64 + lane] = rb[i * 64 + lane] * LOG2E;
                cur_h = h; }
            attn_item(segb, segb + SE, (const bf16_t*)(ws + WS_VT), segb + 3 * SE, OA, btab, wl, b, c, h, half, lane);
        } else if (u < 1536) {
            conv_unit(segb + 4 * SE, segb + 5 * SE, segb + 6 * SE, segb + 7 * SE, OA + SE, args.in[4] + (size_t)L * 3 * DH, u - 1024, tid);
        } else {
            const int su = u - 1536; const int gh = su & 1, n = (su >> 1) & 15, b = su >> 5;
            sgu_unit((const bf16_t*)(ws + WS_VCT), segb + 8 * SE, segb + 10 * SE, OA + 2 * SE, (const bf16_t*)(ws + WS_SGUW) + (size_t)L * 8 * 16384, args.in[8] + (size_t)L * 8 * 128,
                     args.in[5] + (size_t)L * DH, args.in[6] + (size_t)L * DH, b, n, gh, lds, tid);
        }
    }
}

template <int L> __device__ __forceinline__ void phase_br(const Args& args, LAS unsigned char* lds) {
    unsigned char* ws = args.ws;
    pg8::Gemm g{(const bf16_t*)(ws + WS_O), (const bf16_t*)(ws + WS_WBR + (size_t)L * 12 * MiB), MT, DM, DH, (size_t)32 * MiB, (size_t)4 * MiB};
    pg8::TileOrder<3> S; S.init(MT, DM, gridDim.x, blockIdx.x);
    pg8::EpiMerge E{(const bf16_t*)(ws + WS_GATES), (bf16_t*)(ws + WS_MERGED16)};
    pg8::gemm_phase<pg8::EpiMerge, pg8::TileOrder<3>, true>(lds, g, S, E);
}

template <int L> __device__ __forceinline__ void phase_out(const Args& args, LAS unsigned char* lds) {
    unsigned char* ws = args.ws;
    pg8::Gemm g{(const bf16_t*)(ws + WS_MERGED16), (const bf16_t*)(ws + WS_WOUT + (size_t)L * 8 * MiB), MT, DM, DM, 0, 0};
    pg8::TileOrder<1> S; S.init(MT, DM, gridDim.x, blockIdx.x);
    pg8::EpiPlain E{(bf16_t*)(ws + WS_Y), DM};
    pg8::gemm_phase<pg8::EpiPlain, pg8::TileOrder<1>, true>(lds, g, S, E);
}

template <int L> __device__ __forceinline__ void phase_row(const Args& args) {
    const int tid = threadIdx.x, lane = tid & 63, wave = __builtin_amdgcn_readfirstlane(tid >> 6);
    const int gw = blockIdx.x * 8 + wave, NGW = gridDim.x * 8;
    unsigned char* ws = args.ws;
    if (L == 0) row_pass<true, true>(args.in[0], (const bf16_t*)(ws + WS_Y), args.in[13], args.out, args.in[1] + DM, (bf16_t*)(ws + WS_H), gw, NGW, lane);
    else row_pass<true, false>(args.out, (const bf16_t*)(ws + WS_Y), args.in[13] + DM, args.out, nullptr, nullptr, gw, NGW, lane);
}

__global__ void __launch_bounds__(512, 2) mk_fwd(const Args args) {
    extern __shared__ __attribute__((aligned(16))) unsigned char lds_raw[];
    LAS unsigned char* lds = (LAS unsigned char*)lds_raw;
    const int lo = args.ph_lo, hi = args.ph_hi;
#define IN(k) (lo <= (k) && (k) < hi)
#define SEAM(k) do { if (IN((k) + 1)) cg::this_grid().sync(); } while (0)
#ifndef REP_PRO
#define REP_PRO 1
#endif
#ifndef REP_IN
#define REP_IN 1
#endif
#ifndef REP_MIX
#define REP_MIX 1
#endif
#ifndef REP_BR
#define REP_BR 1
#endif
#ifndef REP_OUT
#define REP_OUT 1
#endif
#ifndef REP_ROW
#define REP_ROW 1
#endif
#ifndef REP_SYNC
#define REP_SYNC 0
#endif
    if (IN(0)) { for (int rep = 0; rep < REP_PRO; ++rep) phase_prologue(args, lds); SEAM(0); for (int rep = 0; rep < REP_SYNC; ++rep) cg::this_grid().sync(); }
    if (IN(1)) { for (int rep = 0; rep < REP_IN; ++rep) phase_in<0>(args, lds); SEAM(1); }
    if (IN(2)) { for (int rep = 0; rep < REP_MIX; ++rep) phase_mix<0>(args, lds); SEAM(2); }
    if (IN(3)) { for (int rep = 0; rep < REP_BR; ++rep) phase_br<0>(args, lds); SEAM(3); }
    if (IN(4)) { for (int rep = 0; rep < REP_OUT; ++rep) phase_out<0>(args, lds); SEAM(4); }
    if (IN(5)) { for (int rep = 0; rep < REP_ROW; ++rep) phase_row<0>(args); SEAM(5); }
    if (IN(6)) { phase_in<1>(args, lds); SEAM(6); }
    if (IN(7)) { phase_mix<1>(args, lds); SEAM(7); }
    if (IN(8)) { phase_br<1>(args, lds); SEAM(8); }
    if (IN(9)) { phase_out<1>(args, lds); SEAM(9); }
    if (IN(10)) { phase_row<1>(args); }
#undef IN
#undef SEAM
}

extern "C" void kernel_launch(void* const* d_in, const int* in_sizes, int n_in, void* d_out, int out_size, void* d_ws, size_t ws_size, hipStream_t stream) {
    static int grid = 0;
    if (grid == 0) {
        if (n_in != 14 || out_size != MT * DM || ws_size < WS_END) { fprintf(stderr, "kernel_launch: unexpected shapes (n_in %d out %d ws %zu)\n", n_in, out_size, ws_size); grid = -1; return; }
        int dev = 0, cus = 0, per_cu = 0;
        hipGetDevice(&dev);
        hipDeviceGetAttribute(&cus, hipDeviceAttributeMultiprocessorCount, dev);
        if (hipFuncSetAttribute((const void*)mk_fwd, hipFuncAttributeMaxDynamicSharedMemorySize, LDS_BYTES) != hipSuccess) { fprintf(stderr, "kernel_launch: hipFuncSetAttribute failed\n"); grid = -1; return; }
        if (hipOccupancyMaxActiveBlocksPerMultiprocessor(&per_cu, (const void*)mk_fwd, 512, LDS_BYTES) != hipSuccess || per_cu < 1) { fprintf(stderr, "kernel_launch: occupancy query says %d\n", per_cu); per_cu = 1; }
        (void)hipGetLastError();
        grid = cus * 1;
    }
    if (grid < 0) return;
    Args a{};
    for (int i = 0; i < 14; ++i) a.in[i] = (const float*)d_in[i];
    a.out = (float*)d_out; a.ws = (unsigned char*)d_ws;
#if MK_N_LAUNCHES == 1
    a.ph_lo = 0; a.ph_hi = NPH;
    void* kargs[] = {&a};
    hipError_t e = hipLaunchCooperativeKernel((const void*)mk_fwd, dim3(grid), dim3(512), kargs, LDS_BYTES, stream);
    if (e != hipSuccess) fprintf(stderr, "cooperative launch failed: %s (grid %d)\n", hipGetErrorString(e), grid);
#else
    for (int p = 0; p < NPH; ++p) { a.ph_lo = p; a.ph_hi = p + 1; hipLaunchKernelGGL(mk_fwd, dim3(grid), dim3(512), LDS_BYTES, stream, a); }
#endif
}
```

```cpp
#include <hip/hip_runtime.h>
#include <hip/hip_cooperative_groups.h>
#include <cstdio>
#include <cstdint>
namespace cg = cooperative_groups;

#define LAS __attribute__((address_space(3)))
typedef unsigned short bf16_t;
typedef short bf16x8 __attribute__((ext_vector_type(8)));
typedef float f32x4 __attribute__((ext_vector_type(4)));
typedef float f32x2 __attribute__((ext_vector_type(2)));
typedef float f32x16 __attribute__((ext_vector_type(16)));
typedef unsigned u32x4 __attribute__((ext_vector_type(4)));
typedef unsigned u32x2 __attribute__((ext_vector_type(2)));
typedef __bf16 bf16x2_t __attribute__((ext_vector_type(2)));

#ifndef MK_N_LAUNCHES
#define MK_N_LAUNCHES 1
#endif

constexpr int MT = 16384;
constexpr int SEQ = 2048;
constexpr int DM = 2048;
constexpr int NIN = 17408;
constexpr int DH = 1024;
constexpr int NREL = 320;
constexpr int PT = MT + 64;
constexpr float LOG2E = 1.4426950408889634f;
constexpr float QSCALE = 0.125f * LOG2E;
constexpr float EPSN = 1e-6f;

constexpr size_t MiB = 1u << 20;
constexpr size_t WS_WIN = 2 * MiB;
constexpr size_t WS_WBR = 138 * MiB;
constexpr size_t WS_WOUT = 162 * MiB;
constexpr size_t WS_H = 178 * MiB;
constexpr size_t WS_SEG = 242 * MiB;
constexpr size_t WS_GATES = 594 * MiB;
constexpr size_t WS_O = 786 * MiB;
constexpr size_t WS_SGUW = 882 * MiB;
constexpr size_t WS_VT = 884 * MiB;
constexpr size_t WS_VCT = 918 * MiB;
constexpr size_t WS_END = 952 * MiB;
constexpr size_t SEGB = 32 * MiB;
constexpr size_t WS_MERGED32 = WS_SEG;
constexpr size_t WS_MERGED16 = WS_SEG + 4 * SEGB;
constexpr size_t WS_Y = WS_SEG + 6 * SEGB;

constexpr int LDS_BYTES = 163840;

__device__ __forceinline__ unsigned pk2(float lo, float hi) { f32x2 v = {lo, hi}; bf16x2_t b = __builtin_convertvector(v, bf16x2_t); return __builtin_bit_cast(unsigned, b); }
__device__ __forceinline__ float bflo(unsigned u) { return __uint_as_float(u << 16); }
__device__ __forceinline__ float bfhi(unsigned u) { return __uint_as_float(u & 0xffff0000u); }
__device__ __forceinline__ float fast_sigmoid(float w) { return __builtin_amdgcn_rcpf(1.0f + __builtin_amdgcn_exp2f(-w * LOG2E)); }
__device__ __forceinline__ float wave_sum(float v) {
#pragma unroll
    for (int o = 1; o < 64; o <<= 1) v += __shfl_xor(v, o);
    return v;
}
#define MFMA32(a, b, c) __builtin_amdgcn_mfma_f32_32x32x16_bf16((a), (b), (c), 0, 0, 0)

namespace pg8 {
constexpr int BM = 256, BK = 64, HALF = 128, HTB = HALF * BK * 2, STAGE_BYTES = 8 * HTB, NXCD = 8, WGM = 8;
__device__ __forceinline__ int lds_byte(int r, int c) { const int st = (r >> 4) * 2 + (c >> 5), rr = r & 15, cc = c & 31, ob = rr * 64 + cc * 2; return st * 1024 + (ob ^ (((ob >> 9) & 1) << 5)); }
__device__ __forceinline__ void stage_rc(int b, int& R, int& C) { const int st = b / 1024, sb = b % 1024, swz = sb ^ (((sb >> 9) & 1) << 5); R = (st >> 1) * 16 + swz / 64; C = (st & 1) * 32 + (swz % 64) / 2; }
__device__ __forceinline__ int perm32(int rho) { const int n = rho >> 4, i = rho & 15; return 8 * (i >> 2) + 4 * n + (i & 3); }

struct Unit { int pm, pn, z; };
struct Gemm { const bf16_t* A; const bf16_t* Bt; int M, N, K; size_t zA, zB; };

template <int NZ> struct TileOrder {
    int nM, nN, nwg, G, c;
    __device__ void init(int M, int N, int G_, int c_) { nM = M / BM; nN = N / BM; nwg = nM * nN; G = G_; c = c_; }
    __device__ bool next(int i, Unit& u) const {
        const int ti = i / NZ; u.z = i - ti * NZ;
        const long L = (long)ti * G + c; if (L >= nwg) return false;
        int wgid = (int)L; { const int q = nwg / NXCD, r = nwg % NXCD, xcd = wgid % NXCD, off = wgid / NXCD; wgid = (xcd < r ? xcd * (q + 1) : r * (q + 1) + (xcd - r) * q) + off; }
        const int nig = WGM * nN, gid = wgid / nig, fm = gid * WGM, gsz = (nM - fm) < WGM ? (nM - fm) : WGM;
        u.pm = fm + ((wgid % nig) % gsz); u.pn = (wgid % nig) / gsz; return true;
    }
};


template <int MODE> __device__ __forceinline__ f32x2 act2(f32x2 v, float sc) {
    if constexpr (MODE == 0) return v * sc;
    f32x2 t;
    if constexpr (MODE == 2) { const f32x2 x2 = v * v; t = v * (x2 * (-0.10294325f) + (-2.3022082f)); }
    else t = v * (-LOG2E);
    if constexpr (MODE == 3) { t.x = fminf(t.x, 20.f); t.y = fminf(t.y, 20.f); }
    f32x2 d; d.x = __builtin_amdgcn_exp2f(t.x); d.y = __builtin_amdgcn_exp2f(t.y);
    d = d + 1.0f;
    f32x2 r; r.x = __builtin_amdgcn_rcpf(d.x); r.y = __builtin_amdgcn_rcpf(d.y);
    if constexpr (MODE == 3) return r;
    return v * r;
}
template <int MODE, bool TR>
__device__ __forceinline__ void epi_in_tile(const f32x4 (&acc)[2][2][4][2], bf16_t* __restrict__ base, int ldc, int row0, int col0, float sc) {
#pragma unroll
    for (int ai = 0; ai < 2; ++ai)
#pragma unroll
        for (int m = 0; m < 4; ++m) {
            const int row = row0 + ai * HALF + m * 16;
#pragma unroll
            for (int bj = 0; bj < 2; ++bj) {
                const f32x4 a0 = acc[ai][bj][m][0], a1 = acc[ai][bj][m][1];
                const f32x2 p0 = act2<MODE>((f32x2){a0[0], a0[1]}, sc), p1 = act2<MODE>((f32x2){a0[2], a0[3]}, sc);
                const f32x2 p2 = act2<MODE>((f32x2){a1[0], a1[1]}, sc), p3 = act2<MODE>((f32x2){a1[2], a1[3]}, sc);
                u32x4 w; w.x = pk2(p0.x, p0.y); w.y = pk2(p1.x, p1.y); w.z = pk2(p2.x, p2.y); w.w = pk2(p3.x, p3.y);
                if constexpr (!TR) {
                    *(u32x4*)(base + (size_t)row * ldc + col0 + bj * HALF) = w;
                } else {
                    bf16_t* tp = base + (size_t)(col0 + bj * HALF) * PT + row;
                    tp[0 * (size_t)PT] = (bf16_t)(w.x & 0xffffu); tp[1 * (size_t)PT] = (bf16_t)(w.x >> 16);
                    tp[2 * (size_t)PT] = (bf16_t)(w.y & 0xffffu); tp[3 * (size_t)PT] = (bf16_t)(w.y >> 16);
                    tp[4 * (size_t)PT] = (bf16_t)(w.z & 0xffffu); tp[5 * (size_t)PT] = (bf16_t)(w.z >> 16);
                    tp[6 * (size_t)PT] = (bf16_t)(w.w & 0xffffu); tp[7 * (size_t)PT] = (bf16_t)(w.w >> 16);
                }
            }
        }
}
struct EpiIn {
    static constexpr bool PERM = true;
    unsigned char* seg;
    bf16_t* gates;
    bf16_t* vt; bf16_t* vct;
    __device__ __forceinline__ bool reset(const Unit&) const { return true; }
    __device__ __forceinline__ void operator()(const f32x4 (&acc)[2][2][4][2], const Unit& u, int wr, int wc, int fr, int fq) const {
        const int colt = u.pn * BM;
        const int row0 = u.pm * BM + wr * 64 + fr;
        const int lc = wc * 32 + 8 * fq;
        if (colt >= 11 * DH) { epi_in_tile<3, false>(acc, gates, 3 * DM, row0, colt - 11 * DH + lc, 1.f); return; }
        const int s = colt >> 10; const int col0 = (colt & 1023) + lc;
        bf16_t* base = (bf16_t*)(seg + (size_t)s * SEGB);
        if (s == 3 || s == 7 || s == 10) epi_in_tile<1, false>(acc, base, DH, row0, col0, 1.f);
        else if (s == 8) epi_in_tile<2, false>(acc, base, DH, row0, col0, 1.f);
        else if (s == 9) epi_in_tile<2, true>(acc, vct, 0, row0, col0, 1.f);
        else if (s == 2) epi_in_tile<0, true>(acc, vt, 0, row0, col0, 1.f);
        else epi_in_tile<0, false>(acc, base, DH, row0, col0, s == 0 ? QSCALE : 1.f);
    }
};

struct EpiPlain {
    static constexpr bool PERM = true;
    bf16_t* O; int ldc;
    __device__ __forceinline__ bool reset(const Unit&) const { return true; }
    __device__ __forceinline__ void operator()(const f32x4 (&acc)[2][2][4][2], const Unit& u, int wr, int wc, int fr, int fq) const {
        const int row0 = u.pm * BM + wr * 64 + fr, col0 = u.pn * BM + wc * 32 + 8 * fq;
#pragma unroll
        for (int ai = 0; ai < 2; ++ai)
#pragma unroll
            for (int m = 0; m < 4; ++m) { bf16_t* rowp = O + (size_t)(row0 + ai * HALF + m * 16) * ldc + col0;
#pragma unroll
                for (int bj = 0; bj < 2; ++bj) { const f32x4 v0 = acc[ai][bj][m][0], v1 = acc[ai][bj][m][1];
                    u32x4 w; w.x = pk2(v0[0], v0[1]); w.y = pk2(v0[2], v0[3]); w.z = pk2(v1[0], v1[1]); w.w = pk2(v1[2], v1[3]);
                    *(u32x4*)(rowp + bj * HALF) = w; } }
    }
};

struct EpiMerge {
    static constexpr bool PERM = true;
    const bf16_t* __restrict__ gates; bf16_t* __restrict__ out;
    __device__ __forceinline__ bool reset(const Unit& u) const { return u.z == 2; }
    __device__ __forceinline__ void operator()(f32x4 (&acc)[2][2][4][2], const Unit& u, int wr, int wc, int fr, int fq) const {
        const int row0 = u.pm * BM + wr * 64 + fr, col0 = u.pn * BM + wc * 32 + 8 * fq;
        const int z = u.z;
        const bf16_t* gz = gates + (size_t)row0 * (3 * DM) + z * DM + col0;
        if (z < 2) {
#pragma unroll
            for (int ai = 0; ai < 2; ++ai) {
                u32x4 gn[4][2], gd[4][2];
#pragma unroll
                for (int m = 0; m < 4; ++m)
#pragma unroll
                    for (int bj = 0; bj < 2; ++bj) { const bf16_t* p = gz + (size_t)(ai * HALF + m * 16) * (3 * DM) + bj * HALF; gn[m][bj] = *(const u32x4*)p; gd[m][bj] = *(const u32x4*)(p + DM); }
#pragma unroll
                for (int m = 0; m < 4; ++m)
#pragma unroll
                    for (int bj = 0; bj < 2; ++bj) {
                        const u32x4 a = gn[m][bj], d = gd[m][bj];
                        f32x4& v0 = acc[ai][bj][m][0]; f32x4& v1 = acc[ai][bj][m][1];
                        v0[0] *= bflo(a.x) * __builtin_amdgcn_rcpf(bflo(d.x)); v0[1] *= bfhi(a.x) * __builtin_amdgcn_rcpf(bfhi(d.x));
                        v0[2] *= bflo(a.y) * __builtin_amdgcn_rcpf(bflo(d.y)); v0[3] *= bfhi(a.y) * __builtin_amdgcn_rcpf(bfhi(d.y));
                        v1[0] *= bflo(a.z) * __builtin_amdgcn_rcpf(bflo(d.z)); v1[1] *= bfhi(a.z) * __builtin_amdgcn_rcpf(bfhi(d.z));
                        v1[2] *= bflo(a.w) * __builtin_amdgcn_rcpf(bflo(d.w)); v1[3] *= bfhi(a.w) * __builtin_amdgcn_rcpf(bfhi(d.w));
                    }
            }
        } else {
#pragma unroll
            for (int ai = 0; ai < 2; ++ai) {
                u32x4 gn[4][2];
#pragma unroll
                for (int m = 0; m < 4; ++m)
#pragma unroll
                    for (int bj = 0; bj < 2; ++bj) gn[m][bj] = *(const u32x4*)(gz + (size_t)(ai * HALF + m * 16) * (3 * DM) + bj * HALF);
#pragma unroll
                for (int m = 0; m < 4; ++m)
#pragma unroll
                    for (int bj = 0; bj < 2; ++bj) {
                        const u32x4 a = gn[m][bj];
                        const f32x4 v0 = acc[ai][bj][m][0], v1 = acc[ai][bj][m][1];
                        u32x4 w; w.x = pk2(v0[0] * bflo(a.x), v0[1] * bfhi(a.x)); w.y = pk2(v0[2] * bflo(a.y), v0[3] * bfhi(a.y));
                        w.z = pk2(v1[0] * bflo(a.z), v1[1] * bfhi(a.z)); w.w = pk2(v1[2] * bflo(a.w), v1[3] * bfhi(a.w));
                        *(u32x4*)(out + (size_t)(row0 + ai * HALF + m * 16) * DM + col0 + bj * HALF) = w;
                    }
            }
        }
    }
};

template <class Epi, class Sched, bool ALIGN_EPI>
__device__ __forceinline__ void gemm_phase(LAS unsigned char* lds, const Gemm g, const Sched& S, const Epi& E) {
    const int tid = threadIdx.x, wid = __builtin_amdgcn_readfirstlane(tid >> 6), lane = tid & 63, wr = wid >> 2, wc = wid & 3, fr = lane & 15, fq = lane >> 4;
    const int K = g.K, nt = K / BK;
    unsigned voffA[2], voffB[2];
#pragma unroll
    for (int i = 0; i < 2; ++i) { int R, C; stage_rc(tid * 16 + i * 8192, R, C); const int Rb = Epi::PERM ? ((R & ~31) + perm32(R & 31)) : R;
        voffA[i] = (unsigned)(R * K + C) * 2u; voffB[i] = (unsigned)(Rb * K + C) * 2u; }
    const size_t kstep = (size_t)(BK * 2);
    const size_t hstep = (size_t)HALF * K * 2;
    const size_t tstep = 2 * hstep;
    const unsigned ldsw = (unsigned)wid * 1024u;
    const int aoff = lds_byte(wr * 64 + fr, fq * 8), boff = lds_byte(wc * 32 + fr, fq * 8);
#define PG8_SA(b, h) (((b) * 2 + (h)) * HTB)
#define PG8_SB(b, h) ((4 + (b) * 2 + (h)) * HTB)
#define PG8_STAGE(bufoff, gbase, voff) do { _Pragma("unroll") for (int _i = 0; _i < 2; ++_i) \
        __builtin_amdgcn_global_load_lds((const unsigned*)((const char*)(gbase) + (voff)[_i]), (LAS unsigned*)(lds + (bufoff) + ldsw + _i * 8192), 16, 0, 0); } while (0)
#define PG8_LDA(dst, b, h) do { _Pragma("unroll") for (int m = 0; m < 4; ++m) _Pragma("unroll") for (int k = 0; k < 2; ++k) dst[m][k] = *(const LAS bf16x8*)(lds + PG8_SA(b, h) + aoff + m * 2048 + k * 1024); } while (0)
#define PG8_LDB(dst, b, h) do { _Pragma("unroll") for (int n = 0; n < 2; ++n) _Pragma("unroll") for (int k = 0; k < 2; ++k) dst[n][k] = *(const LAS bf16x8*)(lds + PG8_SB(b, h) + boff + n * 2048 + k * 1024); } while (0)
#define PG8_MMA(ai, bj, At, Bt) do { __builtin_amdgcn_s_setprio(1); _Pragma("unroll") for (int m = 0; m < 4; ++m) _Pragma("unroll") for (int n = 0; n < 2; ++n) _Pragma("unroll") for (int k = 0; k < 2; ++k) \
        acc[ai][bj][m][n] = __builtin_amdgcn_mfma_f32_16x16x32_bf16(Bt[n][k], At[m][k], acc[ai][bj][m][n], 0, 0, 0); __builtin_amdgcn_s_setprio(0); } while (0)
#define PG8_WAIT_V(n) asm volatile("s_waitcnt vmcnt(" #n ")" ::: "memory")
#define PG8_WAIT_L(n) asm volatile("s_waitcnt lgkmcnt(" #n ")" ::: "memory")
#define PG8_BAR __builtin_amdgcn_s_barrier()
#define PG8_SCHED __builtin_amdgcn_sched_barrier(0)
    Unit cur, nxt; int ui = 0;
    if (!S.next(0, cur)) return;
    f32x4 acc[2][2][4][2];
#pragma unroll
    for (int a = 0; a < 2; ++a)
#pragma unroll
        for (int b = 0; b < 2; ++b)
#pragma unroll
            for (int m = 0; m < 4; ++m)
#pragma unroll
                for (int n = 0; n < 2; ++n) acc[a][b][m][n] = (f32x4){0.f, 0.f, 0.f, 0.f};
    bf16x8 At[4][2], B0[2][2], B1[2][2];
    const char* cA = (const char*)g.A + (size_t)cur.z * g.zA + (size_t)cur.pm * tstep; const char* cB = (const char*)g.Bt + (size_t)cur.z * g.zB + (size_t)cur.pn * tstep;
    PG8_STAGE(PG8_SB(0, 0), cB, voffB); PG8_STAGE(PG8_SB(0, 1), cB + hstep, voffB); PG8_STAGE(PG8_SA(0, 0), cA, voffA); PG8_STAGE(PG8_SA(0, 1), cA + hstep, voffA);
    if (wr == 1) PG8_BAR;
    PG8_WAIT_V(2); PG8_BAR;
    PG8_STAGE(PG8_SB(1, 0), cB + kstep, voffB); PG8_STAGE(PG8_SA(1, 0), cA + kstep, voffA); PG8_STAGE(PG8_SB(1, 1), cB + hstep + kstep, voffB);
    PG8_WAIT_V(6); PG8_BAR;
    for (;;) {
        const bool has_next = S.next(ui + 1, nxt);
        const char* nA = has_next ? (const char*)g.A + (size_t)nxt.z * g.zA + (size_t)nxt.pm * tstep : cA;
        const char* nB = has_next ? (const char*)g.Bt + (size_t)nxt.z * g.zB + (size_t)nxt.pn * tstep : cB;
        for (int t = 0; t < nt; t += 2) {
            const bool last = (t == nt - 2);
            const char* a1 = cA + (size_t)(t + 1) * kstep;
            const char* a2 = last ? nA : cA + (size_t)(t + 2) * kstep; const char* b2 = last ? nB : cB + (size_t)(t + 2) * kstep;
            const char* a3 = a2 + kstep; const char* b3 = b2 + kstep;
            PG8_LDB(B0, 0, 0); PG8_LDB(B1, 0, 1); PG8_SCHED; PG8_LDA(At, 0, 0); PG8_STAGE(PG8_SA(1, 1), a1 + hstep, voffA);
            PG8_WAIT_V(8); PG8_WAIT_L(0); PG8_BAR; PG8_MMA(0, 0, At, B0); PG8_MMA(0, 1, At, B1); PG8_BAR; PG8_SCHED;
            PG8_LDA(At, 0, 1); PG8_STAGE(PG8_SB(0, 0), b2, voffB); PG8_STAGE(PG8_SB(0, 1), b2 + hstep, voffB); PG8_STAGE(PG8_SA(0, 0), a2, voffA);
            PG8_WAIT_V(8); PG8_WAIT_L(0); PG8_BAR; PG8_MMA(1, 0, At, B0); PG8_MMA(1, 1, At, B1); PG8_BAR; PG8_SCHED;
            PG8_LDB(B0, 1, 0); PG8_LDB(B1, 1, 1); PG8_SCHED; PG8_LDA(At, 1, 0); PG8_STAGE(PG8_SA(0, 1), a2 + hstep, voffA);
            PG8_WAIT_V(8); PG8_WAIT_L(0); PG8_BAR; PG8_MMA(0, 0, At, B0); PG8_MMA(0, 1, At, B1); PG8_BAR; PG8_SCHED;
            PG8_LDA(At, 1, 1); PG8_STAGE(PG8_SB(1, 0), b3, voffB); PG8_STAGE(PG8_SB(1, 1), b3 + hstep, voffB); PG8_STAGE(PG8_SA(1, 0), a3, voffA);
            PG8_WAIT_V(8); PG8_WAIT_L(0); PG8_BAR; PG8_MMA(1, 0, At, B0); PG8_MMA(1, 1, At, B1); PG8_BAR; PG8_SCHED;
        }
        if constexpr (ALIGN_EPI) { if (wr == 0) PG8_BAR; }
        E(acc, cur, wr, wc, fr, fq);
        if (!has_next) break;
        if (E.reset(cur)) {
#pragma unroll
        for (int a = 0; a < 2; ++a)
#pragma unroll
            for (int b = 0; b < 2; ++b)
#pragma unroll
                for (int m = 0; m < 4; ++m)
#pragma unroll
                    for (int n = 0; n < 2; ++n) acc[a][b][m][n] = (f32x4){0.f, 0.f, 0.f, 0.f};
        }
        cur = nxt; cA = nA; cB = nB; ++ui;
        if constexpr (ALIGN_EPI) { if (wr == 1) PG8_BAR; }
    }
    PG8_WAIT_V(0);
    if constexpr (!ALIGN_EPI) { if (wr == 0) PG8_BAR; }
    PG8_BAR;
#undef PG8_SA
#undef PG8_SB
#undef PG8_STAGE
#undef PG8_LDA
#undef PG8_LDB
#undef PG8_MMA
#undef PG8_WAIT_V
#undef PG8_WAIT_L
#undef PG8_BAR
#undef PG8_SCHED
}
}

#define GAS __attribute__((address_space(1)))
#define RLX_AGENT __ATOMIC_RELAXED, __HIP_MEMORY_SCOPE_AGENT
#define XB_TMO      128
#define XB_XCNT(j)  (256  + 64 * (j))
#define XB_XSUB(j)  (1280 + 64 * (j))
#define XB_XGEN(j)  (2304 + 64 * (j))
#define XB_TOP      3328
#define XB_TOPGEN   3392
#define XCD_BAR_WORDS 3456
#define XB_SPIN_CAP (1u << 18)

__device__ __forceinline__ unsigned xb_ld(unsigned* p)              { return __hip_atomic_load(p, __ATOMIC_RELAXED, __HIP_MEMORY_SCOPE_AGENT); }
__device__ __forceinline__ unsigned xb_add(unsigned* p, unsigned v) { return __hip_atomic_fetch_add(p, v, __ATOMIC_RELAXED, __HIP_MEMORY_SCOPE_AGENT); }
__device__ __forceinline__ unsigned xb_xcc_id() { return (unsigned)__builtin_amdgcn_s_getreg((3 << 11) | 20) & 0xFu; }
#define XB_SPIN(cond, bar) do { unsigned _sp = 0; while (cond) { __builtin_amdgcn_s_sleep(1); \
    if ((++_sp & 255u) == 0u) { if (xb_ld(&(bar)[XB_TMO])) break; if (_sp > XB_SPIN_CAP) { atomicAdd(&(bar)[XB_TMO], 1u); break; } } } } while (0)

struct XcdBarrier {
    unsigned* bar; unsigned x;
    volatile LAS unsigned* st;
};

__device__ __forceinline__ XcdBarrier xcd_barrier_post(unsigned* bar, volatile LAS unsigned* st) {
    XcdBarrier b; b.bar = bar; b.x = xb_xcc_id(); b.st = st;
    if (threadIdx.x == 0) (void)xb_add(&bar[XB_XCNT(b.x)], 1u);
    return b;
}
__device__ __forceinline__ void xcd_barrier_complete(unsigned* bar, unsigned x, unsigned& nloc, unsigned& nx) {
    const unsigned G = gridDim.x * gridDim.y * gridDim.z;
    unsigned sum, cnt, mine, sp = 0u;
    for (;;) {
        sum = 0u; cnt = 0u; mine = 0u;
#pragma unroll
        for (unsigned j = 0; j < 16; ++j) { const unsigned c = xb_ld(&bar[XB_XCNT(j)]); sum += c; cnt += (c > 0u) ? 1u : 0u; mine = (j == x) ? c : mine; }
        if (sum == G) break;
        __builtin_amdgcn_s_sleep(1);
        if ((++sp & 255u) == 0u) { if (xb_ld(&bar[XB_TMO])) break; if (sp > XB_SPIN_CAP) { atomicAdd(&bar[XB_TMO], 1u); break; } }
    }
    nloc = mine > 0u ? mine : 1u; nx = cnt > 0u ? cnt : 1u;
}

__device__ __forceinline__ void xcd_barrier(const XcdBarrier& b) {
    asm volatile("s_waitcnt vmcnt(0)" ::: "memory");
    __syncthreads();
    if (threadIdx.x == 0) {
        unsigned* bar = b.bar;
        __builtin_amdgcn_s_waitcnt(0);
        unsigned nloc = b.st[0], nx = b.st[1];
        if (nloc == 0u) { xcd_barrier_complete(bar, b.x, nloc, nx); b.st[0] = nloc; b.st[1] = nx; }
        const unsigned old = xb_add(&bar[XB_XSUB(b.x)], 1u);
        const unsigned gen = old / nloc;
        if (old + 1u == (gen + 1u) * nloc) {
            __builtin_amdgcn_fence(__ATOMIC_RELEASE, "agent");
            asm volatile("s_waitcnt vmcnt(0)" ::: "memory");
            const unsigned og = xb_add(&bar[XB_TOP], 1u);
            const unsigned tg = og / nx;
            if (og + 1u == (tg + 1u) * nx) xb_add(&bar[XB_TOPGEN], 1u);
            else XB_SPIN(xb_ld(&bar[XB_TOPGEN]) == tg, bar);
            __builtin_amdgcn_fence(__ATOMIC_ACQUIRE, "agent");
            xb_add(&bar[XB_XGEN(b.x)], 1u);
            asm volatile("s_waitcnt vmcnt(0)" ::: "memory");
        } else {
            XB_SPIN(xb_ld(&bar[XB_XGEN(b.x)]) == gen, bar);
            __builtin_amdgcn_fence(__ATOMIC_ACQUIRE, "agent");
            asm volatile("s_waitcnt vmcnt(0)" ::: "memory");
        }
    }
    __syncthreads();
}

__device__ __forceinline__ void transpose_item(const float* __restrict__ W, int K, int N, bf16_t* __restrict__ WT, LAS float* scr, int item, int lane) {
    const int nblk = N / 32, kb = item / nblk, nb = item - kb * nblk, k0 = 64 * kb, n0 = 32 * nb;
    float tv[32];
#pragma unroll
    for (int i = 0; i < 32; ++i) { const int kk = 2 * i + (lane >> 5); tv[i] = W[(size_t)(k0 + kk) * N + n0 + (lane & 31)]; }
#pragma unroll
    for (int i = 0; i < 32; ++i) { const int kk = 2 * i + (lane >> 5); scr[kk * 33 + (lane & 31)] = tv[i]; }
    asm volatile("s_waitcnt lgkmcnt(0)" ::: "memory");
    const int c = lane & 7;
#pragma unroll
    for (int j = 0; j < 4; ++j) { const int n = (lane >> 3) + 8 * j; const LAS float* s = scr + (8 * c) * 33 + n;
        u32x4 o; o.x = pk2(s[0 * 33], s[1 * 33]); o.y = pk2(s[2 * 33], s[3 * 33]); o.z = pk2(s[4 * 33], s[5 * 33]); o.w = pk2(s[6 * 33], s[7 * 33]);
        *(u32x4*)(WT + (size_t)(n0 + n) * K + k0 + 8 * c) = o; }
    asm volatile("s_waitcnt lgkmcnt(0)" ::: "memory");
}

template <bool HAS_Y, bool WRITE_H>
__device__ __forceinline__ void row_pass(const float* __restrict__ xin, const bf16_t* __restrict__ Y, const float* __restrict__ post_g, float* xout,
                                         const float* __restrict__ pre_g, bf16_t* __restrict__ H, int gw, int NGW, int lane) {
    for (int row = gw; row < MT; row += NGW) {
        float xv[4][8];
#pragma unroll
        for (int j = 0; j < 4; ++j) { const int col = (j * 64 + lane) * 8; const f32x4 a = *(const f32x4*)(xin + (size_t)row * DM + col), b = *(const f32x4*)(xin + (size_t)row * DM + col + 4);
#pragma unroll
            for (int e = 0; e < 4; ++e) { xv[j][e] = a[e]; xv[j][4 + e] = b[e]; } }
        if constexpr (HAS_Y) {
            float yv[4][8]; float ss = 0.f;
#pragma unroll
            for (int j = 0; j < 4; ++j) { const int col = (j * 64 + lane) * 8; const u32x4 w = *(const u32x4*)(Y + (size_t)row * DM + col);
                yv[j][0] = bflo(w.x); yv[j][1] = bfhi(w.x); yv[j][2] = bflo(w.y); yv[j][3] = bfhi(w.y); yv[j][4] = bflo(w.z); yv[j][5] = bfhi(w.z); yv[j][6] = bflo(w.w); yv[j][7] = bfhi(w.w);
#pragma unroll
                for (int e = 0; e < 8; ++e) ss += yv[j][e] * yv[j][e]; }
            const float r = 1.0f / sqrtf(wave_sum(ss) * (1.0f / DM) + EPSN);
#pragma unroll
            for (int j = 0; j < 4; ++j) { const int col = (j * 64 + lane) * 8; const f32x4 ga = *(const f32x4*)(post_g + col), gb = *(const f32x4*)(post_g + col + 4);
#pragma unroll
                for (int e = 0; e < 4; ++e) { xv[j][e] += yv[j][e] * r * ga[e]; xv[j][4 + e] += yv[j][4 + e] * r * gb[e]; }
                *(f32x4*)(xout + (size_t)row * DM + col) = (f32x4){xv[j][0], xv[j][1], xv[j][2], xv[j][3]};
                *(f32x4*)(xout + (size_t)row * DM + col + 4) = (f32x4){xv[j][4], xv[j][5], xv[j][6], xv[j][7]}; }
        }
        if constexpr (WRITE_H) {
            float ss = 0.f;
#pragma unroll
            for (int j = 0; j < 4; ++j)
#pragma unroll
                for (int e = 0; e < 8; ++e) ss += xv[j][e] * xv[j][e];
            const float r = 1.0f / sqrtf(wave_sum(ss) * (1.0f / DM) + EPSN);
#pragma unroll
            for (int j = 0; j < 4; ++j) { const int col = (j * 64 + lane) * 8; const f32x4 ga = *(const f32x4*)(pre_g + col), gb = *(const f32x4*)(pre_g + col + 4);
                u32x4 w; w.x = pk2(xv[j][0] * r * ga[0], xv[j][1] * r * ga[1]); w.y = pk2(xv[j][2] * r * ga[2], xv[j][3] * r * ga[3]);
                w.z = pk2(xv[j][4] * r * gb[0], xv[j][5] * r * gb[1]); w.w = pk2(xv[j][6] * r * gb[2], xv[j][7] * r * gb[3]);
                *(u32x4*)(H + (size_t)row * DM + col) = w; }
        }
    }
}

constexpr int ATP = 144;
constexpr int ATT_WAVE_LDS = 2 * 64 * ATP;
__device__ __forceinline__ void attn_item(const bf16_t* __restrict__ Q, const bf16_t* __restrict__ Kb, const bf16_t* __restrict__ VT, const bf16_t* __restrict__ GA,
                                          bf16_t* __restrict__ OA, const LAS float* btab, LAS unsigned char* wl, int b, int c, int h, int half, int lane) {
    const int r = lane & 31, hh = lane >> 5;
    const int rl = lane >> 3, cl = lane & 7;
    const int tokq = b * SEQ + c * 64 + half * 32;
    const int qloc = half * 32 + r;
    const int pr = (r & ~12) | ((r & 4) << 1) | ((r & 8) >> 1);
    const int jmin = c >= 8 ? 0 : 8 - c;
    const int tk0 = b * SEQ + (c - 8 + jmin) * 64;
    const bf16_t* kg = Kb + (size_t)(tk0 + rl) * DH + h * 64 + cl * 8;
    const bf16_t* vg = VT + (size_t)(h * 64 + rl) * PT + tk0 + cl * 8;
    LAS unsigned char* Kt = wl; LAS unsigned char* Vt = wl + 64 * ATP;
    const int stoff = rl * ATP + cl * 16;
    u32x4 kr[8], vr[8];
#pragma unroll
    for (int i = 0; i < 8; ++i) { kr[i] = *(const u32x4*)(kg + (size_t)(8 * i) * DH); vr[i] = *(const u32x4*)(vg + (size_t)(8 * i) * PT); }
    bf16x8 qf[4];
    { const bf16_t* qp = Q + (size_t)(tokq + r) * DH + h * 64 + 8 * hh;
#pragma unroll
      for (int d0 = 0; d0 < 4; ++d0) qf[d0] = *(const bf16x8*)(qp + d0 * 16); }
#pragma unroll
    for (int i = 0; i < 8; ++i) { *(LAS u32x4*)(Kt + stoff + 8 * i * ATP) = kr[i]; *(LAS u32x4*)(Vt + stoff + 8 * i * ATP) = vr[i]; }
    { const int adv = (jmin + 1 <= 8) ? 1 : 0; kg += (size_t)adv * 64 * DH; vg += adv * 64; }
#pragma unroll
    for (int i = 0; i < 8; ++i) { kr[i] = *(const u32x4*)(kg + (size_t)(8 * i) * DH); vr[i] = *(const u32x4*)(vg + (size_t)(8 * i) * PT); }
    f32x16 o0, o1;
#pragma unroll
    for (int i = 0; i < 16; ++i) { o0[i] = 0.f; o1[i] = 0.f; }
    float mrun = -1e30f, lrun = 0.f;
    const float cfar = btab[NREL - 1];
    const LAS unsigned char* kfp = Kt + pr * ATP + 16 * hh;
    const LAS unsigned char* vfp = Vt + r * ATP + 16 * hh;
    for (int j = jmin; j <= 8; ++j) {
        f32x16 s0, s1;
#pragma unroll
        for (int i = 0; i < 16; ++i) { s0[i] = 0.f; s1[i] = 0.f; }
#pragma unroll
        for (int d0 = 0; d0 < 4; ++d0) {
            const bf16x8 k0 = *(const LAS bf16x8*)(kfp + d0 * 32), k1 = *(const LAS bf16x8*)(kfp + 32 * ATP + d0 * 32);
            s0 = MFMA32(k0, qf[d0], s0); s1 = MFMA32(k1, qf[d0], s1);
        }
        if (j <= 3) {
#pragma unroll
            for (int i = 0; i < 16; ++i) { s0[i] += cfar; s1[i] += cfar; }
        } else {
            const int base = qloc + 64 * (8 - j) + 63 - 8 * hh;
#pragma unroll
            for (int i = 0; i < 16; ++i) {
                const int key = (i & 3) + 4 * ((i >> 2) & 1) + 16 * (i >> 3);
                int i0 = base - key, i1 = base - key - 32;
                i0 = i0 > NREL - 1 ? NREL - 1 : i0; i1 = i1 > NREL - 1 ? NREL - 1 : i1;
                s0[i] += btab[i0]; s1[i] += btab[i1];
            }
        }
        float tmax = fmaxf(s0[0], s1[0]);
#pragma unroll
        for (int i = 1; i < 16; ++i) tmax = fmaxf(tmax, fmaxf(s0[i], s1[i]));
        tmax = fmaxf(tmax, __shfl_xor(tmax, 32));
        const float mnew = fmaxf(mrun, tmax);
        const float alpha = __builtin_amdgcn_exp2f(mrun - mnew);
        mrun = mnew;
        float ls = 0.f;
#pragma unroll
        for (int i = 0; i < 16; ++i) { s0[i] = __builtin_amdgcn_exp2f(s0[i] - mnew); s1[i] = __builtin_amdgcn_exp2f(s1[i] - mnew); ls += s0[i] + s1[i]; }
        lrun = lrun * alpha + ls;
#pragma unroll
        for (int i = 0; i < 16; ++i) { o0[i] *= alpha; o1[i] *= alpha; }
#pragma unroll
        for (int s = 0; s < 2; ++s) {
            u32x4 pa, pb;
            pa.x = pk2(s0[8 * s + 0], s0[8 * s + 1]); pa.y = pk2(s0[8 * s + 2], s0[8 * s + 3]); pa.z = pk2(s0[8 * s + 4], s0[8 * s + 5]); pa.w = pk2(s0[8 * s + 6], s0[8 * s + 7]);
            pb.x = pk2(s1[8 * s + 0], s1[8 * s + 1]); pb.y = pk2(s1[8 * s + 2], s1[8 * s + 3]); pb.z = pk2(s1[8 * s + 4], s1[8 * s + 5]); pb.w = pk2(s1[8 * s + 6], s1[8 * s + 7]);
            const bf16x8 va0 = *(const LAS bf16x8*)(vfp + 32 * s), va1 = *(const LAS bf16x8*)(vfp + 32 * ATP + 32 * s);
            const bf16x8 vb0 = *(const LAS bf16x8*)(vfp + 64 + 32 * s), vb1 = *(const LAS bf16x8*)(vfp + 32 * ATP + 64 + 32 * s);
            o0 = MFMA32(va0, __builtin_bit_cast(bf16x8, pa), o0); o1 = MFMA32(va1, __builtin_bit_cast(bf16x8, pa), o1);
            o0 = MFMA32(vb0, __builtin_bit_cast(bf16x8, pb), o0); o1 = MFMA32(vb1, __builtin_bit_cast(bf16x8, pb), o1);
        }
#pragma unroll
        for (int i = 0; i < 8; ++i) { *(LAS u32x4*)(Kt + stoff + 8 * i * ATP) = kr[i]; *(LAS u32x4*)(Vt + stoff + 8 * i * ATP) = vr[i]; }
        { const int adv = (j + 2 <= 8) ? 1 : 0; kg += (size_t)adv * 64 * DH; vg += adv * 64; }
#pragma unroll
        for (int i = 0; i < 8; ++i) { kr[i] = *(const u32x4*)(kg + (size_t)(8 * i) * DH); vr[i] = *(const u32x4*)(vg + (size_t)(8 * i) * PT); }
    }
    const float l = lrun + __shfl_xor(lrun, 32);
    const float inv = 1.0f / l;
    LAS unsigned char* Ot = wl;
#pragma unroll
    for (int g = 0; g < 4; ++g) {
#pragma unroll
        for (int db = 0; db < 2; ++db) {
            const f32x16& o = db ? o1 : o0;
            u32x2 w; w.x = pk2(o[4 * g + 0] * inv, o[4 * g + 1] * inv); w.y = pk2(o[4 * g + 2] * inv, o[4 * g + 3] * inv);
            *(LAS u32x2*)(Ot + r * ATP + (db * 32 + 8 * g + 4 * hh) * 2) = w;
        }
    }
#pragma unroll
    for (int i = 0; i < 4; ++i) {
        const int row = rl + 8 * i;
        const size_t a = (size_t)(tokq + row) * DH + h * 64 + cl * 8;
        const u32x4 gg = *(const u32x4*)(GA + a);
        const u32x4 ov = *(const LAS u32x4*)(Ot + row * ATP + cl * 16);
        u32x4 w; w.x = pk2(bflo(ov.x) * bflo(gg.x), bfhi(ov.x) * bfhi(gg.x)); w.y = pk2(bflo(ov.y) * bflo(gg.y), bfhi(ov.y) * bfhi(gg.y));
        w.z = pk2(bflo(ov.z) * bflo(gg.z), bfhi(ov.z) * bfhi(gg.z)); w.w = pk2(bflo(ov.w) * bflo(gg.w), bfhi(ov.w) * bfhi(gg.w));
        *(u32x4*)(OA + a) = w;
    }
}

__device__ __forceinline__ void unpack8(const u32x4 w, float* v) { v[0] = bflo(w.x); v[1] = bfhi(w.x); v[2] = bflo(w.y); v[3] = bfhi(w.y); v[4] = bflo(w.z); v[5] = bfhi(w.z); v[6] = bflo(w.w); v[7] = bfhi(w.w); }
__device__ __forceinline__ void conv_unit(const bf16_t* __restrict__ BB, const bf16_t* __restrict__ CC, const bf16_t* __restrict__ HB, const bf16_t* __restrict__ GB,
                                          bf16_t* __restrict__ OB, const float* __restrict__ cw, int unit, int tid) {
    const int cgp = tid & 127, sub = tid >> 7, ch = cgp * 8;
    const int t0 = unit * 32 + sub * 8;
    float w0[8], w1[8], w2[8];
#pragma unroll
    for (int e = 0; e < 8; ++e) { w0[e] = cw[ch + e]; w1[e] = cw[DH + ch + e]; w2[e] = cw[2 * DH + ch + e]; }
    float p2[8], p1[8];
#pragma unroll
    for (int e = 0; e < 8; ++e) { p2[e] = 0.f; p1[e] = 0.f; }
    const int tpos = t0 & (SEQ - 1);
    if (tpos >= 2) { float a[8], b[8]; unpack8(*(const u32x4*)(CC + (size_t)(t0 - 2) * DH + ch), a); unpack8(*(const u32x4*)(HB + (size_t)(t0 - 2) * DH + ch), b);
#pragma unroll
        for (int e = 0; e < 8; ++e) p2[e] = a[e] * b[e]; }
    if (tpos >= 1) { float a[8], b[8]; unpack8(*(const u32x4*)(CC + (size_t)(t0 - 1) * DH + ch), a); unpack8(*(const u32x4*)(HB + (size_t)(t0 - 1) * DH + ch), b);
#pragma unroll
        for (int e = 0; e < 8; ++e) p1[e] = a[e] * b[e]; }
#pragma unroll
    for (int i = 0; i < 8; ++i) {
        const size_t off = (size_t)(t0 + i) * DH + ch;
        float a[8], b[8], g1[8], g2[8], o[8];
        unpack8(*(const u32x4*)(CC + off), a); unpack8(*(const u32x4*)(HB + off), b); unpack8(*(const u32x4*)(BB + off), g1); unpack8(*(const u32x4*)(GB + off), g2);
#pragma unroll
        for (int e = 0; e < 8; ++e) { const float cur = a[e] * b[e]; o[e] = g1[e] * (w0[e] * p2[e] + w1[e] * p1[e] + w2[e] * cur) * g2[e]; p2[e] = p1[e]; p1[e] = cur; }
        u32x4 w; w.x = pk2(o[0], o[1]); w.y = pk2(o[2], o[3]); w.z = pk2(o[4], o[5]); w.w = pk2(o[6], o[7]);
        *(u32x4*)(OB + off) = w;
    }
}

template <int tbA, int tbB>
__device__ __forceinline__ void sgu_groups(const bf16_t* __restrict__ VCT, const bf16_t* __restrict__ U, const bf16_t* __restrict__ GC, bf16_t* __restrict__ OC,
                                           const bf16_t* __restrict__ Wbf, const float* __restrict__ spb, const float* __restrict__ lng, const float* __restrict__ lnb,
                                           int tok0, int gh, int cb, int r, int hh, const LAS float* stat) {
    for (int gi = 0; gi < 4; ++gi) {
        const int g = gh * 4 + gi;
        const int ch = g * 128 + cb * 32 + r;
        const float gg = lng[ch], bb = lnb[ch];
        const bf16_t* ap = VCT + (size_t)ch * PT + tok0 + 8 * hh;
        const bf16_t* wp = Wbf + (size_t)g * 16384 + 8 * hh;
        constexpr int NSB = (tbB + 1) * 2, NSA = (tbA + 1) * 2;
        int so = 0; asm volatile("" : "+v"(so));
        u32x4 raw[NSB]; bf16x8 wB[NSB], wA[NSA];
#pragma unroll
        for (int k = 0; k < NSB; ++k) { raw[k] = *(const u32x4*)(ap + 16 * k); wB[k] = *(const bf16x8*)(wp + (size_t)(tbB * 32 + r) * 128 + 16 * k); }
#pragma unroll
        for (int k = 0; k < NSA; ++k) wA[k] = *(const bf16x8*)(wp + (size_t)(tbA * 32 + r) * 128 + 16 * k);
        f32x16 accA, accB;
#pragma unroll
        for (int i = 0; i < 16; ++i) { accA[i] = 0.f; accB[i] = 0.f; }
#pragma unroll
        for (int k = 0; k < NSB; ++k) {
            float v[8]; unpack8(raw[k], v);
#pragma unroll
            for (int jj = 0; jj < 8; ++jj) { const float mean = stat[(16 * k + 8 * hh + jj) * 2 + so], rstd = stat[(16 * k + 8 * hh + jj) * 2 + 1 + so]; v[jj] = (v[jj] - mean) * rstd * gg + bb; }
            u32x4 af; af.x = pk2(v[0], v[1]); af.y = pk2(v[2], v[3]); af.z = pk2(v[4], v[5]); af.w = pk2(v[6], v[7]);
            accB = MFMA32(__builtin_bit_cast(bf16x8, af), wB[k], accB);
            if (k < NSA) accA = MFMA32(__builtin_bit_cast(bf16x8, af), wA[k < NSA ? k : 0], accA);
        }
        u32x2 uu[2][4], gc[2][4]; float sb[2];
#pragma unroll
        for (int which = 0; which < 2; ++which) { const int t = (which ? tbB : tbA) * 32 + r; sb[which] = spb[g * 128 + t];
            const size_t rowoff = (size_t)(tok0 + t) * DH + g * 128 + cb * 32 + 4 * hh;
#pragma unroll
            for (int q = 0; q < 4; ++q) { uu[which][q] = *(const u32x2*)(U + rowoff + 8 * q); gc[which][q] = *(const u32x2*)(GC + rowoff + 8 * q); } }
#pragma unroll
        for (int which = 0; which < 2; ++which) {
            const int tb = which ? tbB : tbA; const f32x16& acc = which ? accB : accA;
            const int t = tb * 32 + r; const float sbv = sb[which];
            const size_t rowoff = (size_t)(tok0 + t) * DH + g * 128 + cb * 32 + 4 * hh;
#pragma unroll
            for (int q = 0; q < 4; ++q) {
                const u32x2 u2 = uu[which][q], g2 = gc[which][q];
                u32x2 o; o.x = pk2(bflo(u2.x) * (acc[4 * q + 0] + sbv) * bflo(g2.x), bfhi(u2.x) * (acc[4 * q + 1] + sbv) * bfhi(g2.x));
                o.y = pk2(bflo(u2.y) * (acc[4 * q + 2] + sbv) * bflo(g2.y), bfhi(u2.y) * (acc[4 * q + 3] + sbv) * bfhi(g2.y));
                *(u32x2*)(OC + rowoff + 8 * q) = o;
            }
        }
    }
}

__device__ __forceinline__ void sgu_unit(const bf16_t* __restrict__ VCT, const bf16_t* __restrict__ U, const bf16_t* __restrict__ GC, bf16_t* __restrict__ OC,
                                         const bf16_t* __restrict__ Wbf, const float* __restrict__ spb, const float* __restrict__ lng, const float* __restrict__ lnb,
                                         int b, int n, int gh, LAS unsigned char* lds, int tid) {
    const int lane = tid & 63, w = __builtin_amdgcn_readfirstlane(tid >> 6), r = lane & 31, hh = lane >> 5;
    const int tok0 = b * SEQ + n * 128;
    __syncthreads();
    LAS float* part = (LAS float*)lds;
    LAS float* stat = part + 8 * 128 * 2;
    {
        const int tl = lane & 15, cq = lane >> 4;
        const bf16_t* p = VCT + (size_t)(w * 128 + cq) * PT + tok0 + 8 * tl;
        float sm[8], sq[8];
#pragma unroll
        for (int e = 0; e < 8; ++e) { sm[e] = 0.f; sq[e] = 0.f; }
#pragma unroll 8
        for (int c4 = 0; c4 < 32; ++c4) { float v[8]; unpack8(*(const u32x4*)(p + (size_t)(c4 * 4) * PT), v);
#pragma unroll
            for (int e = 0; e < 8; ++e) { sm[e] += v[e]; sq[e] += v[e] * v[e]; } }
#pragma unroll
        for (int e = 0; e < 8; ++e) { sm[e] += __shfl_xor(sm[e], 16); sm[e] += __shfl_xor(sm[e], 32); sq[e] += __shfl_xor(sq[e], 16); sq[e] += __shfl_xor(sq[e], 32); }
        if (cq == 0) {
#pragma unroll
            for (int e = 0; e < 8; ++e) { part[(w * 128 + 8 * tl + e) * 2 + 0] = sm[e]; part[(w * 128 + 8 * tl + e) * 2 + 1] = sq[e]; }
        }
    }
    __syncthreads();
    if (tid < 128) {
        float S = 0.f, SS = 0.f;
#pragma unroll
        for (int ww = 0; ww < 8; ++ww) { S += part[(ww * 128 + tid) * 2]; SS += part[(ww * 128 + tid) * 2 + 1]; }
        const float mean = S * (1.0f / DH); const float var = fmaxf(SS * (1.0f / DH) - mean * mean, 0.f);
        stat[tid * 2] = mean; stat[tid * 2 + 1] = 1.0f / sqrtf(var + EPSN);
    }
    __syncthreads();
    if ((w >> 2) == 0) sgu_groups<0, 3>(VCT, U, GC, OC, Wbf, spb, lng, lnb, tok0, gh, w & 3, r, hh, stat);
    else sgu_groups<1, 2>(VCT, U, GC, OC, Wbf, spb, lng, lnb, tok0, gh, w & 3, r, hh, stat);
    __syncthreads();
}

#ifndef X_ATT
#define X_ATT 0
#endif
#ifndef X_CONV
#define X_CONV 0
#endif
#ifndef X_SGU
#define X_SGU 0
#endif
struct Args { const float* in[14]; float* out; unsigned char* ws; int ph_lo, ph_hi; };
constexpr int NPH = 11;

__device__ __forceinline__ void phase_prologue(const Args& args, LAS unsigned char* lds) {
    const int tid = threadIdx.x, lane = tid & 63, wave = __builtin_amdgcn_readfirstlane(tid >> 6);
    const int G = gridDim.x, blk = blockIdx.x, gw = blk * 8 + wave, NGW = G * 8;
    unsigned char* ws = args.ws;
    LAS float* scr = (LAS float*)(lds + wave * 16384);
    constexpr int I_IN = (DM / 64) * (NIN / 32), I_BR = (DH / 64) * (DM / 32), I_OUT = (DM / 64) * (DM / 32);
    constexpr int PER_L = I_IN + 3 * I_BR + I_OUT;
    for (int it = gw; it < 2 * PER_L; it += NGW) {
        const int l = it / PER_L; int r = it - l * PER_L;
        if (r < I_IN) { transpose_item(args.in[2] + (size_t)l * DM * NIN, DM, NIN, (bf16_t*)(ws + WS_WIN + (size_t)l * 68 * MiB), scr, r, lane); continue; } r -= I_IN;
        if (r < 3 * I_BR) { const int br = r / I_BR; r -= br * I_BR; const float* src = (br == 0 ? args.in[9] : (br == 1 ? args.in[10] : args.in[11])) + (size_t)l * DH * DM;
            transpose_item(src, DH, DM, (bf16_t*)(ws + WS_WBR + (size_t)(l * 3 + br) * 4 * MiB), scr, r, lane); continue; } r -= 3 * I_BR;
        transpose_item(args.in[12] + (size_t)l * DM * DM, DM, DM, (bf16_t*)(ws + WS_WOUT + (size_t)l * 8 * MiB), scr, r, lane);
    }
    { bf16_t* wb = (bf16_t*)(ws + WS_SGUW); const float* sp_w = args.in[7];
      for (int e = blk * 512 + tid; e < 2 * 8 * 128 * 128; e += G * 512) { const int t = (e >> 7) & 127, s = e & 127; const unsigned p = pk2(sp_w[e], 0.f); wb[e] = (s <= t) ? (bf16_t)(p & 0xffffu) : (bf16_t)0; } }
    row_pass<false, true>(args.in[0], nullptr, nullptr, nullptr, args.in[1], (bf16_t*)(ws + WS_H), gw, NGW, lane);
}

template <int L> __device__ __forceinline__ void phase_in(const Args& args, LAS unsigned char* lds) {
    unsigned char* ws = args.ws;
    pg8::Gemm g{(const bf16_t*)(ws + WS_H), (const bf16_t*)(ws + WS_WIN + (size_t)L * 68 * MiB), MT, NIN, DM, 0, 0};
    pg8::TileOrder<1> S; S.init(MT, NIN, gridDim.x, blockIdx.x);
    pg8::EpiIn E{ws + WS_SEG, (bf16_t*)(ws + WS_GATES), (bf16_t*)(ws + WS_VT), (bf16_t*)(ws + WS_VCT)};
    pg8::gemm_phase<pg8::EpiIn, pg8::TileOrder<1>, true>(lds, g, S, E);
}

template <int L> __device__ __forceinline__ void phase_mix(const Args& args, LAS unsigned char* lds) {
    const int tid = threadIdx.x, lane = tid & 63, wave = __builtin_amdgcn_readfirstlane(tid >> 6);
    const int G = gridDim.x, blk = blockIdx.x;
    unsigned char* ws = args.ws;
    const bf16_t* segb = (const bf16_t*)(ws + WS_SEG);
    bf16_t* OA = (bf16_t*)(ws + WS_O);
    constexpr size_t SE = (size_t)MT * DH;
    LAS float* btab = (LAS float*)(lds + 8 * ATT_WAVE_LDS + wave * 1280);
    LAS unsigned char* wl = lds + wave * ATT_WAVE_LDS;
    int cur_h = -1;
    constexpr int XA = (L == 0 ? X_ATT : 0) * 1024, XC = (L == 0 ? X_CONV : 0) * 512, XS = (L == 0 ? X_SGU : 0) * 256;
    for (int uu = blk; uu < 1792 + XA + XC + XS; uu += G) {
        int u = uu;
        if (uu >= 1792) { const int x = uu - 1792; u = x < XA ? (x & 1023) : (x < XA + XC ? 1024 + ((x - XA) & 511) : 1536 + ((x - XA - XC) & 255)); }
        if (u < 1024) {
            const int hg = u & 3, b = (u >> 2) & 7, c = u >> 5;
            const int h = hg * 4 + (wave >> 1), half = wave & 1;
            if (h != cur_h) { const float* rb = args.in[3] + (size_t)(L * 16 + h) * NREL;
#pragma unroll
                for (int i = 0; i < 5; ++i) btab[i * 64 + lane] = rb[i * 64 + lane] * LOG2E;
                cur_h = h; }
            attn_item(segb, segb + SE, (const bf16_t*)(ws + WS_VT), segb + 3 * SE, OA, btab, wl, b, c, h, half, lane);
        } else if (u < 1536) {
            conv_unit(segb + 4 * SE, segb + 5 * SE, segb + 6 * SE, segb + 7 * SE, OA + SE, args.in[4] + (size_t)L * 3 * DH, u - 1024, tid);
        } else {
            const int su = u - 1536; const int gh = su & 1, n = (su >> 1) & 15, b = su >> 5;
            sgu_unit((const bf16_t*)(ws + WS_VCT), segb + 8 * SE, segb + 10 * SE, OA + 2 * SE, (const bf16_t*)(ws + WS_SGUW) + (size_t)L * 8 * 16384, args.in[8] + (size_t)L * 8 * 128,
                     args.in[5] + (size_t)L * DH, args.in[6] + (size_t)L * DH, b, n, gh, lds, tid);
        }
    }
}

template <int L> __device__ __forceinline__ void phase_br(const Args& args, LAS unsigned char* lds) {
    unsigned char* ws = args.ws;
    pg8::Gemm g{(const bf16_t*)(ws + WS_O), (const bf16_t*)(ws + WS_WBR + (size_t)L * 12 * MiB), MT, DM, DH, (size_t)32 * MiB, (size_t)4 * MiB};
    pg8::TileOrder<3> S; S.init(MT, DM, gridDim.x, blockIdx.x);
    pg8::EpiMerge E{(const bf16_t*)(ws + WS_GATES), (bf16_t*)(ws + WS_MERGED16)};
    pg8::gemm_phase<pg8::EpiMerge, pg8::TileOrder<3>, true>(lds, g, S, E);
}

template <int L> __device__ __forceinline__ void phase_out(const Args& args, LAS unsigned char* lds) {
    unsigned char* ws = args.ws;
    pg8::Gemm g{(const bf16_t*)(ws + WS_MERGED16), (const bf16_t*)(ws + WS_WOUT + (size_t)L * 8 * MiB), MT, DM, DM, 0, 0};
    pg8::TileOrder<1> S; S.init(MT, DM, gridDim.x, blockIdx.x);
    pg8::EpiPlain E{(bf16_t*)(ws + WS_Y), DM};
    pg8::gemm_phase<pg8::EpiPlain, pg8::TileOrder<1>, true>(lds, g, S, E);
}

template <int L> __device__ __forceinline__ void phase_row(const Args& args) {
    const int tid = threadIdx.x, lane = tid & 63, wave = __builtin_amdgcn_readfirstlane(tid >> 6);
    const int gw = blockIdx.x * 8 + wave, NGW = gridDim.x * 8;
    unsigned char* ws = args.ws;
    if (L == 0) row_pass<true, true>(args.in[0], (const bf16_t*)(ws + WS_Y), args.in[13], args.out, args.in[1] + DM, (bf16_t*)(ws + WS_H), gw, NGW, lane);
    else row_pass<true, false>(args.out, (const bf16_t*)(ws + WS_Y), args.in[13] + DM, args.out, nullptr, nullptr, gw, NGW, lane);
}

__global__ void __launch_bounds__(512, 2) mk_fwd(const Args args) {
    extern __shared__ __attribute__((aligned(16))) unsigned char lds_raw[];
    LAS unsigned char* lds = (LAS unsigned char*)lds_raw;
    const int lo = args.ph_lo, hi = args.ph_hi;
    volatile LAS unsigned* bst = (volatile LAS unsigned*)(lds + LDS_BYTES - 64);
    if (threadIdx.x < 2) bst[threadIdx.x] = 0u;
    __syncthreads();
    XcdBarrier xbar; xbar.bar = (unsigned*)args.ws; xbar.x = 0; xbar.st = nullptr;
    if (hi - lo > 1) xbar = xcd_barrier_post((unsigned*)args.ws, bst);
#define IN(k) (lo <= (k) && (k) < hi)
#define SEAM(k) do { if (IN((k) + 1)) { if ((k) == 0) cg::this_grid().sync(); else xcd_barrier(xbar); } } while (0)
#ifndef REP_PRO
#define REP_PRO 1
#endif
#ifndef REP_IN
#define REP_IN 1
#endif
#ifndef REP_MIX
#define REP_MIX 1
#endif
#ifndef REP_BR
#define REP_BR 1
#endif
#ifndef REP_OUT
#define REP_OUT 1
#endif
#ifndef REP_ROW
#define REP_ROW 1
#endif
#ifndef REP_SYNC
#define REP_SYNC 0
#endif
    if (IN(0)) { for (int rep = 0; rep < REP_PRO; ++rep) phase_prologue(args, lds); SEAM(0); for (int rep = 0; rep < REP_SYNC; ++rep) cg::this_grid().sync(); }
    if (IN(1)) { for (int rep = 0; rep < REP_IN; ++rep) phase_in<0>(args, lds); SEAM(1); }
    if (IN(2)) { for (int rep = 0; rep < REP_MIX; ++rep) phase_mix<0>(args, lds); SEAM(2); }
    if (IN(3)) { for (int rep = 0; rep < REP_BR; ++rep) phase_br<0>(args, lds); SEAM(3); }
    if (IN(4)) { for (int rep = 0; rep < REP_OUT; ++rep) phase_out<0>(args, lds); SEAM(4); }
    if (IN(5)) { for (int rep = 0; rep < REP_ROW; ++rep) phase_row<0>(args); SEAM(5); }
    if (IN(6)) { phase_in<1>(args, lds); SEAM(6); }
    if (IN(7)) { phase_mix<1>(args, lds); SEAM(7); }
    if (IN(8)) { phase_br<1>(args, lds); SEAM(8); }
    if (IN(9)) { phase_out<1>(args, lds); SEAM(9); }
    if (IN(10)) { phase_row<1>(args); }
#undef IN
#undef SEAM
}

extern "C" void kernel_launch(void* const* d_in, const int* in_sizes, int n_in, void* d_out, int out_size, void* d_ws, size_t ws_size, hipStream_t stream) {
    static int grid = 0;
    if (grid == 0) {
        if (n_in != 14 || out_size != MT * DM || ws_size < WS_END) { fprintf(stderr, "kernel_launch: unexpected shapes (n_in %d out %d ws %zu)\n", n_in, out_size, ws_size); grid = -1; return; }
        int dev = 0, cus = 0, per_cu = 0;
        hipGetDevice(&dev);
        hipDeviceGetAttribute(&cus, hipDeviceAttributeMultiprocessorCount, dev);
        if (hipFuncSetAttribute((const void*)mk_fwd, hipFuncAttributeMaxDynamicSharedMemorySize, LDS_BYTES) != hipSuccess) { fprintf(stderr, "kernel_launch: hipFuncSetAttribute failed\n"); grid = -1; return; }
        if (hipOccupancyMaxActiveBlocksPerMultiprocessor(&per_cu, (const void*)mk_fwd, 512, LDS_BYTES) != hipSuccess || per_cu < 1) { fprintf(stderr, "kernel_launch: occupancy query says %d\n", per_cu); per_cu = 1; }
        (void)hipGetLastError();
        grid = cus * 1;
    }
    if (grid < 0) return;
    (void)hipMemsetAsync(d_ws, 0, 16384, stream);
    Args a{};
    for (int i = 0; i < 14; ++i) a.in[i] = (const float*)d_in[i];
    a.out = (float*)d_out; a.ws = (unsigned char*)d_ws;
#if MK_N_LAUNCHES == 1
    a.ph_lo = 0; a.ph_hi = NPH;
    void* kargs[] = {&a};
    hipError_t e = hipLaunchCooperativeKernel((const void*)mk_fwd, dim3(grid), dim3(512), kargs, LDS_BYTES, stream);
    if (e != hipSuccess) fprintf(stderr, "cooperative launch failed: %s (grid %d)\n", hipGetErrorString(e), grid);
#else
    for (int p = 0; p < NPH; ++p) { a.ph_lo = p; a.ph_hi = p + 1; hipLaunchKernelGGL(mk_fwd, dim3(grid), dim3(512), LDS_BYTES, stream, a); }
#endif
}
```

```cpp
#include <hip/hip_runtime.h>
#include <hip/hip_cooperative_groups.h>
#include <cstdio>
#include <cstdint>
namespace cg = cooperative_groups;

#define LAS __attribute__((address_space(3)))
typedef unsigned short bf16_t;
typedef short bf16x8 __attribute__((ext_vector_type(8)));
typedef float f32x4 __attribute__((ext_vector_type(4)));
typedef float f32x2 __attribute__((ext_vector_type(2)));
typedef float f32x16 __attribute__((ext_vector_type(16)));
typedef unsigned u32x4 __attribute__((ext_vector_type(4)));
typedef unsigned u32x2 __attribute__((ext_vector_type(2)));
typedef __bf16 bf16x2_t __attribute__((ext_vector_type(2)));
typedef int i32x4 __attribute__((ext_vector_type(4)));

#ifndef MK_N_LAUNCHES
#define MK_N_LAUNCHES 1
#endif

constexpr int MT = 16384;
constexpr int SEQ = 2048;
constexpr int DM = 2048;
constexpr int NIN = 17408;
constexpr int DH = 1024;
constexpr int NREL = 320;
constexpr int PT = MT + 64;
constexpr float LOG2E = 1.4426950408889634f;
constexpr float QSCALE = 0.125f * LOG2E;
constexpr float EPSN = 1e-6f;
constexpr int NBF = 11 * 1024;

constexpr size_t MiB = 1u << 20;
constexpr size_t WS_WIN = 2 * MiB;
constexpr size_t WS_WBR = 138 * MiB;
constexpr size_t WS_WOUT = 162 * MiB;
constexpr size_t WS_H = 178 * MiB;
constexpr size_t WS_SEG = 242 * MiB;
constexpr size_t WS_GATES = 594 * MiB;
constexpr size_t WS_O = 786 * MiB;
constexpr size_t WS_SGUW = 882 * MiB;
constexpr size_t WS_VT = 884 * MiB;
constexpr size_t WS_VCT = 918 * MiB;
constexpr size_t WS_H8 = 952 * MiB;
constexpr size_t WS_W8 = 984 * MiB;
constexpr size_t WS_HS = 1008 * MiB;
constexpr size_t WS_END = 1009 * MiB;
constexpr size_t WS_COLMAX = 16384;
constexpr size_t SEGB = 32 * MiB;
constexpr size_t WS_MERGED32 = WS_SEG;
constexpr size_t WS_MERGED16 = WS_SEG + 4 * SEGB;
constexpr size_t WS_Y = WS_SEG + 6 * SEGB;

constexpr int LDS_BYTES = 163840;

__device__ __forceinline__ unsigned pk2(float lo, float hi) { f32x2 v = {lo, hi}; bf16x2_t b = __builtin_convertvector(v, bf16x2_t); return __builtin_bit_cast(unsigned, b); }
__device__ __forceinline__ unsigned q8x4(float a, float b, float c, float d) {
    const int ia = (int)__builtin_rintf(a), ib = (int)__builtin_rintf(b), ic = (int)__builtin_rintf(c), id = (int)__builtin_rintf(d);
    return (unsigned)(ia & 0xff) | ((unsigned)(ib & 0xff) << 8) | ((unsigned)(ic & 0xff) << 16) | ((unsigned)id << 24); }
__device__ __forceinline__ float bflo(unsigned u) { return __uint_as_float(u << 16); }
__device__ __forceinline__ float bfhi(unsigned u) { return __uint_as_float(u & 0xffff0000u); }
__device__ __forceinline__ float fast_sigmoid(float w) { return __builtin_amdgcn_rcpf(1.0f + __builtin_amdgcn_exp2f(-w * LOG2E)); }
__device__ __forceinline__ float wave_sum(float v) {
#pragma unroll
    for (int o = 1; o < 64; o <<= 1) v += __shfl_xor(v, o);
    return v;
}
#define MFMA32(a, b, c) __builtin_amdgcn_mfma_f32_32x32x16_bf16((a), (b), (c), 0, 0, 0)

namespace pg8 {
constexpr int BM = 256, BK = 64, HALF = 128, HTB = HALF * BK * 2, STAGE_BYTES = 8 * HTB, NXCD = 8, WGM = 8;
__device__ __forceinline__ int lds_byte(int r, int c) { const int st = (r >> 4) * 2 + (c >> 5), rr = r & 15, cc = c & 31, ob = rr * 64 + cc * 2; return st * 1024 + (ob ^ (((ob >> 9) & 1) << 5)); }
__device__ __forceinline__ void stage_rc(int b, int& R, int& C) { const int st = b / 1024, sb = b % 1024, swz = sb ^ (((sb >> 9) & 1) << 5); R = (st >> 1) * 16 + swz / 64; C = (st & 1) * 32 + (swz % 64) / 2; }
__device__ __forceinline__ int perm32(int rho) { const int n = rho >> 4, i = rho & 15; return 8 * (i >> 2) + 4 * n + (i & 3); }

struct Unit { int pm, pn, z; };
struct Gemm { const bf16_t* A; const bf16_t* Bt; int M, N, K; size_t zA, zB; };

template <int NZ> struct TileOrder {
    int nM, nN, nwg, G, c;
    __device__ void init(int M, int N, int G_, int c_) { nM = M / BM; nN = N / BM; nwg = nM * nN; G = G_; c = c_; }
    __device__ bool next(int i, Unit& u) const {
        const int ti = i / NZ; u.z = i - ti * NZ;
        const long L = (long)ti * G + c; if (L >= nwg) return false;
        int wgid = (int)L; { const int q = nwg / NXCD, r = nwg % NXCD, xcd = wgid % NXCD, off = wgid / NXCD; wgid = (xcd < r ? xcd * (q + 1) : r * (q + 1) + (xcd - r) * q) + off; }
        const int nig = WGM * nN, gid = wgid / nig, fm = gid * WGM, gsz = (nM - fm) < WGM ? (nM - fm) : WGM;
        u.pm = fm + ((wgid % nig) % gsz); u.pn = (wgid % nig) / gsz; return true;
    }
};


template <int MODE> __device__ __forceinline__ f32x2 act2(f32x2 v, float sc) {
    if constexpr (MODE == 0) return v * sc;
    f32x2 t;
    if constexpr (MODE == 2) { const f32x2 x2 = v * v; t = v * (x2 * (-0.10294325f) + (-2.3022082f)); }
    else t = v * (-LOG2E);
    if constexpr (MODE == 3) { t.x = fminf(t.x, 20.f); t.y = fminf(t.y, 20.f); }
    f32x2 d; d.x = __builtin_amdgcn_exp2f(t.x); d.y = __builtin_amdgcn_exp2f(t.y);
    d = d + 1.0f;
    f32x2 r; r.x = __builtin_amdgcn_rcpf(d.x); r.y = __builtin_amdgcn_rcpf(d.y);
    if constexpr (MODE == 3) return r;
    return v * r;
}
template <int MODE, bool TR>
__device__ __forceinline__ void epi_in_tile(const f32x4 (&acc)[2][2][4][2], bf16_t* __restrict__ base, int ldc, int row0, int col0, float sc) {
#pragma unroll
    for (int ai = 0; ai < 2; ++ai)
#pragma unroll
        for (int m = 0; m < 4; ++m) {
            const int row = row0 + ai * HALF + m * 16;
#pragma unroll
            for (int bj = 0; bj < 2; ++bj) {
                const f32x4 a0 = acc[ai][bj][m][0], a1 = acc[ai][bj][m][1];
                const f32x2 p0 = act2<MODE>((f32x2){a0[0], a0[1]}, sc), p1 = act2<MODE>((f32x2){a0[2], a0[3]}, sc);
                const f32x2 p2 = act2<MODE>((f32x2){a1[0], a1[1]}, sc), p3 = act2<MODE>((f32x2){a1[2], a1[3]}, sc);
                u32x4 w; w.x = pk2(p0.x, p0.y); w.y = pk2(p1.x, p1.y); w.z = pk2(p2.x, p2.y); w.w = pk2(p3.x, p3.y);
                if constexpr (!TR) {
                    *(u32x4*)(base + (size_t)row * ldc + col0 + bj * HALF) = w;
                } else {
                    bf16_t* tp = base + (size_t)(col0 + bj * HALF) * PT + row;
                    tp[0 * (size_t)PT] = (bf16_t)(w.x & 0xffffu); tp[1 * (size_t)PT] = (bf16_t)(w.x >> 16);
                    tp[2 * (size_t)PT] = (bf16_t)(w.y & 0xffffu); tp[3 * (size_t)PT] = (bf16_t)(w.y >> 16);
                    tp[4 * (size_t)PT] = (bf16_t)(w.z & 0xffffu); tp[5 * (size_t)PT] = (bf16_t)(w.z >> 16);
                    tp[6 * (size_t)PT] = (bf16_t)(w.w & 0xffffu); tp[7 * (size_t)PT] = (bf16_t)(w.w >> 16);
                }
            }
        }
}
struct EpiIn {
    static constexpr bool PERM = true;
    unsigned char* seg;
    bf16_t* gates;
    bf16_t* vt; bf16_t* vct;
    __device__ __forceinline__ bool reset(const Unit&) const { return true; }
    __device__ __forceinline__ void prefetch(const Unit&, int, int, int, int, float&) const {}
    __device__ __forceinline__ void operator()(const f32x4 (&acc)[2][2][4][2], const Unit& u, int wr, int wc, int fr, int fq) const {
        const int colt = u.pn * BM;
        const int row0 = u.pm * BM + wr * 64 + fr;
        const int lc = wc * 32 + 8 * fq;
        const int s = colt >> 10; const int col0 = (colt & 1023) + lc;
        bf16_t* base = (bf16_t*)(seg + (size_t)s * SEGB);
        if (s == 3 || s == 7 || s == 10) epi_in_tile<1, false>(acc, base, DH, row0, col0, 1.f);
        else if (s == 8) epi_in_tile<2, false>(acc, base, DH, row0, col0, 1.f);
        else if (s == 9) epi_in_tile<2, true>(acc, vct, 0, row0, col0, 1.f);
        else if (s == 2) epi_in_tile<0, true>(acc, vt, 0, row0, col0, 1.f);
        else epi_in_tile<0, false>(acc, base, DH, row0, col0, s == 0 ? QSCALE : 1.f);
    }
};

struct EpiGate8 {
    static constexpr bool PERM = true;
    bf16_t* __restrict__ gates; const float* __restrict__ hs; const float* __restrict__ colmax;
    __device__ __forceinline__ bool reset(const Unit&) const { return true; }
    __device__ __forceinline__ void operator()(const f32x4 (&acc)[2][2][4][2], const Unit& u, int wr, int wc, int fr, int fq) const {
        const int row0 = u.pm * BM + wr * 64 + fr, col0 = u.pn * BM + wc * 32 + 8 * fq;
        float cs[2][8];
#pragma unroll
        for (int bj = 0; bj < 2; ++bj) { const f32x4 a = *(const f32x4*)(colmax + col0 + bj * HALF), b = *(const f32x4*)(colmax + col0 + bj * HALF + 4);
#pragma unroll
            for (int e = 0; e < 4; ++e) { cs[bj][e] = a[e] * (-LOG2E / 127.f); cs[bj][4 + e] = b[e] * (-LOG2E / 127.f); } }
#pragma unroll
        for (int ai = 0; ai < 2; ++ai)
#pragma unroll
            for (int m = 0; m < 4; ++m) {
                const int row = row0 + ai * HALF + m * 16;
                const float rs = hs[row];
#pragma unroll
                for (int bj = 0; bj < 2; ++bj) {
                    const i32x4 a0 = __builtin_bit_cast(i32x4, acc[ai][bj][m][0]), a1 = __builtin_bit_cast(i32x4, acc[ai][bj][m][1]);
                    float r[8];
#pragma unroll
                    for (int e = 0; e < 8; ++e) {
                        const float v = (float)(e < 4 ? a0[e & 3] : a1[e & 3]) * rs;
                        const float t = fminf(v * cs[bj][e], 20.f);
                        r[e] = __builtin_amdgcn_rcpf(1.0f + __builtin_amdgcn_exp2f(t));
                    }
                    u32x4 w; w.x = pk2(r[0], r[1]); w.y = pk2(r[2], r[3]); w.z = pk2(r[4], r[5]); w.w = pk2(r[6], r[7]);
                    *(u32x4*)(gates + (size_t)row * (3 * DM) + col0 + bj * HALF) = w;
                }
            }
    }
};

struct EpiPlain {
    static constexpr bool PERM = true;
    bf16_t* O; int ldc;
    __device__ __forceinline__ bool reset(const Unit&) const { return true; }
    __device__ __forceinline__ void prefetch(const Unit&, int, int, int, int, float&) const {}
    __device__ __forceinline__ void operator()(const f32x4 (&acc)[2][2][4][2], const Unit& u, int wr, int wc, int fr, int fq) const {
        const int row0 = u.pm * BM + wr * 64 + fr, col0 = u.pn * BM + wc * 32 + 8 * fq;
#pragma unroll
        for (int ai = 0; ai < 2; ++ai)
#pragma unroll
            for (int m = 0; m < 4; ++m) { bf16_t* rowp = O + (size_t)(row0 + ai * HALF + m * 16) * ldc + col0;
#pragma unroll
                for (int bj = 0; bj < 2; ++bj) { const f32x4 v0 = acc[ai][bj][m][0], v1 = acc[ai][bj][m][1];
                    u32x4 w; w.x = pk2(v0[0], v0[1]); w.y = pk2(v0[2], v0[3]); w.z = pk2(v1[0], v1[1]); w.w = pk2(v1[2], v1[3]);
                    *(u32x4*)(rowp + bj * HALF) = w; } }
    }
};

struct EpiMerge {
    static constexpr bool PERM = true;
    const bf16_t* __restrict__ gates; bf16_t* __restrict__ out;
    __device__ __forceinline__ bool reset(const Unit& u) const { return u.z == 2; }
    __device__ __forceinline__ void prefetch(const Unit& u, int wr, int wc, int fr, int fq, float& dummy) const {
        const int row0 = u.pm * BM + wr * 64 + fr, col0 = u.pn * BM + wc * 32 + 8 * fq;
        const bf16_t* p = gates + (size_t)row0 * (3 * DM) + u.z * DM + col0;
        asm volatile("" : "+v"(p));
        const bool two = u.z < 2;
#pragma unroll
        for (int i = 0; i < 8; ++i) {
            asm volatile("global_load_dword %0, %1, off" : "+v"(dummy) : "v"(p) : "memory");
            asm volatile("global_load_dword %0, %1, off offset:256" : "+v"(dummy) : "v"(p) : "memory");
            if (two) { const bf16_t* p2 = p + DM;
                asm volatile("global_load_dword %0, %1, off" : "+v"(dummy) : "v"(p2) : "memory");
                asm volatile("global_load_dword %0, %1, off offset:256" : "+v"(dummy) : "v"(p2) : "memory"); }
            p += (size_t)(i == 3 ? 16 + 64 : 16) * (3 * DM);
        }
    }
    __device__ __forceinline__ void operator()(f32x4 (&acc)[2][2][4][2], const Unit& u, int wr, int wc, int fr, int fq) const {
        const int row0 = u.pm * BM + wr * 64 + fr, col0 = u.pn * BM + wc * 32 + 8 * fq;
        const int z = u.z;
        const bf16_t* gz = gates + (size_t)row0 * (3 * DM) + z * DM + col0;
        if (z < 2) {
#pragma unroll
            for (int ai = 0; ai < 2; ++ai) {
                u32x4 gn[4][2], gd[4][2];
#pragma unroll
                for (int m = 0; m < 4; ++m)
#pragma unroll
                    for (int bj = 0; bj < 2; ++bj) { const bf16_t* p = gz + (size_t)(ai * HALF + m * 16) * (3 * DM) + bj * HALF; gn[m][bj] = *(const u32x4*)p; gd[m][bj] = *(const u32x4*)(p + DM); }
#pragma unroll
                for (int m = 0; m < 4; ++m)
#pragma unroll
                    for (int bj = 0; bj < 2; ++bj) {
                        const u32x4 a = gn[m][bj], d = gd[m][bj];
                        f32x4& v0 = acc[ai][bj][m][0]; f32x4& v1 = acc[ai][bj][m][1];
                        v0[0] *= bflo(a.x) * __builtin_amdgcn_rcpf(bflo(d.x)); v0[1] *= bfhi(a.x) * __builtin_amdgcn_rcpf(bfhi(d.x));
                        v0[2] *= bflo(a.y) * __builtin_amdgcn_rcpf(bflo(d.y)); v0[3] *= bfhi(a.y) * __builtin_amdgcn_rcpf(bfhi(d.y));
                        v1[0] *= bflo(a.z) * __builtin_amdgcn_rcpf(bflo(d.z)); v1[1] *= bfhi(a.z) * __builtin_amdgcn_rcpf(bfhi(d.z));
                        v1[2] *= bflo(a.w) * __builtin_amdgcn_rcpf(bflo(d.w)); v1[3] *= bfhi(a.w) * __builtin_amdgcn_rcpf(bfhi(d.w));
                    }
            }
        } else {
#pragma unroll
            for (int ai = 0; ai < 2; ++ai) {
                u32x4 gn[4][2];
#pragma unroll
                for (int m = 0; m < 4; ++m)
#pragma unroll
                    for (int bj = 0; bj < 2; ++bj) gn[m][bj] = *(const u32x4*)(gz + (size_t)(ai * HALF + m * 16) * (3 * DM) + bj * HALF);
#pragma unroll
                for (int m = 0; m < 4; ++m)
#pragma unroll
                    for (int bj = 0; bj < 2; ++bj) {
                        const u32x4 a = gn[m][bj];
                        const f32x4 v0 = acc[ai][bj][m][0], v1 = acc[ai][bj][m][1];
                        u32x4 w; w.x = pk2(v0[0] * bflo(a.x), v0[1] * bfhi(a.x)); w.y = pk2(v0[2] * bflo(a.y), v0[3] * bfhi(a.y));
                        w.z = pk2(v1[0] * bflo(a.z), v1[1] * bfhi(a.z)); w.w = pk2(v1[2] * bflo(a.w), v1[3] * bfhi(a.w));
                        *(u32x4*)(out + (size_t)(row0 + ai * HALF + m * 16) * DM + col0 + bj * HALF) = w;
                    }
            }
        }
    }
};

template <class Epi, class Sched, bool ALIGN_EPI, bool I8 = false>
__device__ __forceinline__ void gemm_phase(LAS unsigned char* lds, const Gemm g, const Sched& S, const Epi& E) {
    const int tid = threadIdx.x, wid = __builtin_amdgcn_readfirstlane(tid >> 6), lane = tid & 63, wr = wid >> 2, wc = wid & 3, fr = lane & 15, fq = lane >> 4;
    const int K = g.K, nt = K / BK;
    unsigned voffA[2], voffB[2];
#pragma unroll
    for (int i = 0; i < 2; ++i) { int R, C; stage_rc(tid * 16 + i * 8192, R, C); const int Rb = Epi::PERM ? ((R & ~31) + perm32(R & 31)) : R;
        voffA[i] = (unsigned)(R * K + C) * 2u; voffB[i] = (unsigned)(Rb * K + C) * 2u; }
    const size_t kstep = (size_t)(BK * 2);
    const size_t hstep = (size_t)HALF * K * 2;
    const size_t tstep = 2 * hstep;
    const unsigned ldsw = (unsigned)wid * 1024u;
    const int aoff = lds_byte(wr * 64 + fr, fq * 8), boff = lds_byte(wc * 32 + fr, fq * 8);
#define PG8_SA(b, h) (((b) * 2 + (h)) * HTB)
#define PG8_SB(b, h) ((4 + (b) * 2 + (h)) * HTB)
#define PG8_STAGE(bufoff, gbase, voff) do { _Pragma("unroll") for (int _i = 0; _i < 2; ++_i) \
        __builtin_amdgcn_global_load_lds((const unsigned*)((const char*)(gbase) + (voff)[_i]), (LAS unsigned*)(lds + (bufoff) + ldsw + _i * 8192), 16, 0, 0); } while (0)
#define PG8_LDA(dst, b, h) do { _Pragma("unroll") for (int m = 0; m < 4; ++m) _Pragma("unroll") for (int k = 0; k < 2; ++k) dst[m][k] = *(const LAS bf16x8*)(lds + PG8_SA(b, h) + aoff + m * 2048 + k * 1024); } while (0)
#define PG8_LDB(dst, b, h) do { _Pragma("unroll") for (int n = 0; n < 2; ++n) _Pragma("unroll") for (int k = 0; k < 2; ++k) dst[n][k] = *(const LAS bf16x8*)(lds + PG8_SB(b, h) + boff + n * 2048 + k * 1024); } while (0)
#define PG8_MMA(ai, bj, At, Bt) do { __builtin_amdgcn_s_setprio(1); _Pragma("unroll") for (int m = 0; m < 4; ++m) _Pragma("unroll") for (int n = 0; n < 2; ++n) _Pragma("unroll") for (int k = 0; k < 2; ++k) { \
        if constexpr (I8) acc[ai][bj][m][n] = __builtin_bit_cast(f32x4, __builtin_amdgcn_mfma_i32_16x16x64_i8(__builtin_bit_cast(i32x4, Bt[n][k]), __builtin_bit_cast(i32x4, At[m][k]), __builtin_bit_cast(i32x4, acc[ai][bj][m][n]), 0, 0, 0)); \
        else acc[ai][bj][m][n] = __builtin_amdgcn_mfma_f32_16x16x32_bf16(Bt[n][k], At[m][k], acc[ai][bj][m][n], 0, 0, 0); } __builtin_amdgcn_s_setprio(0); } while (0)
#define PG8_WAIT_V(n) asm volatile("s_waitcnt vmcnt(" #n ")" ::: "memory")
#define PG8_WAIT_L(n) asm volatile("s_waitcnt lgkmcnt(" #n ")" ::: "memory")
#define PG8_BAR __builtin_amdgcn_s_barrier()
#define PG8_SCHED __builtin_amdgcn_sched_barrier(0)
    Unit cur, nxt; int ui = 0;
    if (!S.next(0, cur)) return;
    f32x4 acc[2][2][4][2];
#pragma unroll
    for (int a = 0; a < 2; ++a)
#pragma unroll
        for (int b = 0; b < 2; ++b)
#pragma unroll
            for (int m = 0; m < 4; ++m)
#pragma unroll
                for (int n = 0; n < 2; ++n) acc[a][b][m][n] = (f32x4){0.f, 0.f, 0.f, 0.f};
    bf16x8 At[4][2], B0[2][2], B1[2][2];
    const char* cA = (const char*)g.A + (size_t)cur.z * g.zA + (size_t)cur.pm * tstep; const char* cB = (const char*)g.Bt + (size_t)cur.z * g.zB + (size_t)cur.pn * tstep;
    PG8_STAGE(PG8_SB(0, 0), cB, voffB); PG8_STAGE(PG8_SB(0, 1), cB + hstep, voffB); PG8_STAGE(PG8_SA(0, 0), cA, voffA); PG8_STAGE(PG8_SA(0, 1), cA + hstep, voffA);
    if (wr == 1) PG8_BAR;
    PG8_WAIT_V(2); PG8_BAR;
    PG8_STAGE(PG8_SB(1, 0), cB + kstep, voffB); PG8_STAGE(PG8_SA(1, 0), cA + kstep, voffA); PG8_STAGE(PG8_SB(1, 1), cB + hstep + kstep, voffB);
    PG8_WAIT_V(6); PG8_BAR;
    for (;;) {
        const bool has_next = S.next(ui + 1, nxt);
        const char* nA = has_next ? (const char*)g.A + (size_t)nxt.z * g.zA + (size_t)nxt.pm * tstep : cA;
        const char* nB = has_next ? (const char*)g.Bt + (size_t)nxt.z * g.zB + (size_t)nxt.pn * tstep : cB;
        for (int t = 0; t < nt; t += 2) {
            const bool last = (t == nt - 2);
            const char* a1 = cA + (size_t)(t + 1) * kstep;
            const char* a2 = last ? nA : cA + (size_t)(t + 2) * kstep; const char* b2 = last ? nB : cB + (size_t)(t + 2) * kstep;
            const char* a3 = a2 + kstep; const char* b3 = b2 + kstep;
            PG8_LDB(B0, 0, 0); PG8_LDB(B1, 0, 1); PG8_SCHED; PG8_LDA(At, 0, 0); PG8_STAGE(PG8_SA(1, 1), a1 + hstep, voffA);
            PG8_WAIT_V(8); PG8_WAIT_L(0); PG8_BAR; PG8_MMA(0, 0, At, B0); PG8_MMA(0, 1, At, B1); PG8_BAR; PG8_SCHED;
            PG8_LDA(At, 0, 1); PG8_STAGE(PG8_SB(0, 0), b2, voffB); PG8_STAGE(PG8_SB(0, 1), b2 + hstep, voffB); PG8_STAGE(PG8_SA(0, 0), a2, voffA);
            PG8_WAIT_V(8); PG8_WAIT_L(0); PG8_BAR; PG8_MMA(1, 0, At, B0); PG8_MMA(1, 1, At, B1); PG8_BAR; PG8_SCHED;
            PG8_LDB(B0, 1, 0); PG8_LDB(B1, 1, 1); PG8_SCHED; PG8_LDA(At, 1, 0); PG8_STAGE(PG8_SA(0, 1), a2 + hstep, voffA);
            PG8_WAIT_V(8); PG8_WAIT_L(0); PG8_BAR; PG8_MMA(0, 0, At, B0); PG8_MMA(0, 1, At, B1); PG8_BAR; PG8_SCHED;
            PG8_LDA(At, 1, 1); PG8_STAGE(PG8_SB(1, 0), b3, voffB); PG8_STAGE(PG8_SB(1, 1), b3 + hstep, voffB); PG8_STAGE(PG8_SA(1, 0), a3, voffA);
            PG8_WAIT_V(8); PG8_WAIT_L(0); PG8_BAR; PG8_MMA(1, 0, At, B0); PG8_MMA(1, 1, At, B1); PG8_BAR; PG8_SCHED;
        }
        if constexpr (ALIGN_EPI) { if (wr == 0) PG8_BAR; }
        E(acc, cur, wr, wc, fr, fq);
        if (!has_next) break;
        if (E.reset(cur)) {
#pragma unroll
        for (int a = 0; a < 2; ++a)
#pragma unroll
            for (int b = 0; b < 2; ++b)
#pragma unroll
                for (int m = 0; m < 4; ++m)
#pragma unroll
                    for (int n = 0; n < 2; ++n) acc[a][b][m][n] = (f32x4){0.f, 0.f, 0.f, 0.f};
        }
        cur = nxt; cA = nA; cB = nB; ++ui;
        if constexpr (ALIGN_EPI) { if (wr == 1) PG8_BAR; }
    }
    PG8_WAIT_V(0);
    if constexpr (!ALIGN_EPI) { if (wr == 0) PG8_BAR; }
    PG8_BAR;
#undef PG8_SA
#undef PG8_SB
#undef PG8_STAGE
#undef PG8_LDA
#undef PG8_LDB
#undef PG8_MMA
#undef PG8_WAIT_V
#undef PG8_WAIT_L
#undef PG8_BAR
#undef PG8_SCHED
}
}

#define GAS __attribute__((address_space(1)))
#define RLX_AGENT __ATOMIC_RELAXED, __HIP_MEMORY_SCOPE_AGENT
#define XB_TMO      128
#define XB_XCNT(j)  (256  + 64 * (j))
#define XB_XSUB(j)  (1280 + 64 * (j))
#define XB_XGEN(j)  (2304 + 64 * (j))
#define XB_TOP      3328
#define XB_TOPGEN   3392
#define XCD_BAR_WORDS 3456
#define XB_SPIN_CAP (1u << 18)

__device__ __forceinline__ unsigned xb_ld(unsigned* p)              { return __hip_atomic_load(p, __ATOMIC_RELAXED, __HIP_MEMORY_SCOPE_AGENT); }
__device__ __forceinline__ unsigned xb_add(unsigned* p, unsigned v) { return __hip_atomic_fetch_add(p, v, __ATOMIC_RELAXED, __HIP_MEMORY_SCOPE_AGENT); }
__device__ __forceinline__ unsigned xb_xcc_id() { return (unsigned)__builtin_amdgcn_s_getreg((3 << 11) | 20) & 0xFu; }
#define XB_SPIN(cond, bar) do { unsigned _sp = 0; while (cond) { __builtin_amdgcn_s_sleep(1); \
    if ((++_sp & 255u) == 0u) { if (xb_ld(&(bar)[XB_TMO])) break; if (_sp > XB_SPIN_CAP) { atomicAdd(&(bar)[XB_TMO], 1u); break; } } } } while (0)

struct XcdBarrier {
    unsigned* bar; unsigned x;
    volatile LAS unsigned* st;
};

__device__ __forceinline__ XcdBarrier xcd_barrier_post(unsigned* bar, volatile LAS unsigned* st) {
    XcdBarrier b; b.bar = bar; b.x = xb_xcc_id(); b.st = st;
    if (threadIdx.x == 0) (void)xb_add(&bar[XB_XCNT(b.x)], 1u);
    return b;
}
__device__ __forceinline__ void xcd_barrier_complete(unsigned* bar, unsigned x, unsigned& nloc, unsigned& nx) {
    const unsigned G = gridDim.x * gridDim.y * gridDim.z;
    unsigned sum, cnt, mine, sp = 0u;
    for (;;) {
        sum = 0u; cnt = 0u; mine = 0u;
#pragma unroll
        for (unsigned j = 0; j < 16; ++j) { const unsigned c = xb_ld(&bar[XB_XCNT(j)]); sum += c; cnt += (c > 0u) ? 1u : 0u; mine = (j == x) ? c : mine; }
        if (sum == G) break;
        __builtin_amdgcn_s_sleep(1);
        if ((++sp & 255u) == 0u) { if (xb_ld(&bar[XB_TMO])) break; if (sp > XB_SPIN_CAP) { atomicAdd(&bar[XB_TMO], 1u); break; } }
    }
    nloc = mine > 0u ? mine : 1u; nx = cnt > 0u ? cnt : 1u;
}

__device__ __forceinline__ void xcd_barrier(const XcdBarrier& b) {
    asm volatile("s_waitcnt vmcnt(0)" ::: "memory");
    __syncthreads();
    if (threadIdx.x == 0) {
        unsigned* bar = b.bar;
        __builtin_amdgcn_s_waitcnt(0);
        unsigned nloc = b.st[0], nx = b.st[1];
        if (nloc == 0u) { xcd_barrier_complete(bar, b.x, nloc, nx); b.st[0] = nloc; b.st[1] = nx; }
        const unsigned old = xb_add(&bar[XB_XSUB(b.x)], 1u);
        const unsigned gen = old / nloc;
        if (old + 1u == (gen + 1u) * nloc) {
            __builtin_amdgcn_fence(__ATOMIC_RELEASE, "agent");
            asm volatile("s_waitcnt vmcnt(0)" ::: "memory");
            const unsigned og = xb_add(&bar[XB_TOP], 1u);
            const unsigned tg = og / nx;
            if (og + 1u == (tg + 1u) * nx) xb_add(&bar[XB_TOPGEN], 1u);
            else XB_SPIN(xb_ld(&bar[XB_TOPGEN]) == tg, bar);
            __builtin_amdgcn_fence(__ATOMIC_ACQUIRE, "agent");
            xb_add(&bar[XB_XGEN(b.x)], 1u);
            asm volatile("s_waitcnt vmcnt(0)" ::: "memory");
        } else {
            XB_SPIN(xb_ld(&bar[XB_XGEN(b.x)]) == gen, bar);
            __builtin_amdgcn_fence(__ATOMIC_ACQUIRE, "agent");
            asm volatile("s_waitcnt vmcnt(0)" ::: "memory");
        }
    }
    __syncthreads();
}

__device__ __forceinline__ void transpose_item(const float* __restrict__ W, int K, int N, bf16_t* __restrict__ WT, LAS float* scr, int item, int lane) {
    const int nblk = N / 32, kb = item / nblk, nb = item - kb * nblk, k0 = 64 * kb, n0 = 32 * nb;
    float tv[32];
#pragma unroll
    for (int i = 0; i < 32; ++i) { const int kk = 2 * i + (lane >> 5); tv[i] = W[(size_t)(k0 + kk) * N + n0 + (lane & 31)]; }
#pragma unroll
    for (int i = 0; i < 32; ++i) { const int kk = 2 * i + (lane >> 5); scr[kk * 33 + (lane & 31)] = tv[i]; }
    asm volatile("s_waitcnt lgkmcnt(0)" ::: "memory");
    const int c = lane & 7;
#pragma unroll
    for (int j = 0; j < 4; ++j) { const int n = (lane >> 3) + 8 * j; const LAS float* s = scr + (8 * c) * 33 + n;
        u32x4 o; o.x = pk2(s[0 * 33], s[1 * 33]); o.y = pk2(s[2 * 33], s[3 * 33]); o.z = pk2(s[4 * 33], s[5 * 33]); o.w = pk2(s[6 * 33], s[7 * 33]);
        *(u32x4*)(WT + (size_t)(n0 + n) * K + k0 + 8 * c) = o; }
    asm volatile("s_waitcnt lgkmcnt(0)" ::: "memory");
}

template <bool QUANT>
__device__ __forceinline__ void gate_weight_item(const float* __restrict__ W, int K, int N, unsigned char* __restrict__ W8, unsigned* colmax, int nbase, LAS float* scr, int item, int lane) {
    constexpr int NBG = 3 * DM / 32;
    const int kb = item / NBG, nb = item - kb * NBG, k0 = 64 * kb, n0 = nbase + 32 * nb;
    float tv[32];
#pragma unroll
    for (int i = 0; i < 32; ++i) { const int kk = 2 * i + (lane >> 5); tv[i] = W[(size_t)(k0 + kk) * N + n0 + (lane & 31)]; }
    if constexpr (!QUANT) {
        float mx = 0.f;
#pragma unroll
        for (int i = 0; i < 32; ++i) mx = fmaxf(mx, fabsf(tv[i]));
        mx = fmaxf(mx, __shfl_xor(mx, 32));
        if (lane < 32) atomicMax(colmax + (n0 - nbase) + lane, __float_as_uint(mx));
    } else {
        const float qs = 127.f / fmaxf(__uint_as_float(colmax[(n0 - nbase) + (lane & 31)]), 1e-30f);
#pragma unroll
        for (int i = 0; i < 32; ++i) { const int kk = 2 * i + (lane >> 5); scr[kk * 33 + (lane & 31)] = tv[i] * qs; }
        asm volatile("s_waitcnt lgkmcnt(0)" ::: "memory");
        const int n = lane >> 1, kh = (lane & 1) * 32;
        const LAS float* s = scr + kh * 33 + n;
        u32x4 o0, o1;
        o0.x = q8x4(s[0 * 33], s[1 * 33], s[2 * 33], s[3 * 33]);     o0.y = q8x4(s[4 * 33], s[5 * 33], s[6 * 33], s[7 * 33]);
        o0.z = q8x4(s[8 * 33], s[9 * 33], s[10 * 33], s[11 * 33]);   o0.w = q8x4(s[12 * 33], s[13 * 33], s[14 * 33], s[15 * 33]);
        o1.x = q8x4(s[16 * 33], s[17 * 33], s[18 * 33], s[19 * 33]); o1.y = q8x4(s[20 * 33], s[21 * 33], s[22 * 33], s[23 * 33]);
        o1.z = q8x4(s[24 * 33], s[25 * 33], s[26 * 33], s[27 * 33]); o1.w = q8x4(s[28 * 33], s[29 * 33], s[30 * 33], s[31 * 33]);
        unsigned char* dst = W8 + (size_t)(n0 - nbase + n) * K + k0 + kh;
        *(u32x4*)dst = o0; *(u32x4*)(dst + 16) = o1;
        asm volatile("s_waitcnt lgkmcnt(0)" ::: "memory");
    }
}

template <bool HAS_Y, bool WRITE_H>
__device__ __forceinline__ void row_pass(const float* __restrict__ xin, const bf16_t* __restrict__ Y, const float* __restrict__ post_g, float* xout,
                                         const float* __restrict__ pre_g, bf16_t* __restrict__ H, unsigned char* __restrict__ H8, float* __restrict__ HS, int gw, int NGW, int lane) {
    for (int row = gw; row < MT; row += NGW) {
        float xv[4][8];
#pragma unroll
        for (int j = 0; j < 4; ++j) { const int col = (j * 64 + lane) * 8; const f32x4 a = *(const f32x4*)(xin + (size_t)row * DM + col), b = *(const f32x4*)(xin + (size_t)row * DM + col + 4);
#pragma unroll
            for (int e = 0; e < 4; ++e) { xv[j][e] = a[e]; xv[j][4 + e] = b[e]; } }
        if constexpr (HAS_Y) {
            float yv[4][8]; float ss = 0.f;
#pragma unroll
            for (int j = 0; j < 4; ++j) { const int col = (j * 64 + lane) * 8; const u32x4 w = *(const u32x4*)(Y + (size_t)row * DM + col);
                yv[j][0] = bflo(w.x); yv[j][1] = bfhi(w.x); yv[j][2] = bflo(w.y); yv[j][3] = bfhi(w.y); yv[j][4] = bflo(w.z); yv[j][5] = bfhi(w.z); yv[j][6] = bflo(w.w); yv[j][7] = bfhi(w.w);
#pragma unroll
                for (int e = 0; e < 8; ++e) ss += yv[j][e] * yv[j][e]; }
            const float r = 1.0f / sqrtf(wave_sum(ss) * (1.0f / DM) + EPSN);
#pragma unroll
            for (int j = 0; j < 4; ++j) { const int col = (j * 64 + lane) * 8; const f32x4 ga = *(const f32x4*)(post_g + col), gb = *(const f32x4*)(post_g + col + 4);
#pragma unroll
                for (int e = 0; e < 4; ++e) { xv[j][e] += yv[j][e] * r * ga[e]; xv[j][4 + e] += yv[j][4 + e] * r * gb[e]; }
                *(f32x4*)(xout + (size_t)row * DM + col) = (f32x4){xv[j][0], xv[j][1], xv[j][2], xv[j][3]};
                *(f32x4*)(xout + (size_t)row * DM + col + 4) = (f32x4){xv[j][4], xv[j][5], xv[j][6], xv[j][7]}; }
        }
        if constexpr (WRITE_H) {
            float ss = 0.f;
#pragma unroll
            for (int j = 0; j < 4; ++j)
#pragma unroll
                for (int e = 0; e < 8; ++e) ss += xv[j][e] * xv[j][e];
            const float r = 1.0f / sqrtf(wave_sum(ss) * (1.0f / DM) + EPSN);
            float amax = 0.f;
#pragma unroll
            for (int j = 0; j < 4; ++j) { const int col = (j * 64 + lane) * 8; const f32x4 ga = *(const f32x4*)(pre_g + col), gb = *(const f32x4*)(pre_g + col + 4);
#pragma unroll
                for (int e = 0; e < 4; ++e) { xv[j][e] *= r * ga[e]; xv[j][4 + e] *= r * gb[e]; amax = fmaxf(amax, fmaxf(fabsf(xv[j][e]), fabsf(xv[j][4 + e]))); }
                u32x4 w; w.x = pk2(xv[j][0], xv[j][1]); w.y = pk2(xv[j][2], xv[j][3]); w.z = pk2(xv[j][4], xv[j][5]); w.w = pk2(xv[j][6], xv[j][7]);
                *(u32x4*)(H + (size_t)row * DM + col) = w; }
#pragma unroll
            for (int o = 1; o < 64; o <<= 1) amax = fmaxf(amax, __shfl_xor(amax, o));
            amax = fmaxf(amax, 1e-20f);
            const float qs = 127.f / amax;
            if (lane == 0) HS[row] = amax * (1.f / 127.f);
#pragma unroll
            for (int j = 0; j < 4; ++j) { const int col = (j * 64 + lane) * 8;
                u32x2 w8; w8.x = q8x4(xv[j][0] * qs, xv[j][1] * qs, xv[j][2] * qs, xv[j][3] * qs); w8.y = q8x4(xv[j][4] * qs, xv[j][5] * qs, xv[j][6] * qs, xv[j][7] * qs);
                *(u32x2*)(H8 + (size_t)row * DM + col) = w8; }
        }
    }
}

constexpr int ATP = 144;
constexpr int ATT_WAVE_LDS = 2 * 64 * ATP;
__device__ __forceinline__ void attn_item(const bf16_t* __restrict__ Q, const bf16_t* __restrict__ Kb, const bf16_t* __restrict__ VT, const bf16_t* __restrict__ GA,
                                          bf16_t* __restrict__ OA, const LAS float* btab, LAS unsigned char* wl, int b, int c, int h, int half, int lane) {
    const int r = lane & 31, hh = lane >> 5;
    const int rl = lane >> 3, cl = lane & 7;
    const int tokq = b * SEQ + c * 64 + half * 32;
    const int qloc = half * 32 + r;
    const int pr = (r & ~12) | ((r & 4) << 1) | ((r & 8) >> 1);
    const int jmin = c >= 8 ? 0 : 8 - c;
    const int tk0 = b * SEQ + (c - 8 + jmin) * 64;
    const bf16_t* kg = Kb + (size_t)(tk0 + rl) * DH + h * 64 + cl * 8;
    const bf16_t* vg = VT + (size_t)(h * 64 + rl) * PT + tk0 + cl * 8;
    LAS unsigned char* Kt = wl; LAS unsigned char* Vt = wl + 64 * ATP;
    const int stoff = rl * ATP + cl * 16;
    u32x4 kr[8], vr[8];
#pragma unroll
    for (int i = 0; i < 8; ++i) { kr[i] = *(const u32x4*)(kg + (size_t)(8 * i) * DH); vr[i] = *(const u32x4*)(vg + (size_t)(8 * i) * PT); }
    bf16x8 qf[4];
    { const bf16_t* qp = Q + (size_t)(tokq + r) * DH + h * 64 + 8 * hh;
#pragma unroll
      for (int d0 = 0; d0 < 4; ++d0) qf[d0] = *(const bf16x8*)(qp + d0 * 16); }
#pragma unroll
    for (int i = 0; i < 8; ++i) { *(LAS u32x4*)(Kt + stoff + 8 * i * ATP) = kr[i]; *(LAS u32x4*)(Vt + stoff + 8 * i * ATP) = vr[i]; }
    { const int adv = (jmin + 1 <= 8) ? 1 : 0; kg += (size_t)adv * 64 * DH; vg += adv * 64; }
#pragma unroll
    for (int i = 0; i < 8; ++i) { kr[i] = *(const u32x4*)(kg + (size_t)(8 * i) * DH); vr[i] = *(const u32x4*)(vg + (size_t)(8 * i) * PT); }
    f32x16 o0, o1;
#pragma unroll
    for (int i = 0; i < 16; ++i) { o0[i] = 0.f; o1[i] = 0.f; }
    float mrun = -1e30f, lrun = 0.f;
    const float cfar = btab[NREL - 1];
    const LAS unsigned char* kfp = Kt + pr * ATP + 16 * hh;
    const LAS unsigned char* vfp = Vt + r * ATP + 16 * hh;
    for (int j = jmin; j <= 8; ++j) {
        f32x16 s0, s1;
#pragma unroll
        for (int i = 0; i < 16; ++i) { s0[i] = 0.f; s1[i] = 0.f; }
#pragma unroll
        for (int d0 = 0; d0 < 4; ++d0) {
            const bf16x8 k0 = *(const LAS bf16x8*)(kfp + d0 * 32), k1 = *(const LAS bf16x8*)(kfp + 32 * ATP + d0 * 32);
            s0 = MFMA32(k0, qf[d0], s0); s1 = MFMA32(k1, qf[d0], s1);
        }
        if (j <= 3) {
#pragma unroll
            for (int i = 0; i < 16; ++i) { s0[i] += cfar; s1[i] += cfar; }
        } else {
            const int base = qloc + 64 * (8 - j) + 63 - 8 * hh;
#pragma unroll
            for (int i = 0; i < 16; ++i) {
                const int key = (i & 3) + 4 * ((i >> 2) & 1) + 16 * (i >> 3);
                int i0 = base - key, i1 = base - key - 32;
                i0 = i0 > NREL - 1 ? NREL - 1 : i0; i1 = i1 > NREL - 1 ? NREL - 1 : i1;
                s0[i] += btab[i0]; s1[i] += btab[i1];
            }
        }
        float tmax = fmaxf(s0[0], s1[0]);
#pragma unroll
        for (int i = 1; i < 16; ++i) tmax = fmaxf(tmax, fmaxf(s0[i], s1[i]));
        tmax = fmaxf(tmax, __shfl_xor(tmax, 32));
        const float mnew = fmaxf(mrun, tmax);
        const float alpha = __builtin_amdgcn_exp2f(mrun - mnew);
        mrun = mnew;
        float ls = 0.f;
#pragma unroll
        for (int i = 0; i < 16; ++i) { s0[i] = __builtin_amdgcn_exp2f(s0[i] - mnew); s1[i] = __builtin_amdgcn_exp2f(s1[i] - mnew); ls += s0[i] + s1[i]; }
        lrun = lrun * alpha + ls;
#pragma unroll
        for (int i = 0; i < 16; ++i) { o0[i] *= alpha; o1[i] *= alpha; }
#pragma unroll
        for (int s = 0; s < 2; ++s) {
            u32x4 pa, pb;
            pa.x = pk2(s0[8 * s + 0], s0[8 * s + 1]); pa.y = pk2(s0[8 * s + 2], s0[8 * s + 3]); pa.z = pk2(s0[8 * s + 4], s0[8 * s + 5]); pa.w = pk2(s0[8 * s + 6], s0[8 * s + 7]);
            pb.x = pk2(s1[8 * s + 0], s1[8 * s + 1]); pb.y = pk2(s1[8 * s + 2], s1[8 * s + 3]); pb.z = pk2(s1[8 * s + 4], s1[8 * s + 5]); pb.w = pk2(s1[8 * s + 6], s1[8 * s + 7]);
            const bf16x8 va0 = *(const LAS bf16x8*)(vfp + 32 * s), va1 = *(const LAS bf16x8*)(vfp + 32 * ATP + 32 * s);
            const bf16x8 vb0 = *(const LAS bf16x8*)(vfp + 64 + 32 * s), vb1 = *(const LAS bf16x8*)(vfp + 32 * ATP + 64 + 32 * s);
            o0 = MFMA32(va0, __builtin_bit_cast(bf16x8, pa), o0); o1 = MFMA32(va1, __builtin_bit_cast(bf16x8, pa), o1);
            o0 = MFMA32(vb0, __builtin_bit_cast(bf16x8, pb), o0); o1 = MFMA32(vb1, __builtin_bit_cast(bf16x8, pb), o1);
        }
#pragma unroll
        for (int i = 0; i < 8; ++i) { *(LAS u32x4*)(Kt + stoff + 8 * i * ATP) = kr[i]; *(LAS u32x4*)(Vt + stoff + 8 * i * ATP) = vr[i]; }
        { const int adv = (j + 2 <= 8) ? 1 : 0; kg += (size_t)adv * 64 * DH; vg += adv * 64; }
#pragma unroll
        for (int i = 0; i < 8; ++i) { kr[i] = *(const u32x4*)(kg + (size_t)(8 * i) * DH); vr[i] = *(const u32x4*)(vg + (size_t)(8 * i) * PT); }
    }
    const float l = lrun + __shfl_xor(lrun, 32);
    const float inv = 1.0f / l;
    LAS unsigned char* Ot = wl;
#pragma unroll
    for (int g = 0; g < 4; ++g) {
#pragma unroll
        for (int db = 0; db < 2; ++db) {
            const f32x16& o = db ? o1 : o0;
            u32x2 w; w.x = pk2(o[4 * g + 0] * inv, o[4 * g + 1] * inv); w.y = pk2(o[4 * g + 2] * inv, o[4 * g + 3] * inv);
            *(LAS u32x2*)(Ot + r * ATP + (db * 32 + 8 * g + 4 * hh) * 2) = w;
        }
    }
#pragma unroll
    for (int i = 0; i < 4; ++i) {
        const int row = rl + 8 * i;
        const size_t a = (size_t)(tokq + row) * DH + h * 64 + cl * 8;
        const u32x4 gg = *(const u32x4*)(GA + a);
        const u32x4 ov = *(const LAS u32x4*)(Ot + row * ATP + cl * 16);
        u32x4 w; w.x = pk2(bflo(ov.x) * bflo(gg.x), bfhi(ov.x) * bfhi(gg.x)); w.y = pk2(bflo(ov.y) * bflo(gg.y), bfhi(ov.y) * bfhi(gg.y));
        w.z = pk2(bflo(ov.z) * bflo(gg.z), bfhi(ov.z) * bfhi(gg.z)); w.w = pk2(bflo(ov.w) * bflo(gg.w), bfhi(ov.w) * bfhi(gg.w));
        *(u32x4*)(OA + a) = w;
    }
}

__device__ __forceinline__ void unpack8(const u32x4 w, float* v) { v[0] = bflo(w.x); v[1] = bfhi(w.x); v[2] = bflo(w.y); v[3] = bfhi(w.y); v[4] = bflo(w.z); v[5] = bfhi(w.z); v[6] = bflo(w.w); v[7] = bfhi(w.w); }
__device__ __forceinline__ void conv_unit(const bf16_t* __restrict__ BB, const bf16_t* __restrict__ CC, const bf16_t* __restrict__ HB, const bf16_t* __restrict__ GB,
                                          bf16_t* __restrict__ OB, const float* __restrict__ cw, int unit, int tid) {
    const int cgp = tid & 127, sub = tid >> 7, ch = cgp * 8;
    const int t0 = unit * 32 + sub * 8;
    float w0[8], w1[8], w2[8];
#pragma unroll
    for (int e = 0; e < 8; ++e) { w0[e] = cw[ch + e]; w1[e] = cw[DH + ch + e]; w2[e] = cw[2 * DH + ch + e]; }
    float p2[8], p1[8];
#pragma unroll
    for (int e = 0; e < 8; ++e) { p2[e] = 0.f; p1[e] = 0.f; }
    const int tpos = t0 & (SEQ - 1);
    if (tpos >= 2) { float a[8], b[8]; unpack8(*(const u32x4*)(CC + (size_t)(t0 - 2) * DH + ch), a); unpack8(*(const u32x4*)(HB + (size_t)(t0 - 2) * DH + ch), b);
#pragma unroll
        for (int e = 0; e < 8; ++e) p2[e] = a[e] * b[e]; }
    if (tpos >= 1) { float a[8], b[8]; unpack8(*(const u32x4*)(CC + (size_t)(t0 - 1) * DH + ch), a); unpack8(*(const u32x4*)(HB + (size_t)(t0 - 1) * DH + ch), b);
#pragma unroll
        for (int e = 0; e < 8; ++e) p1[e] = a[e] * b[e]; }
#pragma unroll
    for (int i = 0; i < 8; ++i) {
        const size_t off = (size_t)(t0 + i) * DH + ch;
        float a[8], b[8], g1[8], g2[8], o[8];
        unpack8(*(const u32x4*)(CC + off), a); unpack8(*(const u32x4*)(HB + off), b); unpack8(*(const u32x4*)(BB + off), g1); unpack8(*(const u32x4*)(GB + off), g2);
#pragma unroll
        for (int e = 0; e < 8; ++e) { const float cur = a[e] * b[e]; o[e] = g1[e] * (w0[e] * p2[e] + w1[e] * p1[e] + w2[e] * cur) * g2[e]; p2[e] = p1[e]; p1[e] = cur; }
        u32x4 w; w.x = pk2(o[0], o[1]); w.y = pk2(o[2], o[3]); w.z = pk2(o[4], o[5]); w.w = pk2(o[6], o[7]);
        *(u32x4*)(OB + off) = w;
    }
}

template <int tbA, int tbB>
__device__ __forceinline__ void sgu_groups(const bf16_t* __restrict__ VCT, const bf16_t* __restrict__ U, const bf16_t* __restrict__ GC, bf16_t* __restrict__ OC,
                                           const bf16_t* __restrict__ Wbf, const float* __restrict__ spb, const float* __restrict__ lng, const float* __restrict__ lnb,
                                           int tok0, int gh, int cb, int r, int hh, const LAS float* stat) {
    for (int gi = 0; gi < 4; ++gi) {
        const int g = gh * 4 + gi;
        const int ch = g * 128 + cb * 32 + r;
        const float gg = lng[ch], bb = lnb[ch];
        const bf16_t* ap = VCT + (size_t)ch * PT + tok0 + 8 * hh;
        const bf16_t* wp = Wbf + (size_t)g * 16384 + 8 * hh;
        constexpr int NSB = (tbB + 1) * 2, NSA = (tbA + 1) * 2;
        int so = 0; asm volatile("" : "+v"(so));
        u32x4 raw[NSB]; bf16x8 wB[NSB], wA[NSA];
#pragma unroll
        for (int k = 0; k < NSB; ++k) { raw[k] = *(const u32x4*)(ap + 16 * k); wB[k] = *(const bf16x8*)(wp + (size_t)(tbB * 32 + r) * 128 + 16 * k); }
#pragma unroll
        for (int k = 0; k < NSA; ++k) wA[k] = *(const bf16x8*)(wp + (size_t)(tbA * 32 + r) * 128 + 16 * k);
        f32x16 accA, accB;
#pragma unroll
        for (int i = 0; i < 16; ++i) { accA[i] = 0.f; accB[i] = 0.f; }
#pragma unroll
        for (int k = 0; k < NSB; ++k) {
            float v[8]; unpack8(raw[k], v);
#pragma unroll
            for (int jj = 0; jj < 8; ++jj) { const float mean = stat[(16 * k + 8 * hh + jj) * 2 + so], rstd = stat[(16 * k + 8 * hh + jj) * 2 + 1 + so]; v[jj] = (v[jj] - mean) * rstd * gg + bb; }
            u32x4 af; af.x = pk2(v[0], v[1]); af.y = pk2(v[2], v[3]); af.z = pk2(v[4], v[5]); af.w = pk2(v[6], v[7]);
            accB = MFMA32(__builtin_bit_cast(bf16x8, af), wB[k], accB);
            if (k < NSA) accA = MFMA32(__builtin_bit_cast(bf16x8, af), wA[k < NSA ? k : 0], accA);
        }
        u32x2 uu[2][4], gc[2][4]; float sb[2];
#pragma unroll
        for (int which = 0; which < 2; ++which) { const int t = (which ? tbB : tbA) * 32 + r; sb[which] = spb[g * 128 + t];
            const size_t rowoff = (size_t)(tok0 + t) * DH + g * 128 + cb * 32 + 4 * hh;
#pragma unroll
            for (int q = 0; q < 4; ++q) { uu[which][q] = *(const u32x2*)(U + rowoff + 8 * q); gc[which][q] = *(const u32x2*)(GC + rowoff + 8 * q); } }
#pragma unroll
        for (int which = 0; which < 2; ++which) {
            const int tb = which ? tbB : tbA; const f32x16& acc = which ? accB : accA;
            const int t = tb * 32 + r; const float sbv = sb[which];
            const size_t rowoff = (size_t)(tok0 + t) * DH + g * 128 + cb * 32 + 4 * hh;
#pragma unroll
            for (int q = 0; q < 4; ++q) {
                const u32x2 u2 = uu[which][q], g2 = gc[which][q];
                u32x2 o; o.x = pk2(bflo(u2.x) * (acc[4 * q + 0] + sbv) * bflo(g2.x), bfhi(u2.x) * (acc[4 * q + 1] + sbv) * bfhi(g2.x));
                o.y = pk2(bflo(u2.y) * (acc[4 * q + 2] + sbv) * bflo(g2.y), bfhi(u2.y) * (acc[4 * q + 3] + sbv) * bfhi(g2.y));
                *(u32x2*)(OC + rowoff + 8 * q) = o;
            }
        }
    }
}

__device__ __forceinline__ void sgu_unit(const bf16_t* __restrict__ VCT, const bf16_t* __restrict__ U, const bf16_t* __restrict__ GC, bf16_t* __restrict__ OC,
                                         const bf16_t* __restrict__ Wbf, const float* __restrict__ spb, const float* __restrict__ lng, const float* __restrict__ lnb,
                                         int b, int n, int gh, LAS unsigned char* lds, int tid) {
    const int lane = tid & 63, w = __builtin_amdgcn_readfirstlane(tid >> 6), r = lane & 31, hh = lane >> 5;
    const int tok0 = b * SEQ + n * 128;
    __syncthreads();
    LAS float* part = (LAS float*)lds;
    LAS float* stat = part + 8 * 128 * 2;
    {
        const int tl = lane & 15, cq = lane >> 4;
        const bf16_t* p = VCT + (size_t)(w * 128 + cq) * PT + tok0 + 8 * tl;
        float sm[8], sq[8];
#pragma unroll
        for (int e = 0; e < 8; ++e) { sm[e] = 0.f; sq[e] = 0.f; }
#pragma unroll 8
        for (int c4 = 0; c4 < 32; ++c4) { float v[8]; unpack8(*(const u32x4*)(p + (size_t)(c4 * 4) * PT), v);
#pragma unroll
            for (int e = 0; e < 8; ++e) { sm[e] += v[e]; sq[e] += v[e] * v[e]; } }
#pragma unroll
        for (int e = 0; e < 8; ++e) { sm[e] += __shfl_xor(sm[e], 16); sm[e] += __shfl_xor(sm[e], 32); sq[e] += __shfl_xor(sq[e], 16); sq[e] += __shfl_xor(sq[e], 32); }
        if (cq == 0) {
#pragma unroll
            for (int e = 0; e < 8; ++e) { part[(w * 128 + 8 * tl + e) * 2 + 0] = sm[e]; part[(w * 128 + 8 * tl + e) * 2 + 1] = sq[e]; }
        }
    }
    __syncthreads();
    if (tid < 128) {
        float S = 0.f, SS = 0.f;
#pragma unroll
        for (int ww = 0; ww < 8; ++ww) { S += part[(ww * 128 + tid) * 2]; SS += part[(ww * 128 + tid) * 2 + 1]; }
        const float mean = S * (1.0f / DH); const float var = fmaxf(SS * (1.0f / DH) - mean * mean, 0.f);
        stat[tid * 2] = mean; stat[tid * 2 + 1] = 1.0f / sqrtf(var + EPSN);
    }
    __syncthreads();
    if ((w >> 2) == 0) sgu_groups<0, 3>(VCT, U, GC, OC, Wbf, spb, lng, lnb, tok0, gh, w & 3, r, hh, stat);
    else sgu_groups<1, 2>(VCT, U, GC, OC, Wbf, spb, lng, lnb, tok0, gh, w & 3, r, hh, stat);
    __syncthreads();
}

#ifndef X_ATT
#define X_ATT 0
#endif
#ifndef X_CONV
#define X_CONV 0
#endif
#ifndef X_SGU
#define X_SGU 0
#endif
struct Args { const float* in[14]; float* out; unsigned char* ws; int ph_lo, ph_hi; };
constexpr int NPH = 11;

__device__ __forceinline__ void phase_prologue(const Args& args, LAS unsigned char* lds) {
    const int tid = threadIdx.x, lane = tid & 63, wave = __builtin_amdgcn_readfirstlane(tid >> 6);
    const int G = gridDim.x, blk = blockIdx.x, gw = blk * 8 + wave, NGW = G * 8;
    unsigned char* ws = args.ws;
    LAS float* scr = (LAS float*)(lds + wave * 16384);
    constexpr int I_IN = (DM / 64) * (NIN / 32), I_BR = (DH / 64) * (DM / 32), I_OUT = (DM / 64) * (DM / 32);
    constexpr int PER_L = I_IN + 3 * I_BR + I_OUT;
    for (int it = gw; it < 2 * PER_L; it += NGW) {
        const int l = it / PER_L; int r = it - l * PER_L;
        if (r < I_IN) { const int kb = r / (NIN / 32), nb = r - kb * (NIN / 32);
            if (nb * 32 < NBF) transpose_item(args.in[2] + (size_t)l * DM * NIN, DM, NIN, (bf16_t*)(ws + WS_WIN + (size_t)l * 68 * MiB), scr, r, lane);
            else gate_weight_item<false>(args.in[2] + (size_t)l * DM * NIN, DM, NIN, nullptr, (unsigned*)(ws + WS_COLMAX) + l * 3 * DM, NBF, scr, kb * (3 * DM / 32) + (nb - NBF / 32), lane);
            continue; } r -= I_IN;
        if (r < 3 * I_BR) { const int br = r / I_BR; r -= br * I_BR; const float* src = (br == 0 ? args.in[9] : (br == 1 ? args.in[10] : args.in[11])) + (size_t)l * DH * DM;
            transpose_item(src, DH, DM, (bf16_t*)(ws + WS_WBR + (size_t)(l * 3 + br) * 4 * MiB), scr, r, lane); continue; } r -= 3 * I_BR;
        transpose_item(args.in[12] + (size_t)l * DM * DM, DM, DM, (bf16_t*)(ws + WS_WOUT + (size_t)l * 8 * MiB), scr, r, lane);
    }
    { bf16_t* wb = (bf16_t*)(ws + WS_SGUW); const float* sp_w = args.in[7];
      for (int e = blk * 512 + tid; e < 2 * 8 * 128 * 128; e += G * 512) { const int t = (e >> 7) & 127, s = e & 127; const unsigned p = pk2(sp_w[e], 0.f); wb[e] = (s <= t) ? (bf16_t)(p & 0xffffu) : (bf16_t)0; } }
    row_pass<false, true>(args.in[0], nullptr, nullptr, nullptr, args.in[1], (bf16_t*)(ws + WS_H), ws + WS_H8, (float*)(ws + WS_HS), gw, NGW, lane);
}

__device__ __forceinline__ void phase_quant(const Args& args, LAS unsigned char* lds) {
    const int tid = threadIdx.x, lane = tid & 63, wave = __builtin_amdgcn_readfirstlane(tid >> 6);
    const int gw = blockIdx.x * 8 + wave, NGW = gridDim.x * 8;
    unsigned char* ws = args.ws;
    LAS float* scr = (LAS float*)(lds + wave * 16384);
    constexpr int PER_L = (DM / 64) * (3 * DM / 32);
    for (int it = gw; it < 2 * PER_L; it += NGW) {
        const int l = it / PER_L, r = it - l * PER_L;
        gate_weight_item<true>(args.in[2] + (size_t)l * DM * NIN, DM, NIN, ws + WS_W8 + (size_t)l * 12 * MiB, (unsigned*)(ws + WS_COLMAX) + l * 3 * DM, NBF, scr, r, lane);
    }
}

template <int L> __device__ __forceinline__ void phase_in(const Args& args, LAS unsigned char* lds) {
    unsigned char* ws = args.ws;
    {
        pg8::Gemm g{(const bf16_t*)(ws + WS_H), (const bf16_t*)(ws + WS_WIN + (size_t)L * 68 * MiB), MT, NBF, DM, 0, 0};
        pg8::TileOrder<1> S; S.init(MT, NBF, gridDim.x, blockIdx.x);
        pg8::EpiIn E{ws + WS_SEG, (bf16_t*)(ws + WS_GATES), (bf16_t*)(ws + WS_VT), (bf16_t*)(ws + WS_VCT)};
        pg8::gemm_phase<pg8::EpiIn, pg8::TileOrder<1>, true>(lds, g, S, E);
    }
    {
        pg8::Gemm g{(const bf16_t*)(ws + WS_H8), (const bf16_t*)(ws + WS_W8 + (size_t)L * 12 * MiB), MT, 3 * DM, DM / 2, 0, 0};
        pg8::TileOrder<1> S; S.init(MT, 3 * DM, gridDim.x, blockIdx.x);
        pg8::EpiGate8 E{(bf16_t*)(ws + WS_GATES), (const float*)(ws + WS_HS), (const float*)(ws + WS_COLMAX) + L * 3 * DM};
        pg8::gemm_phase<pg8::EpiGate8, pg8::TileOrder<1>, true, true>(lds, g, S, E);
    }
}

template <int L> __device__ __forceinline__ void phase_mix(const Args& args, LAS unsigned char* lds) {
    const int tid = threadIdx.x, lane = tid & 63, wave = __builtin_amdgcn_readfirstlane(tid >> 6);
    const int G = gridDim.x, blk = blockIdx.x;
    unsigned char* ws = args.ws;
    const bf16_t* segb = (const bf16_t*)(ws + WS_SEG);
    bf16_t* OA = (bf16_t*)(ws + WS_O);
    constexpr size_t SE = (size_t)MT * DH;
    LAS float* btab = (LAS float*)(lds + 8 * ATT_WAVE_LDS + wave * 1280);
    LAS unsigned char* wl = lds + wave * ATT_WAVE_LDS;
    int cur_h = -1;
    constexpr int XA = (L == 0 ? X_ATT : 0) * 1024, XC = (L == 0 ? X_CONV : 0) * 512, XS = (L == 0 ? X_SGU : 0) * 256;
    for (int uu = blk; uu < 1792 + XA + XC + XS; uu += G) {
        int u = uu;
        if (uu >= 1792) { const int x = uu - 1792; u = x < XA ? (x & 1023) : (x < XA + XC ? 1024 + ((x - XA) & 511) : 1536 + ((x - XA - XC) & 255)); }
        if (u < 1024) {
            const int hg = u & 3, b = (u >> 2) & 7, c = u >> 5;
            const int h = hg * 4 + (wave >> 1), half = wave & 1;
            if (h != cur_h) { const float* rb = args.in[3] + (size_t)(L * 16 + h) * NREL;
#pragma unroll
                for (int i = 0; i < 5; ++i) btab[i * 64 + lane] = rb[i * 64 + lane] * LOG2E;
                cur_h = h; }
            attn_item(segb, segb + SE, (const bf16_t*)(ws + WS_VT), segb + 3 * SE, OA, btab, wl, b, c, h, half, lane);
        } else if (u < 1536) {
            conv_unit(segb + 4 * SE, segb + 5 * SE, segb + 6 * SE, segb + 7 * SE, OA + SE, args.in[4] + (size_t)L * 3 * DH, u - 1024, tid);
        } else {
            const int su = u - 1536; const int gh = su & 1, n = (su >> 1) & 15, b = su >> 5;
            sgu_unit((const bf16_t*)(ws + WS_VCT), segb + 8 * SE, segb + 10 * SE, OA + 2 * SE, (const bf16_t*)(ws + WS_SGUW) + (size_t)L * 8 * 16384, args.in[8] + (size_t)L * 8 * 128,
                     args.in[5] + (size_t)L * DH, args.in[6] + (size_t)L * DH, b, n, gh, lds, tid);
        }
    }
}

template <int L> __device__ __forceinline__ void phase_br(const Args& args, LAS unsigned char* lds) {
    unsigned char* ws = args.ws;
    pg8::Gemm g{(const bf16_t*)(ws + WS_O), (const bf16_t*)(ws + WS_WBR + (size_t)L * 12 * MiB), MT, DM, DH, (size_t)32 * MiB, (size_t)4 * MiB};
    pg8::TileOrder<3> S; S.init(MT, DM, gridDim.x, blockIdx.x);
    pg8::EpiMerge E{(const bf16_t*)(ws + WS_GATES), (bf16_t*)(ws + WS_MERGED16)};
    pg8::gemm_phase<pg8::EpiMerge, pg8::TileOrder<3>, true>(lds, g, S, E);
}

template <int L> __device__ __forceinline__ void phase_out(const Args& args, LAS unsigned char* lds) {
    unsigned char* ws = args.ws;
    pg8::Gemm g{(const bf16_t*)(ws + WS_MERGED16), (const bf16_t*)(ws + WS_WOUT + (size_t)L * 8 * MiB), MT, DM, DM, 0, 0};
    pg8::TileOrder<1> S; S.init(MT, DM, gridDim.x, blockIdx.x);
    pg8::EpiPlain E{(bf16_t*)(ws + WS_Y), DM};
    pg8::gemm_phase<pg8::EpiPlain, pg8::TileOrder<1>, true>(lds, g, S, E);
}

template <int L> __device__ __forceinline__ void phase_row(const Args& args) {
    const int tid = threadIdx.x, lane = tid & 63, wave = __builtin_amdgcn_readfirstlane(tid >> 6);
    const int gw = blockIdx.x * 8 + wave, NGW = gridDim.x * 8;
    unsigned char* ws = args.ws;
    if (L == 0) row_pass<true, true>(args.in[0], (const bf16_t*)(ws + WS_Y), args.in[13], args.out, args.in[1] + DM, (bf16_t*)(ws + WS_H), ws + WS_H8, (float*)(ws + WS_HS), gw, NGW, lane);
    else row_pass<true, false>(args.out, (const bf16_t*)(ws + WS_Y), args.in[13] + DM, args.out, nullptr, nullptr, nullptr, nullptr, gw, NGW, lane);
}

__global__ void __launch_bounds__(512, 2) mk_fwd(const Args args) {
    extern __shared__ __attribute__((aligned(16))) unsigned char lds_raw[];
    LAS unsigned char* lds = (LAS unsigned char*)lds_raw;
    const int lo = args.ph_lo, hi = args.ph_hi;
    volatile LAS unsigned* bst = (volatile LAS unsigned*)(lds + LDS_BYTES - 64);
    if (threadIdx.x < 2) bst[threadIdx.x] = 0u;
    __syncthreads();
    XcdBarrier xbar; xbar.bar = (unsigned*)args.ws; xbar.x = 0; xbar.st = nullptr;
    if (hi - lo > 1) xbar = xcd_barrier_post((unsigned*)args.ws, bst);
#define IN(k) (lo <= (k) && (k) < hi)
#define SEAM(k) do { if (IN((k) + 1)) xcd_barrier(xbar); } while (0)
    if (hi > NPH) cg::this_grid().sync();
#ifndef REP_PRO
#define REP_PRO 1
#endif
#ifndef REP_IN
#define REP_IN 1
#endif
#ifndef REP_MIX
#define REP_MIX 1
#endif
#ifndef REP_BR
#define REP_BR 1
#endif
#ifndef REP_OUT
#define REP_OUT 1
#endif
#ifndef REP_ROW
#define REP_ROW 1
#endif
#ifndef REP_SYNC
#define REP_SYNC 0
#endif
    if (IN(0)) { phase_prologue(args, lds); xcd_barrier(xbar); phase_quant(args, lds); SEAM(0); }
    if (IN(1)) { for (int rep = 0; rep < REP_IN; ++rep) phase_in<0>(args, lds); SEAM(1); }
    if (IN(2)) { for (int rep = 0; rep < REP_MIX; ++rep) phase_mix<0>(args, lds); SEAM(2); }
    if (IN(3)) { for (int rep = 0; rep < REP_BR; ++rep) phase_br<0>(args, lds); SEAM(3); }
    if (IN(4)) { for (int rep = 0; rep < REP_OUT; ++rep) phase_out<0>(args, lds); SEAM(4); }
    if (IN(5)) { for (int rep = 0; rep < REP_ROW; ++rep) phase_row<0>(args); SEAM(5); }
    if (IN(6)) { phase_in<1>(args, lds); SEAM(6); }
    if (IN(7)) { phase_mix<1>(args, lds); SEAM(7); }
    if (IN(8)) { phase_br<1>(args, lds); SEAM(8); }
    if (IN(9)) { phase_out<1>(args, lds); SEAM(9); }
    if (IN(10)) { phase_row<1>(args); }
#undef IN
#undef SEAM
}

extern "C" void kernel_launch(void* const* d_in, const int* in_sizes, int n_in, void* d_out, int out_size, void* d_ws, size_t ws_size, hipStream_t stream) {
    static int grid = 0;
    if (grid == 0) {
        if (n_in != 14 || out_size != MT * DM || ws_size < WS_END) { fprintf(stderr, "kernel_launch: unexpected shapes (n_in %d out %d ws %zu)\n", n_in, out_size, ws_size); grid = -1; return; }
        int dev = 0, cus = 0, per_cu = 0;
        hipGetDevice(&dev);
        hipDeviceGetAttribute(&cus, hipDeviceAttributeMultiprocessorCount, dev);
        if (hipFuncSetAttribute((const void*)mk_fwd, hipFuncAttributeMaxDynamicSharedMemorySize, LDS_BYTES) != hipSuccess) { fprintf(stderr, "kernel_launch: hipFuncSetAttribute failed\n"); grid = -1; return; }
        if (hipOccupancyMaxActiveBlocksPerMultiprocessor(&per_cu, (const void*)mk_fwd, 512, LDS_BYTES) != hipSuccess || per_cu < 1) { fprintf(stderr, "kernel_launch: occupancy query says %d\n", per_cu); per_cu = 1; }
        (void)hipGetLastError();
        grid = cus * 1;
    }
    if (grid < 0) return;
    (void)hipMemsetAsync(d_ws, 0, 65536, stream);
    Args a{};
    for (int i = 0; i < 14; ++i) a.in[i] = (const float*)d_in[i];
    a.out = (float*)d_out; a.ws = (unsigned char*)d_ws;
#if MK_N_LAUNCHES == 1
    a.ph_lo = 0; a.ph_hi = NPH;
    void* kargs[] = {&a};
    hipError_t e = hipLaunchCooperativeKernel((const void*)mk_fwd, dim3(grid), dim3(512), kargs, LDS_BYTES, stream);
    if (e != hipSuccess) fprintf(stderr, "cooperative launch failed: %s (grid %d)\n", hipGetErrorString(e), grid);
#else
    for (int p = 0; p < NPH; ++p) { a.ph_lo = p; a.ph_hi = p + 1; hipLaunchKernelGGL(mk_fwd, dim3(grid), dim3(512), LDS_BYTES, stream, a); }
#endif
}
```

```cpp
#include <hip/hip_runtime.h>
#include <hip/hip_cooperative_groups.h>
#include <cstdio>
#include <cstdint>
namespace cg = cooperative_groups;

#define LAS __attribute__((address_space(3)))
typedef unsigned short bf16_t;
typedef short bf16x8 __attribute__((ext_vector_type(8)));
typedef float f32x4 __attribute__((ext_vector_type(4)));
typedef float f32x2 __attribute__((ext_vector_type(2)));
typedef float f32x16 __attribute__((ext_vector_type(16)));
typedef unsigned u32x4 __attribute__((ext_vector_type(4)));
typedef unsigned u32x2 __attribute__((ext_vector_type(2)));
typedef __bf16 bf16x2_t __attribute__((ext_vector_type(2)));
typedef int i32x4 __attribute__((ext_vector_type(4)));

#ifndef MK_N_LAUNCHES
#define MK_N_LAUNCHES 1
#endif

constexpr int MT = 16384;
constexpr int SEQ = 2048;
constexpr int DM = 2048;
constexpr int NIN = 17408;
constexpr int DH = 1024;
constexpr int NREL = 320;
constexpr int PT = MT + 64;
constexpr float LOG2E = 1.4426950408889634f;
constexpr float QSCALE = 0.125f * LOG2E;
constexpr float EPSN = 1e-6f;
constexpr int NBF = 8 * 1024; constexpr int NI8 = NIN - NBF;

constexpr size_t MiB = 1u << 20;
constexpr size_t WS_WIN = 2 * MiB;
constexpr size_t WS_WBR = 138 * MiB;
constexpr size_t WS_WOUT = 162 * MiB;
constexpr size_t WS_H = 178 * MiB;
constexpr size_t WS_SEG = 242 * MiB;
constexpr size_t WS_GATES = 594 * MiB;
constexpr size_t WS_O = 786 * MiB;
constexpr size_t WS_SGUW = 882 * MiB;
constexpr size_t WS_VT = 884 * MiB;
constexpr size_t WS_VCT = 918 * MiB;
constexpr size_t WS_H8 = 952 * MiB;
constexpr size_t WS_W8 = 984 * MiB;
constexpr size_t WS_HS = 1020 * MiB;
constexpr size_t WS_END = 1021 * MiB;
constexpr size_t WS_COLMAX = 16384;
constexpr size_t SEGB = 32 * MiB;
constexpr size_t WS_MERGED32 = WS_SEG;
constexpr size_t WS_MERGED16 = WS_SEG + 4 * SEGB;
constexpr size_t WS_Y = WS_SEG + 6 * SEGB;

constexpr int LDS_BYTES = 163840;

__device__ __forceinline__ unsigned pk2(float lo, float hi) { f32x2 v = {lo, hi}; bf16x2_t b = __builtin_convertvector(v, bf16x2_t); return __builtin_bit_cast(unsigned, b); }
__device__ __forceinline__ unsigned q8x4(float a, float b, float c, float d) {
    const int ia = (int)__builtin_rintf(a), ib = (int)__builtin_rintf(b), ic = (int)__builtin_rintf(c), id = (int)__builtin_rintf(d);
    return (unsigned)(ia & 0xff) | ((unsigned)(ib & 0xff) << 8) | ((unsigned)(ic & 0xff) << 16) | ((unsigned)id << 24); }
__device__ __forceinline__ float bflo(unsigned u) { return __uint_as_float(u << 16); }
__device__ __forceinline__ float bfhi(unsigned u) { return __uint_as_float(u & 0xffff0000u); }
__device__ __forceinline__ float fast_sigmoid(float w) { return __builtin_amdgcn_rcpf(1.0f + __builtin_amdgcn_exp2f(-w * LOG2E)); }
__device__ __forceinline__ float wave_sum(float v) {
#pragma unroll
    for (int o = 1; o < 64; o <<= 1) v += __shfl_xor(v, o);
    return v;
}
#define MFMA32(a, b, c) __builtin_amdgcn_mfma_f32_32x32x16_bf16((a), (b), (c), 0, 0, 0)

namespace pg8 {
constexpr int BM = 256, BK = 64, HALF = 128, HTB = HALF * BK * 2, STAGE_BYTES = 8 * HTB, NXCD = 8, WGM = 8;
__device__ __forceinline__ int lds_byte(int r, int c) { const int st = (r >> 4) * 2 + (c >> 5), rr = r & 15, cc = c & 31, ob = rr * 64 + cc * 2; return st * 1024 + (ob ^ (((ob >> 9) & 1) << 5)); }
__device__ __forceinline__ void stage_rc(int b, int& R, int& C) { const int st = b / 1024, sb = b % 1024, swz = sb ^ (((sb >> 9) & 1) << 5); R = (st >> 1) * 16 + swz / 64; C = (st & 1) * 32 + (swz % 64) / 2; }
__device__ __forceinline__ int perm32(int rho) { const int n = rho >> 4, i = rho & 15; return 8 * (i >> 2) + 4 * n + (i & 3); }

struct Unit { int pm, pn, z; };
struct Gemm { const bf16_t* A; const bf16_t* Bt; int M, N, K; size_t zA, zB; };

template <int NZ> struct TileOrder {
    int nM, nN, nwg, G, c;
    __device__ void init(int M, int N, int G_, int c_) { nM = M / BM; nN = N / BM; nwg = nM * nN; G = G_; c = c_; }
    __device__ bool next(int i, Unit& u) const {
        const int ti = i / NZ; u.z = i - ti * NZ;
        const long L = (long)ti * G + c; if (L >= nwg) return false;
        int wgid = (int)L; { const int q = nwg / NXCD, r = nwg % NXCD, xcd = wgid % NXCD, off = wgid / NXCD; wgid = (xcd < r ? xcd * (q + 1) : r * (q + 1) + (xcd - r) * q) + off; }
        const int nig = WGM * nN, gid = wgid / nig, fm = gid * WGM, gsz = (nM - fm) < WGM ? (nM - fm) : WGM;
        u.pm = fm + ((wgid % nig) % gsz); u.pn = (wgid % nig) / gsz; return true;
    }
};


template <int MODE> __device__ __forceinline__ f32x2 act2(f32x2 v, float sc) {
    if constexpr (MODE == 0) return v * sc;
    f32x2 t;
    if constexpr (MODE == 2) { const f32x2 x2 = v * v; t = v * (x2 * (-0.10294325f) + (-2.3022082f)); }
    else t = v * (-LOG2E);
    if constexpr (MODE == 3) { t.x = fminf(t.x, 20.f); t.y = fminf(t.y, 20.f); }
    f32x2 d; d.x = __builtin_amdgcn_exp2f(t.x); d.y = __builtin_amdgcn_exp2f(t.y);
    d = d + 1.0f;
    f32x2 r; r.x = __builtin_amdgcn_rcpf(d.x); r.y = __builtin_amdgcn_rcpf(d.y);
    if constexpr (MODE == 3) return r;
    return v * r;
}
template <int MODE, bool TR, bool I8 = false>
__device__ __forceinline__ void epi_in_tile(const f32x4 (&acc)[2][2][4][2], bf16_t* __restrict__ base, int ldc, int row0, int col0, float sc,
                                            const float* __restrict__ hs = nullptr, const float* __restrict__ cmx = nullptr) {
    f32x4 cs[2][2];
    if constexpr (I8) {
#pragma unroll
        for (int bj = 0; bj < 2; ++bj) { cs[bj][0] = *(const f32x4*)(cmx + bj * HALF) * (1.f / 127.f); cs[bj][1] = *(const f32x4*)(cmx + bj * HALF + 4) * (1.f / 127.f); }
    }
#pragma unroll
    for (int ai = 0; ai < 2; ++ai)
#pragma unroll
        for (int m = 0; m < 4; ++m) {
            const int row = row0 + ai * HALF + m * 16;
            float rs = 1.f; if constexpr (I8) rs = hs[row];
#pragma unroll
            for (int bj = 0; bj < 2; ++bj) {
                f32x4 a0 = acc[ai][bj][m][0], a1 = acc[ai][bj][m][1];
                if constexpr (I8) { const i32x4 i0 = __builtin_bit_cast(i32x4, a0), i1 = __builtin_bit_cast(i32x4, a1);
                    a0 = (f32x4){(float)i0[0], (float)i0[1], (float)i0[2], (float)i0[3]} * rs * cs[bj][0];
                    a1 = (f32x4){(float)i1[0], (float)i1[1], (float)i1[2], (float)i1[3]} * rs * cs[bj][1]; }
                const f32x2 p0 = act2<MODE>((f32x2){a0[0], a0[1]}, sc), p1 = act2<MODE>((f32x2){a0[2], a0[3]}, sc);
                const f32x2 p2 = act2<MODE>((f32x2){a1[0], a1[1]}, sc), p3 = act2<MODE>((f32x2){a1[2], a1[3]}, sc);
                u32x4 w; w.x = pk2(p0.x, p0.y); w.y = pk2(p1.x, p1.y); w.z = pk2(p2.x, p2.y); w.w = pk2(p3.x, p3.y);
                if constexpr (!TR) {
                    *(u32x4*)(base + (size_t)row * ldc + col0 + bj * HALF) = w;
                } else {
                    bf16_t* tp = base + (size_t)(col0 + bj * HALF) * PT + row;
                    tp[0 * (size_t)PT] = (bf16_t)(w.x & 0xffffu); tp[1 * (size_t)PT] = (bf16_t)(w.x >> 16);
                    tp[2 * (size_t)PT] = (bf16_t)(w.y & 0xffffu); tp[3 * (size_t)PT] = (bf16_t)(w.y >> 16);
                    tp[4 * (size_t)PT] = (bf16_t)(w.z & 0xffffu); tp[5 * (size_t)PT] = (bf16_t)(w.z >> 16);
                    tp[6 * (size_t)PT] = (bf16_t)(w.w & 0xffffu); tp[7 * (size_t)PT] = (bf16_t)(w.w >> 16);
                }
            }
        }
}
struct EpiIn {
    static constexpr bool PERM = true;
    unsigned char* seg;
    bf16_t* gates;
    bf16_t* vt; bf16_t* vct;
    __device__ __forceinline__ bool reset(const Unit&) const { return true; }
    __device__ __forceinline__ void prefetch(const Unit&, int, int, int, int, float&) const {}
    __device__ __forceinline__ void operator()(const f32x4 (&acc)[2][2][4][2], const Unit& u, int wr, int wc, int fr, int fq) const {
        const int colt = u.pn * BM;
        const int row0 = u.pm * BM + wr * 64 + fr;
        const int lc = wc * 32 + 8 * fq;
        const int s = colt >> 10; const int col0 = (colt & 1023) + lc;
        bf16_t* base = (bf16_t*)(seg + (size_t)s * SEGB);
        if (s == 3 || s == 7) epi_in_tile<1, false>(acc, base, DH, row0, col0, 1.f);
        else if (s == 2) epi_in_tile<0, true>(acc, vt, 0, row0, col0, 1.f);
        else epi_in_tile<0, false>(acc, base, DH, row0, col0, s == 0 ? QSCALE : 1.f);
    }
};

struct EpiIn8 {
    static constexpr bool PERM = true;
    unsigned char* seg; bf16_t* gates; bf16_t* vct; const float* hs; const float* colmax;
    __device__ __forceinline__ bool reset(const Unit&) const { return true; }
    __device__ __forceinline__ void operator()(const f32x4 (&acc)[2][2][4][2], const Unit& u, int wr, int wc, int fr, int fq) const {
        const int colt = NBF + u.pn * BM;
        const int row0 = u.pm * BM + wr * 64 + fr;
        const int lc = wc * 32 + 8 * fq;
        const float* cmx = colmax + u.pn * BM + lc;
        if (colt >= 11 * DH) { epi_in_tile<3, false, true>(acc, gates, 3 * DM, row0, colt - 11 * DH + lc, 1.f, hs, cmx); return; }
        const int s = colt >> 10; const int col0 = (colt & 1023) + lc;
        bf16_t* base = (bf16_t*)(seg + (size_t)s * SEGB);
        if (s == 10) epi_in_tile<1, false, true>(acc, base, DH, row0, col0, 1.f, hs, cmx);
        else if (s == 9) epi_in_tile<2, true, true>(acc, vct, 0, row0, col0, 1.f, hs, cmx);
        else epi_in_tile<2, false, true>(acc, base, DH, row0, col0, 1.f, hs, cmx);
    }
};

struct EpiPlain {
    static constexpr bool PERM = true;
    bf16_t* O; int ldc;
    __device__ __forceinline__ bool reset(const Unit&) const { return true; }
    __device__ __forceinline__ void prefetch(const Unit&, int, int, int, int, float&) const {}
    __device__ __forceinline__ void operator()(const f32x4 (&acc)[2][2][4][2], const Unit& u, int wr, int wc, int fr, int fq) const {
        const int row0 = u.pm * BM + wr * 64 + fr, col0 = u.pn * BM + wc * 32 + 8 * fq;
#pragma unroll
        for (int ai = 0; ai < 2; ++ai)
#pragma unroll
            for (int m = 0; m < 4; ++m) { bf16_t* rowp = O + (size_t)(row0 + ai * HALF + m * 16) * ldc + col0;
#pragma unroll
                for (int bj = 0; bj < 2; ++bj) { const f32x4 v0 = acc[ai][bj][m][0], v1 = acc[ai][bj][m][1];
                    u32x4 w; w.x = pk2(v0[0], v0[1]); w.y = pk2(v0[2], v0[3]); w.z = pk2(v1[0], v1[1]); w.w = pk2(v1[2], v1[3]);
                    *(u32x4*)(rowp + bj * HALF) = w; } }
    }
};

struct EpiMerge {
    static constexpr bool PERM = true;
    const bf16_t* __restrict__ gates; bf16_t* __restrict__ out;
    __device__ __forceinline__ bool reset(const Unit& u) const { return u.z == 2; }
    __device__ __forceinline__ void prefetch(const Unit& u, int wr, int wc, int fr, int fq, float& dummy) const {
        const int row0 = u.pm * BM + wr * 64 + fr, col0 = u.pn * BM + wc * 32 + 8 * fq;
        const bf16_t* p = gates + (size_t)row0 * (3 * DM) + u.z * DM + col0;
        asm volatile("" : "+v"(p));
        const bool two = u.z < 2;
#pragma unroll
        for (int i = 0; i < 8; ++i) {
            asm volatile("global_load_dword %0, %1, off" : "+v"(dummy) : "v"(p) : "memory");
            asm volatile("global_load_dword %0, %1, off offset:256" : "+v"(dummy) : "v"(p) : "memory");
            if (two) { const bf16_t* p2 = p + DM;
                asm volatile("global_load_dword %0, %1, off" : "+v"(dummy) : "v"(p2) : "memory");
                asm volatile("global_load_dword %0, %1, off offset:256" : "+v"(dummy) : "v"(p2) : "memory"); }
            p += (size_t)(i == 3 ? 16 + 64 : 16) * (3 * DM);
        }
    }
    __device__ __forceinline__ void operator()(f32x4 (&acc)[2][2][4][2], const Unit& u, int wr, int wc, int fr, int fq) const {
        const int row0 = u.pm * BM + wr * 64 + fr, col0 = u.pn * BM + wc * 32 + 8 * fq;
        const int z = u.z;
        const bf16_t* gz = gates + (size_t)row0 * (3 * DM) + z * DM + col0;
        if (z < 2) {
#pragma unroll
            for (int ai = 0; ai < 2; ++ai) {
                u32x4 gn[4][2], gd[4][2];
#pragma unroll
                for (int m = 0; m < 4; ++m)
#pragma unroll
                    for (int bj = 0; bj < 2; ++bj) { const bf16_t* p = gz + (size_t)(ai * HALF + m * 16) * (3 * DM) + bj * HALF; gn[m][bj] = *(const u32x4*)p; gd[m][bj] = *(const u32x4*)(p + DM); }
#pragma unroll
                for (int m = 0; m < 4; ++m)
#pragma unroll
                    for (int bj = 0; bj < 2; ++bj) {
                        const u32x4 a = gn[m][bj], d = gd[m][bj];
                        f32x4& v0 = acc[ai][bj][m][0]; f32x4& v1 = acc[ai][bj][m][1];
                        v0[0] *= bflo(a.x) * __builtin_amdgcn_rcpf(bflo(d.x)); v0[1] *= bfhi(a.x) * __builtin_amdgcn_rcpf(bfhi(d.x));
                        v0[2] *= bflo(a.y) * __builtin_amdgcn_rcpf(bflo(d.y)); v0[3] *= bfhi(a.y) * __builtin_amdgcn_rcpf(bfhi(d.y));
                        v1[0] *= bflo(a.z) * __builtin_amdgcn_rcpf(bflo(d.z)); v1[1] *= bfhi(a.z) * __builtin_amdgcn_rcpf(bfhi(d.z));
                        v1[2] *= bflo(a.w) * __builtin_amdgcn_rcpf(bflo(d.w)); v1[3] *= bfhi(a.w) * __builtin_amdgcn_rcpf(bfhi(d.w));
                    }
            }
        } else {
#pragma unroll
            for (int ai = 0; ai < 2; ++ai) {
                u32x4 gn[4][2];
#pragma unroll
                for (int m = 0; m < 4; ++m)
#pragma unroll
                    for (int bj = 0; bj < 2; ++bj) gn[m][bj] = *(const u32x4*)(gz + (size_t)(ai * HALF + m * 16) * (3 * DM) + bj * HALF);
#pragma unroll
                for (int m = 0; m < 4; ++m)
#pragma unroll
                    for (int bj = 0; bj < 2; ++bj) {
                        const u32x4 a = gn[m][bj];
                        const f32x4 v0 = acc[ai][bj][m][0], v1 = acc[ai][bj][m][1];
                        u32x4 w; w.x = pk2(v0[0] * bflo(a.x), v0[1] * bfhi(a.x)); w.y = pk2(v0[2] * bflo(a.y), v0[3] * bfhi(a.y));
                        w.z = pk2(v1[0] * bflo(a.z), v1[1] * bfhi(a.z)); w.w = pk2(v1[2] * bflo(a.w), v1[3] * bfhi(a.w));
                        *(u32x4*)(out + (size_t)(row0 + ai * HALF + m * 16) * DM + col0 + bj * HALF) = w;
                    }
            }
        }
    }
};

template <class Epi, class Sched, bool ALIGN_EPI, bool I8 = false>
__device__ __forceinline__ void gemm_phase(LAS unsigned char* lds, const Gemm g, const Sched& S, const Epi& E) {
    const int tid = threadIdx.x, wid = __builtin_amdgcn_readfirstlane(tid >> 6), lane = tid & 63, wr = wid >> 2, wc = wid & 3, fr = lane & 15, fq = lane >> 4;
    const int K = g.K, nt = K / BK;
    unsigned voffA[2], voffB[2];
#pragma unroll
    for (int i = 0; i < 2; ++i) { int R, C; stage_rc(tid * 16 + i * 8192, R, C); const int Rb = Epi::PERM ? ((R & ~31) + perm32(R & 31)) : R;
        voffA[i] = (unsigned)(R * K + C) * 2u; voffB[i] = (unsigned)(Rb * K + C) * 2u; }
    const size_t kstep = (size_t)(BK * 2);
    const size_t hstep = (size_t)HALF * K * 2;
    const size_t tstep = 2 * hstep;
    const unsigned ldsw = (unsigned)wid * 1024u;
    const int aoff = lds_byte(wr * 64 + fr, fq * 8), boff = lds_byte(wc * 32 + fr, fq * 8);
#define PG8_SA(b, h) (((b) * 2 + (h)) * HTB)
#define PG8_SB(b, h) ((4 + (b) * 2 + (h)) * HTB)
#define PG8_STAGE(bufoff, gbase, voff) do { _Pragma("unroll") for (int _i = 0; _i < 2; ++_i) \
        __builtin_amdgcn_global_load_lds((const unsigned*)((const char*)(gbase) + (voff)[_i]), (LAS unsigned*)(lds + (bufoff) + ldsw + _i * 8192), 16, 0, 0); } while (0)
#define PG8_LDA(dst, b, h) do { _Pragma("unroll") for (int m = 0; m < 4; ++m) _Pragma("unroll") for (int k = 0; k < 2; ++k) dst[m][k] = *(const LAS bf16x8*)(lds + PG8_SA(b, h) + aoff + m * 2048 + k * 1024); } while (0)
#define PG8_LDB(dst, b, h) do { _Pragma("unroll") for (int n = 0; n < 2; ++n) _Pragma("unroll") for (int k = 0; k < 2; ++k) dst[n][k] = *(const LAS bf16x8*)(lds + PG8_SB(b, h) + boff + n * 2048 + k * 1024); } while (0)
#define PG8_MMA(ai, bj, At, Bt) do { __builtin_amdgcn_s_setprio(1); _Pragma("unroll") for (int m = 0; m < 4; ++m) _Pragma("unroll") for (int n = 0; n < 2; ++n) _Pragma("unroll") for (int k = 0; k < 2; ++k) { \
        if constexpr (I8) acc[ai][bj][m][n] = __builtin_bit_cast(f32x4, __builtin_amdgcn_mfma_i32_16x16x64_i8(__builtin_bit_cast(i32x4, Bt[n][k]), __builtin_bit_cast(i32x4, At[m][k]), __builtin_bit_cast(i32x4, acc[ai][bj][m][n]), 0, 0, 0)); \
        else acc[ai][bj][m][n] = __builtin_amdgcn_mfma_f32_16x16x32_bf16(Bt[n][k], At[m][k], acc[ai][bj][m][n], 0, 0, 0); } __builtin_amdgcn_s_setprio(0); } while (0)
#define PG8_WAIT_V(n) asm volatile("s_waitcnt vmcnt(" #n ")" ::: "memory")
#define PG8_WAIT_L(n) asm volatile("s_waitcnt lgkmcnt(" #n ")" ::: "memory")
#define PG8_BAR __builtin_amdgcn_s_barrier()
#define PG8_SCHED __builtin_amdgcn_sched_barrier(0)
    Unit cur, nxt; int ui = 0;
    if (!S.next(0, cur)) return;
    f32x4 acc[2][2][4][2];
#pragma unroll
    for (int a = 0; a < 2; ++a)
#pragma unroll
        for (int b = 0; b < 2; ++b)
#pragma unroll
            for (int m = 0; m < 4; ++m)
#pragma unroll
                for (int n = 0; n < 2; ++n) acc[a][b][m][n] = (f32x4){0.f, 0.f, 0.f, 0.f};
    bf16x8 At[4][2], B0[2][2], B1[2][2];
    const char* cA = (const char*)g.A + (size_t)cur.z * g.zA + (size_t)cur.pm * tstep; const char* cB = (const char*)g.Bt + (size_t)cur.z * g.zB + (size_t)cur.pn * tstep;
    PG8_STAGE(PG8_SB(0, 0), cB, voffB); PG8_STAGE(PG8_SB(0, 1), cB + hstep, voffB); PG8_STAGE(PG8_SA(0, 0), cA, voffA); PG8_STAGE(PG8_SA(0, 1), cA + hstep, voffA);
    if (wr == 1) PG8_BAR;
    PG8_WAIT_V(2); PG8_BAR;
    PG8_STAGE(PG8_SB(1, 0), cB + kstep, voffB); PG8_STAGE(PG8_SA(1, 0), cA + kstep, voffA); PG8_STAGE(PG8_SB(1, 1), cB + hstep + kstep, voffB);
    PG8_WAIT_V(6); PG8_BAR;
    for (;;) {
        const bool has_next = S.next(ui + 1, nxt);
        const char* nA = has_next ? (const char*)g.A + (size_t)nxt.z * g.zA + (size_t)nxt.pm * tstep : cA;
        const char* nB = has_next ? (const char*)g.Bt + (size_t)nxt.z * g.zB + (size_t)nxt.pn * tstep : cB;
        for (int t = 0; t < nt; t += 2) {
            const bool last = (t == nt - 2);
            const char* a1 = cA + (size_t)(t + 1) * kstep;
            const char* a2 = last ? nA : cA + (size_t)(t + 2) * kstep; const char* b2 = last ? nB : cB + (size_t)(t + 2) * kstep;
            const char* a3 = a2 + kstep; const char* b3 = b2 + kstep;
            PG8_LDB(B0, 0, 0); PG8_LDB(B1, 0, 1); PG8_SCHED; PG8_LDA(At, 0, 0); PG8_STAGE(PG8_SA(1, 1), a1 + hstep, voffA);
            PG8_WAIT_V(8); PG8_WAIT_L(0); PG8_BAR; PG8_MMA(0, 0, At, B0); PG8_MMA(0, 1, At, B1); PG8_BAR; PG8_SCHED;
            PG8_LDA(At, 0, 1); PG8_STAGE(PG8_SB(0, 0), b2, voffB); PG8_STAGE(PG8_SB(0, 1), b2 + hstep, voffB); PG8_STAGE(PG8_SA(0, 0), a2, voffA);
            PG8_WAIT_V(8); PG8_WAIT_L(0); PG8_BAR; PG8_MMA(1, 0, At, B0); PG8_MMA(1, 1, At, B1); PG8_BAR; PG8_SCHED;
            PG8_LDB(B0, 1, 0); PG8_LDB(B1, 1, 1); PG8_SCHED; PG8_LDA(At, 1, 0); PG8_STAGE(PG8_SA(0, 1), a2 + hstep, voffA);
            PG8_WAIT_V(8); PG8_WAIT_L(0); PG8_BAR; PG8_MMA(0, 0, At, B0); PG8_MMA(0, 1, At, B1); PG8_BAR; PG8_SCHED;
            PG8_LDA(At, 1, 1); PG8_STAGE(PG8_SB(1, 0), b3, voffB); PG8_STAGE(PG8_SB(1, 1), b3 + hstep, voffB); PG8_STAGE(PG8_SA(1, 0), a3, voffA);
            PG8_WAIT_V(8); PG8_WAIT_L(0); PG8_BAR; PG8_MMA(1, 0, At, B0); PG8_MMA(1, 1, At, B1); PG8_BAR; PG8_SCHED;
        }
        if constexpr (ALIGN_EPI) { if (wr == 0) PG8_BAR; }
        E(acc, cur, wr, wc, fr, fq);
        if (!has_next) break;
        if (E.reset(cur)) {
#pragma unroll
        for (int a = 0; a < 2; ++a)
#pragma unroll
            for (int b = 0; b < 2; ++b)
#pragma unroll
                for (int m = 0; m < 4; ++m)
#pragma unroll
                    for (int n = 0; n < 2; ++n) acc[a][b][m][n] = (f32x4){0.f, 0.f, 0.f, 0.f};
        }
        cur = nxt; cA = nA; cB = nB; ++ui;
        if constexpr (ALIGN_EPI) { if (wr == 1) PG8_BAR; }
    }
    PG8_WAIT_V(0);
    if constexpr (!ALIGN_EPI) { if (wr == 0) PG8_BAR; }
    PG8_BAR;
#undef PG8_SA
#undef PG8_SB
#undef PG8_STAGE
#undef PG8_LDA
#undef PG8_LDB
#undef PG8_MMA
#undef PG8_WAIT_V
#undef PG8_WAIT_L
#undef PG8_BAR
#undef PG8_SCHED
}
}

#define GAS __attribute__((address_space(1)))
#define RLX_AGENT __ATOMIC_RELAXED, __HIP_MEMORY_SCOPE_AGENT
#define XB_TMO      128
#define XB_XCNT(j)  (256  + 64 * (j))
#define XB_XSUB(j)  (1280 + 64 * (j))
#define XB_XGEN(j)  (2304 + 64 * (j))
#define XB_TOP      3328
#define XB_TOPGEN   3392
#define XCD_BAR_WORDS 3456
#define XB_SPIN_CAP (1u << 18)

__device__ __forceinline__ unsigned xb_ld(unsigned* p)              { return __hip_atomic_load(p, __ATOMIC_RELAXED, __HIP_MEMORY_SCOPE_AGENT); }
__device__ __forceinline__ unsigned xb_add(unsigned* p, unsigned v) { return __hip_atomic_fetch_add(p, v, __ATOMIC_RELAXED, __HIP_MEMORY_SCOPE_AGENT); }
__device__ __forceinline__ unsigned xb_xcc_id() { return (unsigned)__builtin_amdgcn_s_getreg((3 << 11) | 20) & 0xFu; }
#define XB_SPIN(cond, bar) do { unsigned _sp = 0; while (cond) { __builtin_amdgcn_s_sleep(1); \
    if ((++_sp & 255u) == 0u) { if (xb_ld(&(bar)[XB_TMO])) break; if (_sp > XB_SPIN_CAP) { atomicAdd(&(bar)[XB_TMO], 1u); break; } } } } while (0)

struct XcdBarrier {
    unsigned* bar; unsigned x;
    volatile LAS unsigned* st;
};

__device__ __forceinline__ XcdBarrier xcd_barrier_post(unsigned* bar, volatile LAS unsigned* st) {
    XcdBarrier b; b.bar = bar; b.x = xb_xcc_id(); b.st = st;
    if (threadIdx.x == 0) (void)xb_add(&bar[XB_XCNT(b.x)], 1u);
    return b;
}
__device__ __forceinline__ void xcd_barrier_complete(unsigned* bar, unsigned x, unsigned& nloc, unsigned& nx) {
    const unsigned G = gridDim.x * gridDim.y * gridDim.z;
    unsigned sum, cnt, mine, sp = 0u;
    for (;;) {
        sum = 0u; cnt = 0u; mine = 0u;
#pragma unroll
        for (unsigned j = 0; j < 16; ++j) { const unsigned c = xb_ld(&bar[XB_XCNT(j)]); sum += c; cnt += (c > 0u) ? 1u : 0u; mine = (j == x) ? c : mine; }
        if (sum == G) break;
        __builtin_amdgcn_s_sleep(1);
        if ((++sp & 255u) == 0u) { if (xb_ld(&bar[XB_TMO])) break; if (sp > XB_SPIN_CAP) { atomicAdd(&bar[XB_TMO], 1u); break; } }
    }
    nloc = mine > 0u ? mine : 1u; nx = cnt > 0u ? cnt : 1u;
}

__device__ __forceinline__ void xcd_barrier(const XcdBarrier& b) {
    asm volatile("s_waitcnt vmcnt(0)" ::: "memory");
    __syncthreads();
    if (threadIdx.x == 0) {
        unsigned* bar = b.bar;
        __builtin_amdgcn_s_waitcnt(0);
        unsigned nloc = b.st[0], nx = b.st[1];
        if (nloc == 0u) { xcd_barrier_complete(bar, b.x, nloc, nx); b.st[0] = nloc; b.st[1] = nx; }
        const unsigned old = xb_add(&bar[XB_XSUB(b.x)], 1u);
        const unsigned gen = old / nloc;
        if (old + 1u == (gen + 1u) * nloc) {
            __builtin_amdgcn_fence(__ATOMIC_RELEASE, "agent");
            asm volatile("s_waitcnt vmcnt(0)" ::: "memory");
            const unsigned og = xb_add(&bar[XB_TOP], 1u);
            const unsigned tg = og / nx;
            if (og + 1u == (tg + 1u) * nx) xb_add(&bar[XB_TOPGEN], 1u);
            else XB_SPIN(xb_ld(&bar[XB_TOPGEN]) == tg, bar);
            __builtin_amdgcn_fence(__ATOMIC_ACQUIRE, "agent");
            xb_add(&bar[XB_XGEN(b.x)], 1u);
            asm volatile("s_waitcnt vmcnt(0)" ::: "memory");
        } else {
            XB_SPIN(xb_ld(&bar[XB_XGEN(b.x)]) == gen, bar);
            __builtin_amdgcn_fence(__ATOMIC_ACQUIRE, "agent");
            asm volatile("s_waitcnt vmcnt(0)" ::: "memory");
        }
    }
    __syncthreads();
}

__device__ __forceinline__ void transpose_item(const float* __restrict__ W, int K, int N, bf16_t* __restrict__ WT, LAS float* scr, int item, int lane) {
    const int nblk = N / 32, kb = item / nblk, nb = item - kb * nblk, k0 = 64 * kb, n0 = 32 * nb;
    float tv[32];
#pragma unroll
    for (int i = 0; i < 32; ++i) { const int kk = 2 * i + (lane >> 5); tv[i] = W[(size_t)(k0 + kk) * N + n0 + (lane & 31)]; }
#pragma unroll
    for (int i = 0; i < 32; ++i) { const int kk = 2 * i + (lane >> 5); scr[kk * 33 + (lane & 31)] = tv[i]; }
    asm volatile("s_waitcnt lgkmcnt(0)" ::: "memory");
    const int c = lane & 7;
#pragma unroll
    for (int j = 0; j < 4; ++j) { const int n = (lane >> 3) + 8 * j; const LAS float* s = scr + (8 * c) * 33 + n;
        u32x4 o; o.x = pk2(s[0 * 33], s[1 * 33]); o.y = pk2(s[2 * 33], s[3 * 33]); o.z = pk2(s[4 * 33], s[5 * 33]); o.w = pk2(s[6 * 33], s[7 * 33]);
        *(u32x4*)(WT + (size_t)(n0 + n) * K + k0 + 8 * c) = o; }
    asm volatile("s_waitcnt lgkmcnt(0)" ::: "memory");
}

template <bool QUANT>
__device__ __forceinline__ void gate_weight_item(const float* __restrict__ W, int K, int N, unsigned char* __restrict__ W8, unsigned* colmax, int nbase, LAS float* scr, int item, int lane) {
    constexpr int NBG = NI8 / 32;
    const int kb = item / NBG, nb = item - kb * NBG, k0 = 64 * kb, n0 = nbase + 32 * nb;
    float tv[32];
#pragma unroll
    for (int i = 0; i < 32; ++i) { const int kk = 2 * i + (lane >> 5); tv[i] = W[(size_t)(k0 + kk) * N + n0 + (lane & 31)]; }
    if constexpr (!QUANT) {
        float mx = 0.f;
#pragma unroll
        for (int i = 0; i < 32; ++i) mx = fmaxf(mx, fabsf(tv[i]));
        mx = fmaxf(mx, __shfl_xor(mx, 32));
        if (lane < 32) atomicMax(colmax + (n0 - nbase) + lane, __float_as_uint(mx));
    } else {
        const float qs = 127.f / fmaxf(__uint_as_float(colmax[(n0 - nbase) + (lane & 31)]), 1e-30f);
#pragma unroll
        for (int i = 0; i < 32; ++i) { const int kk = 2 * i + (lane >> 5); scr[kk * 33 + (lane & 31)] = tv[i] * qs; }
        asm volatile("s_waitcnt lgkmcnt(0)" ::: "memory");
        const int n = lane >> 1, kh = (lane & 1) * 32;
        const LAS float* s = scr + kh * 33 + n;
        u32x4 o0, o1;
        o0.x = q8x4(s[0 * 33], s[1 * 33], s[2 * 33], s[3 * 33]);     o0.y = q8x4(s[4 * 33], s[5 * 33], s[6 * 33], s[7 * 33]);
        o0.z = q8x4(s[8 * 33], s[9 * 33], s[10 * 33], s[11 * 33]);   o0.w = q8x4(s[12 * 33], s[13 * 33], s[14 * 33], s[15 * 33]);
        o1.x = q8x4(s[16 * 33], s[17 * 33], s[18 * 33], s[19 * 33]); o1.y = q8x4(s[20 * 33], s[21 * 33], s[22 * 33], s[23 * 33]);
        o1.z = q8x4(s[24 * 33], s[25 * 33], s[26 * 33], s[27 * 33]); o1.w = q8x4(s[28 * 33], s[29 * 33], s[30 * 33], s[31 * 33]);
        unsigned char* dst = W8 + (size_t)(n0 - nbase + n) * K + k0 + kh;
        *(u32x4*)dst = o0; *(u32x4*)(dst + 16) = o1;
        asm volatile("s_waitcnt lgkmcnt(0)" ::: "memory");
    }
}

template <bool HAS_Y, bool WRITE_H>
__device__ __forceinline__ void row_pass(const float* __restrict__ xin, const bf16_t* __restrict__ Y, const float* __restrict__ post_g, float* xout,
                                         const float* __restrict__ pre_g, bf16_t* __restrict__ H, unsigned char* __restrict__ H8, float* __restrict__ HS, int gw, int NGW, int lane) {
    for (int row = gw; row < MT; row += NGW) {
        float xv[4][8];
#pragma unroll
        for (int j = 0; j < 4; ++j) { const int col = (j * 64 + lane) * 8; const f32x4 a = *(const f32x4*)(xin + (size_t)row * DM + col), b = *(const f32x4*)(xin + (size_t)row * DM + col + 4);
#pragma unroll
            for (int e = 0; e < 4; ++e) { xv[j][e] = a[e]; xv[j][4 + e] = b[e]; } }
        if constexpr (HAS_Y) {
            float yv[4][8]; float ss = 0.f;
#pragma unroll
            for (int j = 0; j < 4; ++j) { const int col = (j * 64 + lane) * 8; const u32x4 w = *(const u32x4*)(Y + (size_t)row * DM + col);
                yv[j][0] = bflo(w.x); yv[j][1] = bfhi(w.x); yv[j][2] = bflo(w.y); yv[j][3] = bfhi(w.y); yv[j][4] = bflo(w.z); yv[j][5] = bfhi(w.z); yv[j][6] = bflo(w.w); yv[j][7] = bfhi(w.w);
#pragma unroll
                for (int e = 0; e < 8; ++e) ss += yv[j][e] * yv[j][e]; }
            const float r = 1.0f / sqrtf(wave_sum(ss) * (1.0f / DM) + EPSN);
#pragma unroll
            for (int j = 0; j < 4; ++j) { const int col = (j * 64 + lane) * 8; const f32x4 ga = *(const f32x4*)(post_g + col), gb = *(const f32x4*)(post_g + col + 4);
#pragma unroll
                for (int e = 0; e < 4; ++e) { xv[j][e] += yv[j][e] * r * ga[e]; xv[j][4 + e] += yv[j][4 + e] * r * gb[e]; }
                *(f32x4*)(xout + (size_t)row * DM + col) = (f32x4){xv[j][0], xv[j][1], xv[j][2], xv[j][3]};
                *(f32x4*)(xout + (size_t)row * DM + col + 4) = (f32x4){xv[j][4], xv[j][5], xv[j][6], xv[j][7]}; }
        }
        if constexpr (WRITE_H) {
            float ss = 0.f;
#pragma unroll
            for (int j = 0; j < 4; ++j)
#pragma unroll
                for (int e = 0; e < 8; ++e) ss += xv[j][e] * xv[j][e];
            const float r = 1.0f / sqrtf(wave_sum(ss) * (1.0f / DM) + EPSN);
            float amax = 0.f;
#pragma unroll
            for (int j = 0; j < 4; ++j) { const int col = (j * 64 + lane) * 8; const f32x4 ga = *(const f32x4*)(pre_g + col), gb = *(const f32x4*)(pre_g + col + 4);
#pragma unroll
                for (int e = 0; e < 4; ++e) { xv[j][e] *= r * ga[e]; xv[j][4 + e] *= r * gb[e]; amax = fmaxf(amax, fmaxf(fabsf(xv[j][e]), fabsf(xv[j][4 + e]))); }
                u32x4 w; w.x = pk2(xv[j][0], xv[j][1]); w.y = pk2(xv[j][2], xv[j][3]); w.z = pk2(xv[j][4], xv[j][5]); w.w = pk2(xv[j][6], xv[j][7]);
                *(u32x4*)(H + (size_t)row * DM + col) = w; }
#pragma unroll
            for (int o = 1; o < 64; o <<= 1) amax = fmaxf(amax, __shfl_xor(amax, o));
            amax = fmaxf(amax, 1e-20f);
            const float qs = 127.f / amax;
            if (lane == 0) HS[row] = amax * (1.f / 127.f);
#pragma unroll
            for (int j = 0; j < 4; ++j) { const int col = (j * 64 + lane) * 8;
                u32x2 w8; w8.x = q8x4(xv[j][0] * qs, xv[j][1] * qs, xv[j][2] * qs, xv[j][3] * qs); w8.y = q8x4(xv[j][4] * qs, xv[j][5] * qs, xv[j][6] * qs, xv[j][7] * qs);
                *(u32x2*)(H8 + (size_t)row * DM + col) = w8; }
        }
    }
}

constexpr int ATP = 144;
constexpr int ATT_WAVE_LDS = 2 * 64 * ATP;
__device__ __forceinline__ void attn_item(const bf16_t* __restrict__ Q, const bf16_t* __restrict__ Kb, const bf16_t* __restrict__ VT, const bf16_t* __restrict__ GA,
                                          bf16_t* __restrict__ OA, const LAS float* btab, LAS unsigned char* wl, int b, int c, int h, int half, int lane) {
    const int r = lane & 31, hh = lane >> 5;
    const int rl = lane >> 3, cl = lane & 7;
    const int tokq = b * SEQ + c * 64 + half * 32;
    const int qloc = half * 32 + r;
    const int pr = (r & ~12) | ((r & 4) << 1) | ((r & 8) >> 1);
    const int jmin = c >= 8 ? 0 : 8 - c;
    const int tk0 = b * SEQ + (c - 8 + jmin) * 64;
    const bf16_t* kg = Kb + (size_t)(tk0 + rl) * DH + h * 64 + cl * 8;
    const bf16_t* vg = VT + (size_t)(h * 64 + rl) * PT + tk0 + cl * 8;
    LAS unsigned char* Kt = wl; LAS unsigned char* Vt = wl + 64 * ATP;
    const int stoff = rl * ATP + cl * 16;
    u32x4 kr[8], vr[8];
#pragma unroll
    for (int i = 0; i < 8; ++i) { kr[i] = *(const u32x4*)(kg + (size_t)(8 * i) * DH); vr[i] = *(const u32x4*)(vg + (size_t)(8 * i) * PT); }
    bf16x8 qf[4];
    { const bf16_t* qp = Q + (size_t)(tokq + r) * DH + h * 64 + 8 * hh;
#pragma unroll
      for (int d0 = 0; d0 < 4; ++d0) qf[d0] = *(const bf16x8*)(qp + d0 * 16); }
#pragma unroll
    for (int i = 0; i < 8; ++i) { *(LAS u32x4*)(Kt + stoff + 8 * i * ATP) = kr[i]; *(LAS u32x4*)(Vt + stoff + 8 * i * ATP) = vr[i]; }
    { const int adv = (jmin + 1 <= 8) ? 1 : 0; kg += (size_t)adv * 64 * DH; vg += adv * 64; }
#pragma unroll
    for (int i = 0; i < 8; ++i) { kr[i] = *(const u32x4*)(kg + (size_t)(8 * i) * DH); vr[i] = *(const u32x4*)(vg + (size_t)(8 * i) * PT); }
    f32x16 o0, o1;
#pragma unroll
    for (int i = 0; i < 16; ++i) { o0[i] = 0.f; o1[i] = 0.f; }
    float mrun = -1e30f, lrun = 0.f;
    const float cfar = btab[NREL - 1];
    const LAS unsigned char* kfp = Kt + pr * ATP + 16 * hh;
    const LAS unsigned char* vfp = Vt + r * ATP + 16 * hh;
    for (int j = jmin; j <= 8; ++j) {
        f32x16 s0, s1;
#pragma unroll
        for (int i = 0; i < 16; ++i) { s0[i] = 0.f; s1[i] = 0.f; }
#pragma unroll
        for (int d0 = 0; d0 < 4; ++d0) {
            const bf16x8 k0 = *(const LAS bf16x8*)(kfp + d0 * 32), k1 = *(const LAS bf16x8*)(kfp + 32 * ATP + d0 * 32);
            s0 = MFMA32(k0, qf[d0], s0); s1 = MFMA32(k1, qf[d0], s1);
        }
        if (j <= 3) {
#pragma unroll
            for (int i = 0; i < 16; ++i) { s0[i] += cfar; s1[i] += cfar; }
        } else {
            const int base = qloc + 64 * (8 - j) + 63 - 8 * hh;
#pragma unroll
            for (int i = 0; i < 16; ++i) {
                const int key = (i & 3) + 4 * ((i >> 2) & 1) + 16 * (i >> 3);
                int i0 = base - key, i1 = base - key - 32;
                i0 = i0 > NREL - 1 ? NREL - 1 : i0; i1 = i1 > NREL - 1 ? NREL - 1 : i1;
                s0[i] += btab[i0]; s1[i] += btab[i1];
            }
        }
        float tmax = fmaxf(s0[0], s1[0]);
#pragma unroll
        for (int i = 1; i < 16; ++i) tmax = fmaxf(tmax, fmaxf(s0[i], s1[i]));
        tmax = fmaxf(tmax, __shfl_xor(tmax, 32));
        const float mnew = fmaxf(mrun, tmax);
        const float alpha = __builtin_amdgcn_exp2f(mrun - mnew);
        mrun = mnew;
        float ls = 0.f;
#pragma unroll
        for (int i = 0; i < 16; ++i) { s0[i] = __builtin_amdgcn_exp2f(s0[i] - mnew); s1[i] = __builtin_amdgcn_exp2f(s1[i] - mnew); ls += s0[i] + s1[i]; }
        lrun = lrun * alpha + ls;
#pragma unroll
        for (int i = 0; i < 16; ++i) { o0[i] *= alpha; o1[i] *= alpha; }
#pragma unroll
        for (int s = 0; s < 2; ++s) {
            u32x4 pa, pb;
            pa.x = pk2(s0[8 * s + 0], s0[8 * s + 1]); pa.y = pk2(s0[8 * s + 2], s0[8 * s + 3]); pa.z = pk2(s0[8 * s + 4], s0[8 * s + 5]); pa.w = pk2(s0[8 * s + 6], s0[8 * s + 7]);
            pb.x = pk2(s1[8 * s + 0], s1[8 * s + 1]); pb.y = pk2(s1[8 * s + 2], s1[8 * s + 3]); pb.z = pk2(s1[8 * s + 4], s1[8 * s + 5]); pb.w = pk2(s1[8 * s + 6], s1[8 * s + 7]);
            const bf16x8 va0 = *(const LAS bf16x8*)(vfp + 32 * s), va1 = *(const LAS bf16x8*)(vfp + 32 * ATP + 32 * s);
            const bf16x8 vb0 = *(const LAS bf16x8*)(vfp + 64 + 32 * s), vb1 = *(const LAS bf16x8*)(vfp + 32 * ATP + 64 + 32 * s);
            o0 = MFMA32(va0, __builtin_bit_cast(bf16x8, pa), o0); o1 = MFMA32(va1, __builtin_bit_cast(bf16x8, pa), o1);
            o0 = MFMA32(vb0, __builtin_bit_cast(bf16x8, pb), o0); o1 = MFMA32(vb1, __builtin_bit_cast(bf16x8, pb), o1);
        }
#pragma unroll
        for (int i = 0; i < 8; ++i) { *(LAS u32x4*)(Kt + stoff + 8 * i * ATP) = kr[i]; *(LAS u32x4*)(Vt + stoff + 8 * i * ATP) = vr[i]; }
        { const int adv = (j + 2 <= 8) ? 1 : 0; kg += (size_t)adv * 64 * DH; vg += adv * 64; }
#pragma unroll
        for (int i = 0; i < 8; ++i) { kr[i] = *(const u32x4*)(kg + (size_t)(8 * i) * DH); vr[i] = *(const u32x4*)(vg + (size_t)(8 * i) * PT); }
    }
    const float l = lrun + __shfl_xor(lrun, 32);
    const float inv = 1.0f / l;
    LAS unsigned char* Ot = wl;
#pragma unroll
    for (int g = 0; g < 4; ++g) {
#pragma unroll
        for (int db = 0; db < 2; ++db) {
            const f32x16& o = db ? o1 : o0;
            u32x2 w; w.x = pk2(o[4 * g + 0] * inv, o[4 * g + 1] * inv); w.y = pk2(o[4 * g + 2] * inv, o[4 * g + 3] * inv);
            *(LAS u32x2*)(Ot + r * ATP + (db * 32 + 8 * g + 4 * hh) * 2) = w;
        }
    }
#pragma unroll
    for (int i = 0; i < 4; ++i) {
        const int row = rl + 8 * i;
        const size_t a = (size_t)(tokq + row) * DH + h * 64 + cl * 8;
        const u32x4 gg = *(const u32x4*)(GA + a);
        const u32x4 ov = *(const LAS u32x4*)(Ot + row * ATP + cl * 16);
        u32x4 w; w.x = pk2(bflo(ov.x) * bflo(gg.x), bfhi(ov.x) * bfhi(gg.x)); w.y = pk2(bflo(ov.y) * bflo(gg.y), bfhi(ov.y) * bfhi(gg.y));
        w.z = pk2(bflo(ov.z) * bflo(gg.z), bfhi(ov.z) * bfhi(gg.z)); w.w = pk2(bflo(ov.w) * bflo(gg.w), bfhi(ov.w) * bfhi(gg.w));
        *(u32x4*)(OA + a) = w;
    }
}

__device__ __forceinline__ void unpack8(const u32x4 w, float* v) { v[0] = bflo(w.x); v[1] = bfhi(w.x); v[2] = bflo(w.y); v[3] = bfhi(w.y); v[4] = bflo(w.z); v[5] = bfhi(w.z); v[6] = bflo(w.w); v[7] = bfhi(w.w); }
__device__ __forceinline__ void conv_unit(const bf16_t* __restrict__ BB, const bf16_t* __restrict__ CC, const bf16_t* __restrict__ HB, const bf16_t* __restrict__ GB,
                                          bf16_t* __restrict__ OB, const float* __restrict__ cw, int unit, int tid) {
    const int cgp = tid & 127, sub = tid >> 7, ch = cgp * 8;
    const int t0 = unit * 32 + sub * 8;
    float w0[8], w1[8], w2[8];
#pragma unroll
    for (int e = 0; e < 8; ++e) { w0[e] = cw[ch + e]; w1[e] = cw[DH + ch + e]; w2[e] = cw[2 * DH + ch + e]; }
    float p2[8], p1[8];
#pragma unroll
    for (int e = 0; e < 8; ++e) { p2[e] = 0.f; p1[e] = 0.f; }
    const int tpos = t0 & (SEQ - 1);
    if (tpos >= 2) { float a[8], b[8]; unpack8(*(const u32x4*)(CC + (size_t)(t0 - 2) * DH + ch), a); unpack8(*(const u32x4*)(HB + (size_t)(t0 - 2) * DH + ch), b);
#pragma unroll
        for (int e = 0; e < 8; ++e) p2[e] = a[e] * b[e]; }
    if (tpos >= 1) { float a[8], b[8]; unpack8(*(const u32x4*)(CC + (size_t)(t0 - 1) * DH + ch), a); unpack8(*(const u32x4*)(HB + (size_t)(t0 - 1) * DH + ch), b);
#pragma unroll
        for (int e = 0; e < 8; ++e) p1[e] = a[e] * b[e]; }
#pragma unroll
    for (int i = 0; i < 8; ++i) {
        const size_t off = (size_t)(t0 + i) * DH + ch;
        float a[8], b[8], g1[8], g2[8], o[8];
        unpack8(*(const u32x4*)(CC + off), a); unpack8(*(const u32x4*)(HB + off), b); unpack8(*(const u32x4*)(BB + off), g1); unpack8(*(const u32x4*)(GB + off), g2);
#pragma unroll
        for (int e = 0; e < 8; ++e) { const float cur = a[e] * b[e]; o[e] = g1[e] * (w0[e] * p2[e] + w1[e] * p1[e] + w2[e] * cur) * g2[e]; p2[e] = p1[e]; p1[e] = cur; }
        u32x4 w; w.x = pk2(o[0], o[1]); w.y = pk2(o[2], o[3]); w.z = pk2(o[4], o[5]); w.w = pk2(o[6], o[7]);
        *(u32x4*)(OB + off) = w;
    }
}

template <int tbA, int tbB>
__device__ __forceinline__ void sgu_groups(const bf16_t* __restrict__ VCT, const bf16_t* __restrict__ U, const bf16_t* __restrict__ GC, bf16_t* __restrict__ OC,
                                           const bf16_t* __restrict__ Wbf, const float* __restrict__ spb, const float* __restrict__ lng, const float* __restrict__ lnb,
                                           int tok0, int gh, int cb, int r, int hh, const LAS float* stat) {
    for (int gi = 0; gi < 4; ++gi) {
        const int g = gh * 4 + gi;
        const int ch = g * 128 + cb * 32 + r;
        const float gg = lng[ch], bb = lnb[ch];
        const bf16_t* ap = VCT + (size_t)ch * PT + tok0 + 8 * hh;
        const bf16_t* wp = Wbf + (size_t)g * 16384 + 8 * hh;
        constexpr int NSB = (tbB + 1) * 2, NSA = (tbA + 1) * 2;
        int so = 0; asm volatile("" : "+v"(so));
        u32x4 raw[NSB]; bf16x8 wB[NSB], wA[NSA];
#pragma unroll
        for (int k = 0; k < NSB; ++k) { raw[k] = *(const u32x4*)(ap + 16 * k); wB[k] = *(const bf16x8*)(wp + (size_t)(tbB * 32 + r) * 128 + 16 * k); }
#pragma unroll
        for (int k = 0; k < NSA; ++k) wA[k] = *(const bf16x8*)(wp + (size_t)(tbA * 32 + r) * 128 + 16 * k);
        f32x16 accA, accB;
#pragma unroll
        for (int i = 0; i < 16; ++i) { accA[i] = 0.f; accB[i] = 0.f; }
#pragma unroll
        for (int k = 0; k < NSB; ++k) {
            float v[8]; unpack8(raw[k], v);
#pragma unroll
            for (int jj = 0; jj < 8; ++jj) { const float mean = stat[(16 * k + 8 * hh + jj) * 2 + so], rstd = stat[(16 * k + 8 * hh + jj) * 2 + 1 + so]; v[jj] = (v[jj] - mean) * rstd * gg + bb; }
            u32x4 af; af.x = pk2(v[0], v[1]); af.y = pk2(v[2], v[3]); af.z = pk2(v[4], v[5]); af.w = pk2(v[6], v[7]);
            accB = MFMA32(__builtin_bit_cast(bf16x8, af), wB[k], accB);
            if (k < NSA) accA = MFMA32(__builtin_bit_cast(bf16x8, af), wA[k < NSA ? k : 0], accA);
        }
        u32x2 uu[2][4], gc[2][4]; float sb[2];
#pragma unroll
        for (int which = 0; which < 2; ++which) { const int t = (which ? tbB : tbA) * 32 + r; sb[which] = spb[g * 128 + t];
            const size_t rowoff = (size_t)(tok0 + t) * DH + g * 128 + cb * 32 + 4 * hh;
#pragma unroll
            for (int q = 0; q < 4; ++q) { uu[which][q] = *(const u32x2*)(U + rowoff + 8 * q); gc[which][q] = *(const u32x2*)(GC + rowoff + 8 * q); } }
#pragma unroll
        for (int which = 0; which < 2; ++which) {
            const int tb = which ? tbB : tbA; const f32x16& acc = which ? accB : accA;
            const int t = tb * 32 + r; const float sbv = sb[which];
            const size_t rowoff = (size_t)(tok0 + t) * DH + g * 128 + cb * 32 + 4 * hh;
#pragma unroll
            for (int q = 0; q < 4; ++q) {
                const u32x2 u2 = uu[which][q], g2 = gc[which][q];
                u32x2 o; o.x = pk2(bflo(u2.x) * (acc[4 * q + 0] + sbv) * bflo(g2.x), bfhi(u2.x) * (acc[4 * q + 1] + sbv) * bfhi(g2.x));
                o.y = pk2(bflo(u2.y) * (acc[4 * q + 2] + sbv) * bflo(g2.y), bfhi(u2.y) * (acc[4 * q + 3] + sbv) * bfhi(g2.y));
                *(u32x2*)(OC + rowoff + 8 * q) = o;
            }
        }
    }
}

__device__ __forceinline__ void sgu_unit(const bf16_t* __restrict__ VCT, const bf16_t* __restrict__ U, const bf16_t* __restrict__ GC, bf16_t* __restrict__ OC,
                                         const bf16_t* __restrict__ Wbf, const float* __restrict__ spb, const float* __restrict__ lng, const float* __restrict__ lnb,
                                         int b, int n, int gh, LAS unsigned char* lds, int tid) {
    const int lane = tid & 63, w = __builtin_amdgcn_readfirstlane(tid >> 6), r = lane & 31, hh = lane >> 5;
    const int tok0 = b * SEQ + n * 128;
    __syncthreads();
    LAS float* part = (LAS float*)lds;
    LAS float* stat = part + 8 * 128 * 2;
    {
        const int tl = lane & 15, cq = lane >> 4;
        const bf16_t* p = VCT + (size_t)(w * 128 + cq) * PT + tok0 + 8 * tl;
        float sm[8], sq[8];
#pragma unroll
        for (int e = 0; e < 8; ++e) { sm[e] = 0.f; sq[e] = 0.f; }
#pragma unroll 8
        for (int c4 = 0; c4 < 32; ++c4) { float v[8]; unpack8(*(const u32x4*)(p + (size_t)(c4 * 4) * PT), v);
#pragma unroll
            for (int e = 0; e < 8; ++e) { sm[e] += v[e]; sq[e] += v[e] * v[e]; } }
#pragma unroll
        for (int e = 0; e < 8; ++e) { sm[e] += __shfl_xor(sm[e], 16); sm[e] += __shfl_xor(sm[e], 32); sq[e] += __shfl_xor(sq[e], 16); sq[e] += __shfl_xor(sq[e], 32); }
        if (cq == 0) {
#pragma unroll
            for (int e = 0; e < 8; ++e) { part[(w * 128 + 8 * tl + e) * 2 + 0] = sm[e]; part[(w * 128 + 8 * tl + e) * 2 + 1] = sq[e]; }
        }
    }
    __syncthreads();
    if (tid < 128) {
        float S = 0.f, SS = 0.f;
#pragma unroll
        for (int ww = 0; ww < 8; ++ww) { S += part[(ww * 128 + tid) * 2]; SS += part[(ww * 128 + tid) * 2 + 1]; }
        const float mean = S * (1.0f / DH); const float var = fmaxf(SS * (1.0f / DH) - mean * mean, 0.f);
        stat[tid * 2] = mean; stat[tid * 2 + 1] = 1.0f / sqrtf(var + EPSN);
    }
    __syncthreads();
    if ((w >> 2) == 0) sgu_groups<0, 3>(VCT, U, GC, OC, Wbf, spb, lng, lnb, tok0, gh, w & 3, r, hh, stat);
    else sgu_groups<1, 2>(VCT, U, GC, OC, Wbf, spb, lng, lnb, tok0, gh, w & 3, r, hh, stat);
    __syncthreads();
}

#ifndef X_ATT
#define X_ATT 0
#endif
#ifndef X_CONV
#define X_CONV 0
#endif
#ifndef X_SGU
#define X_SGU 0
#endif
struct Args { const float* in[14]; float* out; unsigned char* ws; int ph_lo, ph_hi; };
constexpr int NPH = 11;

__device__ __forceinline__ void phase_prologue(const Args& args, LAS unsigned char* lds) {
    const int tid = threadIdx.x, lane = tid & 63, wave = __builtin_amdgcn_readfirstlane(tid >> 6);
    const int G = gridDim.x, blk = blockIdx.x, gw = blk * 8 + wave, NGW = G * 8;
    unsigned char* ws = args.ws;
    LAS float* scr = (LAS float*)(lds + wave * 16384);
    constexpr int I_IN = (DM / 64) * (NIN / 32), I_BR = (DH / 64) * (DM / 32), I_OUT = (DM / 64) * (DM / 32);
    constexpr int PER_L = I_IN + 3 * I_BR + I_OUT;
    for (int it = gw; it < 2 * PER_L; it += NGW) {
        const int l = it / PER_L; int r = it - l * PER_L;
        if (r < I_IN) { const int kb = r / (NIN / 32), nb = r - kb * (NIN / 32);
            if (nb * 32 < NBF) transpose_item(args.in[2] + (size_t)l * DM * NIN, DM, NIN, (bf16_t*)(ws + WS_WIN + (size_t)l * 68 * MiB), scr, r, lane);
            else gate_weight_item<false>(args.in[2] + (size_t)l * DM * NIN, DM, NIN, nullptr, (unsigned*)(ws + WS_COLMAX) + l * NI8, NBF, scr, kb * (NI8 / 32) + (nb - NBF / 32), lane);
            continue; } r -= I_IN;
        if (r < 3 * I_BR) { const int br = r / I_BR; r -= br * I_BR; const float* src = (br == 0 ? args.in[9] : (br == 1 ? args.in[10] : args.in[11])) + (size_t)l * DH * DM;
            transpose_item(src, DH, DM, (bf16_t*)(ws + WS_WBR + (size_t)(l * 3 + br) * 4 * MiB), scr, r, lane); continue; } r -= 3 * I_BR;
        transpose_item(args.in[12] + (size_t)l * DM * DM, DM, DM, (bf16_t*)(ws + WS_WOUT + (size_t)l * 8 * MiB), scr, r, lane);
    }
    { bf16_t* wb = (bf16_t*)(ws + WS_SGUW); const float* sp_w = args.in[7];
      for (int e = blk * 512 + tid; e < 2 * 8 * 128 * 128; e += G * 512) { const int t = (e >> 7) & 127, s = e & 127; const unsigned p = pk2(sp_w[e], 0.f); wb[e] = (s <= t) ? (bf16_t)(p & 0xffffu) : (bf16_t)0; } }
    row_pass<false, true>(args.in[0], nullptr, nullptr, nullptr, args.in[1], (bf16_t*)(ws + WS_H), ws + WS_H8, (float*)(ws + WS_HS), gw, NGW, lane);
}

__device__ __forceinline__ void phase_quant(const Args& args, LAS unsigned char* lds) {
    const int tid = threadIdx.x, lane = tid & 63, wave = __builtin_amdgcn_readfirstlane(tid >> 6);
    const int gw = blockIdx.x * 8 + wave, NGW = gridDim.x * 8;
    unsigned char* ws = args.ws;
    LAS float* scr = (LAS float*)(lds + wave * 16384);
    constexpr int PER_L = (DM / 64) * (NI8 / 32);
    for (int it = gw; it < 2 * PER_L; it += NGW) {
        const int l = it / PER_L, r = it - l * PER_L;
        gate_weight_item<true>(args.in[2] + (size_t)l * DM * NIN, DM, NIN, ws + WS_W8 + (size_t)l * 18 * MiB, (unsigned*)(ws + WS_COLMAX) + l * NI8, NBF, scr, r, lane);
    }
}

template <int L> __device__ __forceinline__ void phase_in(const Args& args, LAS unsigned char* lds) {
    unsigned char* ws = args.ws;
    {
        pg8::Gemm g{(const bf16_t*)(ws + WS_H), (const bf16_t*)(ws + WS_WIN + (size_t)L * 68 * MiB), MT, NBF, DM, 0, 0};
        pg8::TileOrder<1> S; S.init(MT, NBF, gridDim.x, blockIdx.x);
        pg8::EpiIn E{ws + WS_SEG, (bf16_t*)(ws + WS_GATES), (bf16_t*)(ws + WS_VT), (bf16_t*)(ws + WS_VCT)};
        pg8::gemm_phase<pg8::EpiIn, pg8::TileOrder<1>, true>(lds, g, S, E);
    }
    {
        pg8::Gemm g{(const bf16_t*)(ws + WS_H8), (const bf16_t*)(ws + WS_W8 + (size_t)L * 18 * MiB), MT, NI8, DM / 2, 0, 0};
        pg8::TileOrder<1> S; S.init(MT, NI8, gridDim.x, blockIdx.x);
        pg8::EpiIn8 E{ws + WS_SEG, (bf16_t*)(ws + WS_GATES), (bf16_t*)(ws + WS_VCT), (const float*)(ws + WS_HS), (const float*)(ws + WS_COLMAX) + L * NI8};
        pg8::gemm_phase<pg8::EpiIn8, pg8::TileOrder<1>, true, true>(lds, g, S, E);
    }
}

template <int L> __device__ __forceinline__ void phase_mix(const Args& args, LAS unsigned char* lds) {
    const int tid = threadIdx.x, lane = tid & 63, wave = __builtin_amdgcn_readfirstlane(tid >> 6);
    const int G = gridDim.x, blk = blockIdx.x;
    unsigned char* ws = args.ws;
    const bf16_t* segb = (const bf16_t*)(ws + WS_SEG);
    bf16_t* OA = (bf16_t*)(ws + WS_O);
    constexpr size_t SE = (size_t)MT * DH;
    LAS float* btab = (LAS float*)(lds + 8 * ATT_WAVE_LDS + wave * 1280);
    LAS unsigned char* wl = lds + wave * ATT_WAVE_LDS;
    int cur_h = -1;
    constexpr int XA = (L == 0 ? X_ATT : 0) * 1024, XC = (L == 0 ? X_CONV : 0) * 512, XS = (L == 0 ? X_SGU : 0) * 256;
    for (int uu = blk; uu < 1792 + XA + XC + XS; uu += G) {
        int u = uu;
        if (uu >= 1792) { const int x = uu - 1792; u = x < XA ? (x & 1023) : (x < XA + XC ? 1024 + ((x - XA) & 511) : 1536 + ((x - XA - XC) & 255)); }
        if (u < 1024) {
            const int hg = u & 3, b = (u >> 2) & 7, c = u >> 5;
            const int h = hg * 4 + (wave >> 1), half = wave & 1;
            if (h != cur_h) { const float* rb = args.in[3] + (size_t)(L * 16 + h) * NREL;
#pragma unroll
                for (int i = 0; i < 5; ++i) btab[i * 64 + lane] = rb[i * 64 + lane] * LOG2E;
                cur_h = h; }
            attn_item(segb, segb + SE, (const bf16_t*)(ws + WS_VT), segb + 3 * SE, OA, btab, wl, b, c, h, half, lane);
        } else if (u < 1536) {
            conv_unit(segb + 4 * SE, segb + 5 * SE, segb + 6 * SE, segb + 7 * SE, OA + SE, args.in[4] + (size_t)L * 3 * DH, u - 1024, tid);
        } else {
            const int su = u - 1536; const int gh = su & 1, n = (su >> 1) & 15, b = su >> 5;
            sgu_unit((const bf16_t*)(ws + WS_VCT), segb + 8 * SE, segb + 10 * SE, OA + 2 * SE, (const bf16_t*)(ws + WS_SGUW) + (size_t)L * 8 * 16384, args.in[8] + (size_t)L * 8 * 128,
                     args.in[5] + (size_t)L * DH, args.in[6] + (size_t)L * DH, b, n, gh, lds, tid);
        }
    }
}

template <int L> __device__ __forceinline__ void phase_br(const Args& args, LAS unsigned char* lds) {
    unsigned char* ws = args.ws;
    pg8::Gemm g{(const bf16_t*)(ws + WS_O), (const bf16_t*)(ws + WS_WBR + (size_t)L * 12 * MiB), MT, DM, DH, (size_t)32 * MiB, (size_t)4 * MiB};
    pg8::TileOrder<3> S; S.init(MT, DM, gridDim.x, blockIdx.x);
    pg8::EpiMerge E{(const bf16_t*)(ws + WS_GATES), (bf16_t*)(ws + WS_MERGED16)};
    pg8::gemm_phase<pg8::EpiMerge, pg8::TileOrder<3>, true>(lds, g, S, E);
}

template <int L> __device__ __forceinline__ void phase_out(const Args& args, LAS unsigned char* lds) {
    unsigned char* ws = args.ws;
    pg8::Gemm g{(const bf16_t*)(ws + WS_MERGED16), (const bf16_t*)(ws + WS_WOUT + (size_t)L * 8 * MiB), MT, DM, DM, 0, 0};
    pg8::TileOrder<1> S; S.init(MT, DM, gridDim.x, blockIdx.x);
    pg8::EpiPlain E{(bf16_t*)(ws + WS_Y), DM};
    pg8::gemm_phase<pg8::EpiPlain, pg8::TileOrder<1>, true>(lds, g, S, E);
}

template <int L> __device__ __forceinline__ void phase_row(const Args& args) {
    const int tid = threadIdx.x, lane = tid & 63, wave = __builtin_amdgcn_readfirstlane(tid >> 6);
    const int gw = blockIdx.x * 8 + wave, NGW = gridDim.x * 8;
    unsigned char* ws = args.ws;
    if (L == 0) row_pass<true, true>(args.in[0], (const bf16_t*)(ws + WS_Y), args.in[13], args.out, args.in[1] + DM, (bf16_t*)(ws + WS_H), ws + WS_H8, (float*)(ws + WS_HS), gw, NGW, lane);
    else row_pass<true, false>(args.out, (const bf16_t*)(ws + WS_Y), args.in[13] + DM, args.out, nullptr, nullptr, nullptr, nullptr, gw, NGW, lane);
}

__global__ void __launch_bounds__(512, 2) mk_fwd(const Args args) {
    extern __shared__ __attribute__((aligned(16))) unsigned char lds_raw[];
    LAS unsigned char* lds = (LAS unsigned char*)lds_raw;
    const int lo = args.ph_lo, hi = args.ph_hi;
    volatile LAS unsigned* bst = (volatile LAS unsigned*)(lds + LDS_BYTES - 64);
    if (threadIdx.x < 2) bst[threadIdx.x] = 0u;
    __syncthreads();
    XcdBarrier xbar; xbar.bar = (unsigned*)args.ws; xbar.x = 0; xbar.st = nullptr;
    if (hi - lo > 1) xbar = xcd_barrier_post((unsigned*)args.ws, bst);
#define IN(k) (lo <= (k) && (k) < hi)
#define SEAM(k) do { if (IN((k) + 1)) xcd_barrier(xbar); } while (0)
    if (hi > NPH) cg::this_grid().sync();
#ifndef REP_PRO
#define REP_PRO 1
#endif
#ifndef REP_IN
#define REP_IN 1
#endif
#ifndef REP_MIX
#define REP_MIX 1
#endif
#ifndef REP_BR
#define REP_BR 1
#endif
#ifndef REP_OUT
#define REP_OUT 1
#endif
#ifndef REP_ROW
#define REP_ROW 1
#endif
#ifndef REP_SYNC
#define REP_SYNC 0
#endif
    if (IN(0)) { phase_prologue(args, lds); xcd_barrier(xbar); phase_quant(args, lds); SEAM(0); }
    if (IN(1)) { for (int rep = 0; rep < REP_IN; ++rep) phase_in<0>(args, lds); SEAM(1); }
    if (IN(2)) { for (int rep = 0; rep < REP_MIX; ++rep) phase_mix<0>(args, lds); SEAM(2); }
    if (IN(3)) { for (int rep = 0; rep < REP_BR; ++rep) phase_br<0>(args, lds); SEAM(3); }
    if (IN(4)) { for (int rep = 0; rep < REP_OUT; ++rep) phase_out<0>(args, lds); SEAM(4); }
    if (IN(5)) { for (int rep = 0; rep < REP_ROW; ++rep) phase_row<0>(args); SEAM(5); }
    if (IN(6)) { phase_in<1>(args, lds); SEAM(6); }
    if (IN(7)) { phase_mix<1>(args, lds); SEAM(7); }
    if (IN(8)) { phase_br<1>(args, lds); SEAM(8); }
    if (IN(9)) { phase_out<1>(args, lds); SEAM(9); }
    if (IN(10)) { phase_row<1>(args); }
#undef IN
#undef SEAM
}

extern "C" void kernel_launch(void* const* d_in, const int* in_sizes, int n_in, void* d_out, int out_size, void* d_ws, size_t ws_size, hipStream_t stream) {
    static int grid = 0;
    if (grid == 0) {
        if (n_in != 14 || out_size != MT * DM || ws_size < WS_END) { fprintf(stderr, "kernel_launch: unexpected shapes (n_in %d out %d ws %zu)\n", n_in, out_size, ws_size); grid = -1; return; }
        int dev = 0, cus = 0, per_cu = 0;
        hipGetDevice(&dev);
        hipDeviceGetAttribute(&cus, hipDeviceAttributeMultiprocessorCount, dev);
        if (hipFuncSetAttribute((const void*)mk_fwd, hipFuncAttributeMaxDynamicSharedMemorySize, LDS_BYTES) != hipSuccess) { fprintf(stderr, "kernel_launch: hipFuncSetAttribute failed\n"); grid = -1; return; }
        if (hipOccupancyMaxActiveBlocksPerMultiprocessor(&per_cu, (const void*)mk_fwd, 512, LDS_BYTES) != hipSuccess || per_cu < 1) { fprintf(stderr, "kernel_launch: occupancy query says %d\n", per_cu); per_cu = 1; }
        (void)hipGetLastError();
        grid = cus * 1;
    }
    if (grid < 0) return;
    (void)hipMemsetAsync(d_ws, 0, 98304, stream);
    Args a{};
    for (int i = 0; i < 14; ++i) a.in[i] = (const float*)d_in[i];
    a.out = (float*)d_out; a.ws = (unsigned char*)d_ws;
#if MK_N_LAUNCHES == 1
    a.ph_lo = 0; a.ph_hi = NPH;
    void* kargs[] = {&a};
    hipError_t e = hipLaunchCooperativeKernel((const void*)mk_fwd, dim3(grid), dim3(512), kargs, LDS_BYTES, stream);
    if (e != hipSuccess) fprintf(stderr, "cooperative launch failed: %s (grid %d)\n", hipGetErrorString(e), grid);
#else
    for (int p = 0; p < NPH; ++p) { a.ph_lo = p; a.ph_hi = p + 1; hipLaunchKernelGGL(mk_fwd, dim3(grid), dim3(512), LDS_BYTES, stream, a); }
#endif
}
```

```cpp
#include <hip/hip_runtime.h>
#include <hip/hip_cooperative_groups.h>
#include <cstdio>
#include <cstdint>
namespace cg = cooperative_groups;

#define LAS __attribute__((address_space(3)))
typedef unsigned short bf16_t;
typedef short bf16x8 __attribute__((ext_vector_type(8)));
typedef float f32x4 __attribute__((ext_vector_type(4)));
typedef float f32x2 __attribute__((ext_vector_type(2)));
typedef float f32x16 __attribute__((ext_vector_type(16)));
typedef unsigned u32x4 __attribute__((ext_vector_type(4)));
typedef unsigned u32x2 __attribute__((ext_vector_type(2)));
typedef __bf16 bf16x2_t __attribute__((ext_vector_type(2)));
typedef int i32x4 __attribute__((ext_vector_type(4)));

#ifndef MK_N_LAUNCHES
#define MK_N_LAUNCHES 1
#endif

constexpr int MT = 16384;
constexpr int SEQ = 2048;
constexpr int DM = 2048;
constexpr int NIN = 17408;
constexpr int DH = 1024;
constexpr int NREL = 320;
constexpr int PT = MT + 64;
constexpr float LOG2E = 1.4426950408889634f;
constexpr float QSCALE = 0.125f * LOG2E;
constexpr float EPSN = 1e-6f;
constexpr int NBF = 8 * 1024; constexpr int NI8 = NIN - NBF;

constexpr size_t MiB = 1u << 20;
constexpr size_t WS_WIN = 2 * MiB;
constexpr size_t WS_WBR = 138 * MiB;
constexpr size_t WS_WOUT = 162 * MiB;
constexpr size_t WS_H = 178 * MiB;
constexpr size_t WS_SEG = 242 * MiB;
constexpr size_t WS_GATES = 594 * MiB;
constexpr size_t WS_O = 786 * MiB;
constexpr size_t WS_SGUW = 882 * MiB;
constexpr size_t WS_VT = 884 * MiB;
constexpr size_t WS_VCT = 918 * MiB;
constexpr size_t WS_H8 = 952 * MiB;
constexpr size_t WS_W8 = 984 * MiB;
constexpr size_t WS_HS = 1020 * MiB;
constexpr size_t WS_END = 1021 * MiB;
constexpr size_t WS_COLMAX = 16384;
constexpr size_t SEGB = 32 * MiB;
constexpr size_t WS_MERGED32 = WS_SEG;
constexpr size_t WS_MERGED16 = WS_SEG + 4 * SEGB;
constexpr size_t WS_Y = WS_SEG + 6 * SEGB;

constexpr int LDS_BYTES = 163840;

__device__ __forceinline__ unsigned pk2(float lo, float hi) { f32x2 v = {lo, hi}; bf16x2_t b = __builtin_convertvector(v, bf16x2_t); return __builtin_bit_cast(unsigned, b); }
__device__ __forceinline__ unsigned q8x4(float a, float b, float c, float d) {
    const int ia = (int)__builtin_rintf(a), ib = (int)__builtin_rintf(b), ic = (int)__builtin_rintf(c), id = (int)__builtin_rintf(d);
    return (unsigned)(ia & 0xff) | ((unsigned)(ib & 0xff) << 8) | ((unsigned)(ic & 0xff) << 16) | ((unsigned)id << 24); }
__device__ __forceinline__ float bflo(unsigned u) { return __uint_as_float(u << 16); }
__device__ __forceinline__ float bfhi(unsigned u) { return __uint_as_float(u & 0xffff0000u); }
__device__ __forceinline__ float fast_sigmoid(float w) { return __builtin_amdgcn_rcpf(1.0f + __builtin_amdgcn_exp2f(-w * LOG2E)); }
__device__ __forceinline__ float wave_sum(float v) {
#pragma unroll
    for (int o = 1; o < 64; o <<= 1) v += __shfl_xor(v, o);
    return v;
}
#define MFMA32(a, b, c) __builtin_amdgcn_mfma_f32_32x32x16_bf16((a), (b), (c), 0, 0, 0)

namespace pg8 {
constexpr int BM = 256, BK = 64, HALF = 128, HTB = HALF * BK * 2, STAGE_BYTES = 8 * HTB, NXCD = 8, WGM = 8;
__device__ __forceinline__ int lds_byte(int r, int c) { const int st = (r >> 4) * 2 + (c >> 5), rr = r & 15, cc = c & 31, ob = rr * 64 + cc * 2; return st * 1024 + (ob ^ (((ob >> 9) & 1) << 5)); }
__device__ __forceinline__ void stage_rc(int b, int& R, int& C) { const int st = b / 1024, sb = b % 1024, swz = sb ^ (((sb >> 9) & 1) << 5); R = (st >> 1) * 16 + swz / 64; C = (st & 1) * 32 + (swz % 64) / 2; }
__device__ __forceinline__ int perm32(int rho) { const int n = rho >> 4, i = rho & 15; return 8 * (i >> 2) + 4 * n + (i & 3); }

struct Unit { int pm, pn, z; };
struct Gemm { const bf16_t* A; const bf16_t* Bt; int M, N, K; size_t zA, zB; };

template <int NZ> struct TileOrder {
    int nM, nN, nwg, G, c;
    __device__ void init(int M, int N, int G_, int c_) { nM = M / BM; nN = N / BM; nwg = nM * nN; G = G_; c = c_; }
    __device__ bool next(int i, Unit& u) const {
        const int ti = i / NZ; u.z = i - ti * NZ;
        const long L = (long)ti * G + c; if (L >= nwg) return false;
        int wgid = (int)L; { const int q = nwg / NXCD, r = nwg % NXCD, xcd = wgid % NXCD, off = wgid / NXCD; wgid = (xcd < r ? xcd * (q + 1) : r * (q + 1) + (xcd - r) * q) + off; }
        const int nig = WGM * nN, gid = wgid / nig, fm = gid * WGM, gsz = (nM - fm) < WGM ? (nM - fm) : WGM;
        u.pm = fm + ((wgid % nig) % gsz); u.pn = (wgid % nig) / gsz; return true;
    }
};


template <int MODE> __device__ __forceinline__ f32x2 act2(f32x2 v, float sc) {
    if constexpr (MODE == 0) return v * sc;
    f32x2 t;
    if constexpr (MODE == 2) { const f32x2 x2 = v * v; t = v * (x2 * (-0.10294325f) + (-2.3022082f)); }
    else t = v * (-LOG2E);
    if constexpr (MODE == 3) { t.x = fminf(t.x, 20.f); t.y = fminf(t.y, 20.f); }
    f32x2 d; d.x = __builtin_amdgcn_exp2f(t.x); d.y = __builtin_amdgcn_exp2f(t.y);
    d = d + 1.0f;
    f32x2 r; r.x = __builtin_amdgcn_rcpf(d.x); r.y = __builtin_amdgcn_rcpf(d.y);
    if constexpr (MODE == 3) return r;
    return v * r;
}
template <int MODE, bool TR, bool I8 = false>
__device__ __forceinline__ void epi_in_tile(const f32x4 (&acc)[2][2][4][2], bf16_t* __restrict__ base, int ldc, int row0, int col0, float sc,
                                            const float* __restrict__ hs = nullptr, const float* __restrict__ cmx = nullptr) {
    f32x4 cs[2][2];
    if constexpr (I8) {
#pragma unroll
        for (int bj = 0; bj < 2; ++bj) { cs[bj][0] = *(const f32x4*)(cmx + bj * HALF) * (1.f / 127.f); cs[bj][1] = *(const f32x4*)(cmx + bj * HALF + 4) * (1.f / 127.f); }
    }
#pragma unroll
    for (int ai = 0; ai < 2; ++ai)
#pragma unroll
        for (int m = 0; m < 4; ++m) {
            const int row = row0 + ai * HALF + m * 16;
            float rs = 1.f; if constexpr (I8) rs = hs[row];
#pragma unroll
            for (int bj = 0; bj < 2; ++bj) {
                f32x4 a0 = acc[ai][bj][m][0], a1 = acc[ai][bj][m][1];
                if constexpr (I8) { const i32x4 i0 = __builtin_bit_cast(i32x4, a0), i1 = __builtin_bit_cast(i32x4, a1);
                    a0 = (f32x4){(float)i0[0], (float)i0[1], (float)i0[2], (float)i0[3]} * rs * cs[bj][0];
                    a1 = (f32x4){(float)i1[0], (float)i1[1], (float)i1[2], (float)i1[3]} * rs * cs[bj][1]; }
                const f32x2 p0 = act2<MODE>((f32x2){a0[0], a0[1]}, sc), p1 = act2<MODE>((f32x2){a0[2], a0[3]}, sc);
                const f32x2 p2 = act2<MODE>((f32x2){a1[0], a1[1]}, sc), p3 = act2<MODE>((f32x2){a1[2], a1[3]}, sc);
                u32x4 w; w.x = pk2(p0.x, p0.y); w.y = pk2(p1.x, p1.y); w.z = pk2(p2.x, p2.y); w.w = pk2(p3.x, p3.y);
                if constexpr (!TR) {
                    *(u32x4*)(base + (size_t)row * ldc + col0 + bj * HALF) = w;
                } else {
                    bf16_t* tp = base + (size_t)(col0 + bj * HALF) * PT + row;
                    tp[0 * (size_t)PT] = (bf16_t)(w.x & 0xffffu); tp[1 * (size_t)PT] = (bf16_t)(w.x >> 16);
                    tp[2 * (size_t)PT] = (bf16_t)(w.y & 0xffffu); tp[3 * (size_t)PT] = (bf16_t)(w.y >> 16);
                    tp[4 * (size_t)PT] = (bf16_t)(w.z & 0xffffu); tp[5 * (size_t)PT] = (bf16_t)(w.z >> 16);
                    tp[6 * (size_t)PT] = (bf16_t)(w.w & 0xffffu); tp[7 * (size_t)PT] = (bf16_t)(w.w >> 16);
                }
            }
        }
}
struct EpiIn {
    static constexpr bool PERM = true;
    unsigned char* seg;
    bf16_t* gates;
    bf16_t* vt; bf16_t* vct;
    __device__ __forceinline__ bool reset(const Unit&) const { return true; }
    __device__ __forceinline__ void prefetch(const Unit&, int, int, int, int, float&) const {}
    __device__ __forceinline__ void operator()(const f32x4 (&acc)[2][2][4][2], const Unit& u, int wr, int wc, int fr, int fq) const {
        const int colt = u.pn * BM;
        const int row0 = u.pm * BM + wr * 64 + fr;
        const int lc = wc * 32 + 8 * fq;
        const int s = colt >> 10; const int col0 = (colt & 1023) + lc;
        bf16_t* base = (bf16_t*)(seg + (size_t)s * SEGB);
        if (s == 3 || s == 7) epi_in_tile<1, false>(acc, base, DH, row0, col0, 1.f);
        else if (s == 2) epi_in_tile<0, true>(acc, vt, 0, row0, col0, 1.f);
        else epi_in_tile<0, false>(acc, base, DH, row0, col0, s == 0 ? QSCALE : 1.f);
    }
};

struct EpiIn8 {
    static constexpr bool PERM = true;
    unsigned char* seg; bf16_t* gates; bf16_t* vct; const float* hs; const float* colmax;
    __device__ __forceinline__ bool reset(const Unit&) const { return true; }
    __device__ __forceinline__ void operator()(const f32x4 (&acc)[2][2][4][2], const Unit& u, int wr, int wc, int fr, int fq) const {
        const int colt = NBF + u.pn * BM;
        const int row0 = u.pm * BM + wr * 64 + fr;
        const int lc = wc * 32 + 8 * fq;
        const float* cmx = colmax + u.pn * BM + lc;
        if (colt >= 11 * DH) { epi_in_tile<3, false, true>(acc, gates, 3 * DM, row0, colt - 11 * DH + lc, 1.f, hs, cmx); return; }
        const int s = colt >> 10; const int col0 = (colt & 1023) + lc;
        bf16_t* base = (bf16_t*)(seg + (size_t)s * SEGB);
        if (s == 10) epi_in_tile<1, false, true>(acc, base, DH, row0, col0, 1.f, hs, cmx);
        else if (s == 9) epi_in_tile<2, true, true>(acc, vct, 0, row0, col0, 1.f, hs, cmx);
        else epi_in_tile<2, false, true>(acc, base, DH, row0, col0, 1.f, hs, cmx);
    }
};

struct EpiPlain {
    static constexpr bool PERM = true;
    bf16_t* O; int ldc;
    __device__ __forceinline__ bool reset(const Unit&) const { return true; }
    __device__ __forceinline__ void prefetch(const Unit&, int, int, int, int, float&) const {}
    __device__ __forceinline__ void operator()(const f32x4 (&acc)[2][2][4][2], const Unit& u, int wr, int wc, int fr, int fq) const {
        const int row0 = u.pm * BM + wr * 64 + fr, col0 = u.pn * BM + wc * 32 + 8 * fq;
#pragma unroll
        for (int ai = 0; ai < 2; ++ai)
#pragma unroll
            for (int m = 0; m < 4; ++m) { bf16_t* rowp = O + (size_t)(row0 + ai * HALF + m * 16) * ldc + col0;
#pragma unroll
                for (int bj = 0; bj < 2; ++bj) { const f32x4 v0 = acc[ai][bj][m][0], v1 = acc[ai][bj][m][1];
                    u32x4 w; w.x = pk2(v0[0], v0[1]); w.y = pk2(v0[2], v0[3]); w.z = pk2(v1[0], v1[1]); w.w = pk2(v1[2], v1[3]);
                    *(u32x4*)(rowp + bj * HALF) = w; } }
    }
};

struct EpiMerge {
    static constexpr bool PERM = true;
    const bf16_t* __restrict__ gates; bf16_t* __restrict__ out;
    __device__ __forceinline__ bool reset(const Unit& u) const { return u.z == 2; }
    __device__ __forceinline__ void prefetch(const Unit& u, int wr, int wc, int fr, int fq, float& dummy) const {
        const int row0 = u.pm * BM + wr * 64 + fr, col0 = u.pn * BM + wc * 32 + 8 * fq;
        const bf16_t* p = gates + (size_t)row0 * (3 * DM) + u.z * DM + col0;
        asm volatile("" : "+v"(p));
        const bool two = u.z < 2;
#pragma unroll
        for (int i = 0; i < 8; ++i) {
            asm volatile("global_load_dword %0, %1, off" : "+v"(dummy) : "v"(p) : "memory");
            asm volatile("global_load_dword %0, %1, off offset:256" : "+v"(dummy) : "v"(p) : "memory");
            if (two) { const bf16_t* p2 = p + DM;
                asm volatile("global_load_dword %0, %1, off" : "+v"(dummy) : "v"(p2) : "memory");
                asm volatile("global_load_dword %0, %1, off offset:256" : "+v"(dummy) : "v"(p2) : "memory"); }
            p += (size_t)(i == 3 ? 16 + 64 : 16) * (3 * DM);
        }
    }
    __device__ __forceinline__ void operator()(f32x4 (&acc)[2][2][4][2], const Unit& u, int wr, int wc, int fr, int fq) const {
        const int row0 = u.pm * BM + wr * 64 + fr, col0 = u.pn * BM + wc * 32 + 8 * fq;
        const int z = u.z;
        const bf16_t* gz = gates + (size_t)row0 * (3 * DM) + z * DM + col0;
        if (z < 2) {
#pragma unroll
            for (int ai = 0; ai < 2; ++ai) {
                u32x4 gn[4][2], gd[4][2];
#pragma unroll
                for (int m = 0; m < 4; ++m)
#pragma unroll
                    for (int bj = 0; bj < 2; ++bj) { const bf16_t* p = gz + (size_t)(ai * HALF + m * 16) * (3 * DM) + bj * HALF; gn[m][bj] = *(const u32x4*)p; gd[m][bj] = *(const u32x4*)(p + DM); }
#pragma unroll
                for (int m = 0; m < 4; ++m)
#pragma unroll
                    for (int bj = 0; bj < 2; ++bj) {
                        const u32x4 a = gn[m][bj], d = gd[m][bj];
                        f32x4& v0 = acc[ai][bj][m][0]; f32x4& v1 = acc[ai][bj][m][1];
                        v0[0] *= bflo(a.x) * __builtin_amdgcn_rcpf(bflo(d.x)); v0[1] *= bfhi(a.x) * __builtin_amdgcn_rcpf(bfhi(d.x));
                        v0[2] *= bflo(a.y) * __builtin_amdgcn_rcpf(bflo(d.y)); v0[3] *= bfhi(a.y) * __builtin_amdgcn_rcpf(bfhi(d.y));
                        v1[0] *= bflo(a.z) * __builtin_amdgcn_rcpf(bflo(d.z)); v1[1] *= bfhi(a.z) * __builtin_amdgcn_rcpf(bfhi(d.z));
                        v1[2] *= bflo(a.w) * __builtin_amdgcn_rcpf(bflo(d.w)); v1[3] *= bfhi(a.w) * __builtin_amdgcn_rcpf(bfhi(d.w));
                    }
            }
        } else {
#pragma unroll
            for (int ai = 0; ai < 2; ++ai) {
                u32x4 gn[4][2];
#pragma unroll
                for (int m = 0; m < 4; ++m)
#pragma unroll
                    for (int bj = 0; bj < 2; ++bj) gn[m][bj] = *(const u32x4*)(gz + (size_t)(ai * HALF + m * 16) * (3 * DM) + bj * HALF);
#pragma unroll
                for (int m = 0; m < 4; ++m)
#pragma unroll
                    for (int bj = 0; bj < 2; ++bj) {
                        const u32x4 a = gn[m][bj];
                        const f32x4 v0 = acc[ai][bj][m][0], v1 = acc[ai][bj][m][1];
                        u32x4 w; w.x = pk2(v0[0] * bflo(a.x), v0[1] * bfhi(a.x)); w.y = pk2(v0[2] * bflo(a.y), v0[3] * bfhi(a.y));
                        w.z = pk2(v1[0] * bflo(a.z), v1[1] * bfhi(a.z)); w.w = pk2(v1[2] * bflo(a.w), v1[3] * bfhi(a.w));
                        *(u32x4*)(out + (size_t)(row0 + ai * HALF + m * 16) * DM + col0 + bj * HALF) = w;
                    }
            }
        }
    }
};

template <class Epi, class Sched, bool ALIGN_EPI, bool I8 = false>
__device__ __forceinline__ void gemm_phase(LAS unsigned char* lds, const Gemm g, const Sched& S, const Epi& E) {
    const int tid = threadIdx.x, wid = __builtin_amdgcn_readfirstlane(tid >> 6), lane = tid & 63, wr = wid >> 2, wc = wid & 3, fr = lane & 15, fq = lane >> 4;
    const int K = g.K, nt = K / BK;
    unsigned voffA[2], voffB[2];
#pragma unroll
    for (int i = 0; i < 2; ++i) { int R, C; stage_rc(tid * 16 + i * 8192, R, C); const int Rb = Epi::PERM ? ((R & ~31) + perm32(R & 31)) : R;
        voffA[i] = (unsigned)(R * K + C) * 2u; voffB[i] = (unsigned)(Rb * K + C) * 2u; }
    const size_t kstep = (size_t)(BK * 2);
    const size_t hstep = (size_t)HALF * K * 2;
    const size_t tstep = 2 * hstep;
    const unsigned ldsw = (unsigned)wid * 1024u;
    const int aoff = lds_byte(wr * 64 + fr, fq * 8), boff = lds_byte(wc * 32 + fr, fq * 8);
#define PG8_SA(b, h) (((b) * 2 + (h)) * HTB)
#define PG8_SB(b, h) ((4 + (b) * 2 + (h)) * HTB)
#define PG8_STAGE(bufoff, gbase, voff) do { _Pragma("unroll") for (int _i = 0; _i < 2; ++_i) \
        __builtin_amdgcn_global_load_lds((const unsigned*)((const char*)(gbase) + (voff)[_i]), (LAS unsigned*)(lds + (bufoff) + ldsw + _i * 8192), 16, 0, 0); } while (0)
#define PG8_LDA(dst, b, h) do { _Pragma("unroll") for (int m = 0; m < 4; ++m) _Pragma("unroll") for (int k = 0; k < 2; ++k) dst[m][k] = *(const LAS bf16x8*)(lds + PG8_SA(b, h) + aoff + m * 2048 + k * 1024); } while (0)
#define PG8_LDB(dst, b, h) do { _Pragma("unroll") for (int n = 0; n < 2; ++n) _Pragma("unroll") for (int k = 0; k < 2; ++k) dst[n][k] = *(const LAS bf16x8*)(lds + PG8_SB(b, h) + boff + n * 2048 + k * 1024); } while (0)
#define PG8_MMA(ai, bj, At, Bt) do { __builtin_amdgcn_s_setprio(1); _Pragma("unroll") for (int m = 0; m < 4; ++m) _Pragma("unroll") for (int n = 0; n < 2; ++n) _Pragma("unroll") for (int k = 0; k < 2; ++k) { \
        if constexpr (I8) acc[ai][bj][m][n] = __builtin_bit_cast(f32x4, __builtin_amdgcn_mfma_i32_16x16x64_i8(__builtin_bit_cast(i32x4, Bt[n][k]), __builtin_bit_cast(i32x4, At[m][k]), __builtin_bit_cast(i32x4, acc[ai][bj][m][n]), 0, 0, 0)); \
        else acc[ai][bj][m][n] = __builtin_amdgcn_mfma_f32_16x16x32_bf16(Bt[n][k], At[m][k], acc[ai][bj][m][n], 0, 0, 0); } __builtin_amdgcn_s_setprio(0); } while (0)
#define PG8_WAIT_V(n) asm volatile("s_waitcnt vmcnt(" #n ")" ::: "memory")
#define PG8_WAIT_L(n) asm volatile("s_waitcnt lgkmcnt(" #n ")" ::: "memory")
#define PG8_BAR __builtin_amdgcn_s_barrier()
#define PG8_SCHED __builtin_amdgcn_sched_barrier(0)
    Unit cur, nxt; int ui = 0;
    if (!S.next(0, cur)) return;
    f32x4 acc[2][2][4][2];
#pragma unroll
    for (int a = 0; a < 2; ++a)
#pragma unroll
        for (int b = 0; b < 2; ++b)
#pragma unroll
            for (int m = 0; m < 4; ++m)
#pragma unroll
                for (int n = 0; n < 2; ++n) acc[a][b][m][n] = (f32x4){0.f, 0.f, 0.f, 0.f};
    bf16x8 At[4][2], B0[2][2], B1[2][2];
    const char* cA = (const char*)g.A + (size_t)cur.z * g.zA + (size_t)cur.pm * tstep; const char* cB = (const char*)g.Bt + (size_t)cur.z * g.zB + (size_t)cur.pn * tstep;
    PG8_STAGE(PG8_SB(0, 0), cB, voffB); PG8_STAGE(PG8_SB(0, 1), cB + hstep, voffB); PG8_STAGE(PG8_SA(0, 0), cA, voffA); PG8_STAGE(PG8_SA(0, 1), cA + hstep, voffA);
    if (wr == 1) PG8_BAR;
    PG8_WAIT_V(2); PG8_BAR;
    PG8_STAGE(PG8_SB(1, 0), cB + kstep, voffB); PG8_STAGE(PG8_SA(1, 0), cA + kstep, voffA); PG8_STAGE(PG8_SB(1, 1), cB + hstep + kstep, voffB);
    PG8_WAIT_V(6); PG8_BAR;
    for (;;) {
        const bool has_next = S.next(ui + 1, nxt);
        const char* nA = has_next ? (const char*)g.A + (size_t)nxt.z * g.zA + (size_t)nxt.pm * tstep : cA;
        const char* nB = has_next ? (const char*)g.Bt + (size_t)nxt.z * g.zB + (size_t)nxt.pn * tstep : cB;
        for (int t = 0; t < nt; t += 2) {
            const bool last = (t == nt - 2);
            const char* a1 = cA + (size_t)(t + 1) * kstep;
            const char* a2 = last ? nA : cA + (size_t)(t + 2) * kstep; const char* b2 = last ? nB : cB + (size_t)(t + 2) * kstep;
            const char* a3 = a2 + kstep; const char* b3 = b2 + kstep;
            PG8_LDB(B0, 0, 0); PG8_LDB(B1, 0, 1); PG8_SCHED; PG8_LDA(At, 0, 0); PG8_STAGE(PG8_SA(1, 1), a1 + hstep, voffA);
            PG8_WAIT_V(8); PG8_WAIT_L(0); PG8_BAR; PG8_MMA(0, 0, At, B0); PG8_MMA(0, 1, At, B1); PG8_BAR; PG8_SCHED;
            PG8_LDA(At, 0, 1); PG8_STAGE(PG8_SB(0, 0), b2, voffB); PG8_STAGE(PG8_SB(0, 1), b2 + hstep, voffB); PG8_STAGE(PG8_SA(0, 0), a2, voffA);
            PG8_WAIT_V(8); PG8_WAIT_L(0); PG8_BAR; PG8_MMA(1, 0, At, B0); PG8_MMA(1, 1, At, B1); PG8_BAR; PG8_SCHED;
            PG8_LDB(B0, 1, 0); PG8_LDB(B1, 1, 1); PG8_SCHED; PG8_LDA(At, 1, 0); PG8_STAGE(PG8_SA(0, 1), a2 + hstep, voffA);
            PG8_WAIT_V(8); PG8_WAIT_L(0); PG8_BAR; PG8_MMA(0, 0, At, B0); PG8_MMA(0, 1, At, B1); PG8_BAR; PG8_SCHED;
            PG8_LDA(At, 1, 1); PG8_STAGE(PG8_SB(1, 0), b3, voffB); PG8_STAGE(PG8_SB(1, 1), b3 + hstep, voffB); PG8_STAGE(PG8_SA(1, 0), a3, voffA);
            PG8_WAIT_V(8); PG8_WAIT_L(0); PG8_BAR; PG8_MMA(1, 0, At, B0); PG8_MMA(1, 1, At, B1); PG8_BAR; PG8_SCHED;
        }
        if constexpr (ALIGN_EPI) { if (wr == 0) PG8_BAR; }
        E(acc, cur, wr, wc, fr, fq);
        if (!has_next) break;
        if (E.reset(cur)) {
#pragma unroll
        for (int a = 0; a < 2; ++a)
#pragma unroll
            for (int b = 0; b < 2; ++b)
#pragma unroll
                for (int m = 0; m < 4; ++m)
#pragma unroll
                    for (int n = 0; n < 2; ++n) acc[a][b][m][n] = (f32x4){0.f, 0.f, 0.f, 0.f};
        }
        cur = nxt; cA = nA; cB = nB; ++ui;
        if constexpr (ALIGN_EPI) { if (wr == 1) PG8_BAR; }
    }
    PG8_WAIT_V(0);
    if constexpr (!ALIGN_EPI) { if (wr == 0) PG8_BAR; }
    PG8_BAR;
#undef PG8_SA
#undef PG8_SB
#undef PG8_STAGE
#undef PG8_LDA
#undef PG8_LDB
#undef PG8_MMA
#undef PG8_WAIT_V
#undef PG8_WAIT_L
#undef PG8_BAR
#undef PG8_SCHED
}
}

#define GAS __attribute__((address_space(1)))
#define RLX_AGENT __ATOMIC_RELAXED, __HIP_MEMORY_SCOPE_AGENT
#define XB_TMO      128
#define XB_XCNT(j)  (256  + 64 * (j))
#define XB_XSUB(j)  (1280 + 64 * (j))
#define XB_XGEN(j)  (2304 + 64 * (j))
#define XB_TOP      3328
#define XB_TOPGEN   3392
#define XCD_BAR_WORDS 3456
#define XB_SPIN_CAP (1u << 18)

__device__ __forceinline__ unsigned xb_ld(unsigned* p)              { return __hip_atomic_load(p, __ATOMIC_RELAXED, __HIP_MEMORY_SCOPE_AGENT); }
__device__ __forceinline__ unsigned xb_add(unsigned* p, unsigned v) { return __hip_atomic_fetch_add(p, v, __ATOMIC_RELAXED, __HIP_MEMORY_SCOPE_AGENT); }
__device__ __forceinline__ unsigned xb_xcc_id() { return (unsigned)__builtin_amdgcn_s_getreg((3 << 11) | 20) & 0xFu; }
#define XB_SPIN(cond, bar) do { unsigned _sp = 0; while (cond) { __builtin_amdgcn_s_sleep(1); \
    if ((++_sp & 255u) == 0u) { if (xb_ld(&(bar)[XB_TMO])) break; if (_sp > XB_SPIN_CAP) { atomicAdd(&(bar)[XB_TMO], 1u); break; } } } } while (0)

struct XcdBarrier {
    unsigned* bar; unsigned x;
    volatile LAS unsigned* st;
};

__device__ __forceinline__ XcdBarrier xcd_barrier_post(unsigned* bar, volatile LAS unsigned* st) {
    XcdBarrier b; b.bar = bar; b.x = xb_xcc_id(); b.st = st;
    if (threadIdx.x == 0) (void)xb_add(&bar[XB_XCNT(b.x)], 1u);
    return b;
}
__device__ __forceinline__ void xcd_barrier_complete(unsigned* bar, unsigned x, unsigned& nloc, unsigned& nx) {
    const unsigned G = gridDim.x * gridDim.y * gridDim.z;
    unsigned sum, cnt, mine, sp = 0u;
    for (;;) {
        sum = 0u; cnt = 0u; mine = 0u;
#pragma unroll
        for (unsigned j = 0; j < 16; ++j) { const unsigned c = xb_ld(&bar[XB_XCNT(j)]); sum += c; cnt += (c > 0u) ? 1u : 0u; mine = (j == x) ? c : mine; }
        if (sum == G) break;
        __builtin_amdgcn_s_sleep(1);
        if ((++sp & 255u) == 0u) { if (xb_ld(&bar[XB_TMO])) break; if (sp > XB_SPIN_CAP) { atomicAdd(&bar[XB_TMO], 1u); break; } }
    }
    nloc = mine > 0u ? mine : 1u; nx = cnt > 0u ? cnt : 1u;
}

__device__ __forceinline__ void xcd_barrier(const XcdBarrier& b) {
    asm volatile("s_waitcnt vmcnt(0)" ::: "memory");
    __syncthreads();
    if (threadIdx.x == 0) {
        unsigned* bar = b.bar;
        __builtin_amdgcn_s_waitcnt(0);
        unsigned nloc = b.st[0], nx = b.st[1];
        if (nloc == 0u) { xcd_barrier_complete(bar, b.x, nloc, nx); b.st[0] = nloc; b.st[1] = nx; }
        const unsigned old = xb_add(&bar[XB_XSUB(b.x)], 1u);
        const unsigned gen = old / nloc;
        if (old + 1u == (gen + 1u) * nloc) {
            __builtin_amdgcn_fence(__ATOMIC_RELEASE, "agent");
            asm volatile("s_waitcnt vmcnt(0)" ::: "memory");
            const unsigned og = xb_add(&bar[XB_TOP], 1u);
            const unsigned tg = og / nx;
            if (og + 1u == (tg + 1u) * nx) xb_add(&bar[XB_TOPGEN], 1u);
            else XB_SPIN(xb_ld(&bar[XB_TOPGEN]) == tg, bar);
            __builtin_amdgcn_fence(__ATOMIC_ACQUIRE, "agent");
            xb_add(&bar[XB_XGEN(b.x)], 1u);
            asm volatile("s_waitcnt vmcnt(0)" ::: "memory");
        } else {
            XB_SPIN(xb_ld(&bar[XB_XGEN(b.x)]) == gen, bar);
            __builtin_amdgcn_fence(__ATOMIC_ACQUIRE, "agent");
            asm volatile("s_waitcnt vmcnt(0)" ::: "memory");
        }
    }
    __syncthreads();
}

__device__ __forceinline__ void transpose_item(const float* __restrict__ W, int K, int N, bf16_t* __restrict__ WT, LAS float* scr, int item, int lane) {
    const int nblk = N / 32, kb = item / nblk, nb = item - kb * nblk, k0 = 64 * kb, n0 = 32 * nb;
    float tv[32];
#pragma unroll
    for (int i = 0; i < 32; ++i) { const int kk = 2 * i + (lane >> 5); tv[i] = W[(size_t)(k0 + kk) * N + n0 + (lane & 31)]; }
#pragma unroll
    for (int i = 0; i < 32; ++i) { const int kk = 2 * i + (lane >> 5); scr[kk * 33 + (lane & 31)] = tv[i]; }
    asm volatile("s_waitcnt lgkmcnt(0)" ::: "memory");
    const int c = lane & 7;
#pragma unroll
    for (int j = 0; j < 4; ++j) { const int n = (lane >> 3) + 8 * j; const LAS float* s = scr + (8 * c) * 33 + n;
        u32x4 o; o.x = pk2(s[0 * 33], s[1 * 33]); o.y = pk2(s[2 * 33], s[3 * 33]); o.z = pk2(s[4 * 33], s[5 * 33]); o.w = pk2(s[6 * 33], s[7 * 33]);
        *(u32x4*)(WT + (size_t)(n0 + n) * K + k0 + 8 * c) = o; }
    asm volatile("s_waitcnt lgkmcnt(0)" ::: "memory");
}

template <bool QUANT>
__device__ __forceinline__ void gate_weight_item(const float* __restrict__ W, int K, int N, unsigned char* __restrict__ W8, unsigned* colmax, int nbase, LAS float* scr, int item, int lane) {
    constexpr int NBG = NI8 / 32;
    const int kb = item / NBG, nb = item - kb * NBG, k0 = 64 * kb, n0 = nbase + 32 * nb;
    float tv[32];
#pragma unroll
    for (int i = 0; i < 32; ++i) { const int kk = 2 * i + (lane >> 5); tv[i] = W[(size_t)(k0 + kk) * N + n0 + (lane & 31)]; }
    if constexpr (!QUANT) {
        float mx = 0.f;
#pragma unroll
        for (int i = 0; i < 32; ++i) mx = fmaxf(mx, fabsf(tv[i]));
        mx = fmaxf(mx, __shfl_xor(mx, 32));
        if (lane < 32) atomicMax(colmax + (n0 - nbase) + lane, __float_as_uint(mx));
    } else {
        const float qs = 127.f / fmaxf(__uint_as_float(colmax[(n0 - nbase) + (lane & 31)]), 1e-30f);
#pragma unroll
        for (int i = 0; i < 32; ++i) { const int kk = 2 * i + (lane >> 5); scr[kk * 33 + (lane & 31)] = tv[i] * qs; }
        asm volatile("s_waitcnt lgkmcnt(0)" ::: "memory");
        const int n = lane >> 1, kh = (lane & 1) * 32;
        const LAS float* s = scr + kh * 33 + n;
        u32x4 o0, o1;
        o0.x = q8x4(s[0 * 33], s[1 * 33], s[2 * 33], s[3 * 33]);     o0.y = q8x4(s[4 * 33], s[5 * 33], s[6 * 33], s[7 * 33]);
        o0.z = q8x4(s[8 * 33], s[9 * 33], s[10 * 33], s[11 * 33]);   o0.w = q8x4(s[12 * 33], s[13 * 33], s[14 * 33], s[15 * 33]);
        o1.x = q8x4(s[16 * 33], s[17 * 33], s[18 * 33], s[19 * 33]); o1.y = q8x4(s[20 * 33], s[21 * 33], s[22 * 33], s[23 * 33]);
        o1.z = q8x4(s[24 * 33], s[25 * 33], s[26 * 33], s[27 * 33]); o1.w = q8x4(s[28 * 33], s[29 * 33], s[30 * 33], s[31 * 33]);
        unsigned char* dst = W8 + (size_t)(n0 - nbase + n) * K + k0 + kh;
        *(u32x4*)dst = o0; *(u32x4*)(dst + 16) = o1;
        asm volatile("s_waitcnt lgkmcnt(0)" ::: "memory");
    }
}

template <bool HAS_Y, bool WRITE_H>
__device__ __forceinline__ void row_pass(const float* __restrict__ xin, const bf16_t* __restrict__ Y, const float* __restrict__ post_g, float* xout,
                                         const float* __restrict__ pre_g, bf16_t* __restrict__ H, unsigned char* __restrict__ H8, float* __restrict__ HS, int gw, int NGW, int lane) {
    for (int row = gw; row < MT; row += NGW) {
        float xv[4][8];
#pragma unroll
        for (int j = 0; j < 4; ++j) { const int col = (j * 64 + lane) * 8; const f32x4 a = *(const f32x4*)(xin + (size_t)row * DM + col), b = *(const f32x4*)(xin + (size_t)row * DM + col + 4);
#pragma unroll
            for (int e = 0; e < 4; ++e) { xv[j][e] = a[e]; xv[j][4 + e] = b[e]; } }
        if constexpr (HAS_Y) {
            float yv[4][8]; float ss = 0.f;
#pragma unroll
            for (int j = 0; j < 4; ++j) { const int col = (j * 64 + lane) * 8; const u32x4 w = *(const u32x4*)(Y + (size_t)row * DM + col);
                yv[j][0] = bflo(w.x); yv[j][1] = bfhi(w.x); yv[j][2] = bflo(w.y); yv[j][3] = bfhi(w.y); yv[j][4] = bflo(w.z); yv[j][5] = bfhi(w.z); yv[j][6] = bflo(w.w); yv[j][7] = bfhi(w.w);
#pragma unroll
                for (int e = 0; e < 8; ++e) ss += yv[j][e] * yv[j][e]; }
            const float r = 1.0f / sqrtf(wave_sum(ss) * (1.0f / DM) + EPSN);
#pragma unroll
            for (int j = 0; j < 4; ++j) { const int col = (j * 64 + lane) * 8; const f32x4 ga = *(const f32x4*)(post_g + col), gb = *(const f32x4*)(post_g + col + 4);
#pragma unroll
                for (int e = 0; e < 4; ++e) { xv[j][e] += yv[j][e] * r * ga[e]; xv[j][4 + e] += yv[j][4 + e] * r * gb[e]; }
                *(f32x4*)(xout + (size_t)row * DM + col) = (f32x4){xv[j][0], xv[j][1], xv[j][2], xv[j][3]};
                *(f32x4*)(xout + (size_t)row * DM + col + 4) = (f32x4){xv[j][4], xv[j][5], xv[j][6], xv[j][7]}; }
        }
        if constexpr (WRITE_H) {
            float ss = 0.f;
#pragma unroll
            for (int j = 0; j < 4; ++j)
#pragma unroll
                for (int e = 0; e < 8; ++e) ss += xv[j][e] * xv[j][e];
            const float r = 1.0f / sqrtf(wave_sum(ss) * (1.0f / DM) + EPSN);
            float amax = 0.f;
#pragma unroll
            for (int j = 0; j < 4; ++j) { const int col = (j * 64 + lane) * 8; const f32x4 ga = *(const f32x4*)(pre_g + col), gb = *(const f32x4*)(pre_g + col + 4);
#pragma unroll
                for (int e = 0; e < 4; ++e) { xv[j][e] *= r * ga[e]; xv[j][4 + e] *= r * gb[e]; amax = fmaxf(amax, fmaxf(fabsf(xv[j][e]), fabsf(xv[j][4 + e]))); }
                u32x4 w; w.x = pk2(xv[j][0], xv[j][1]); w.y = pk2(xv[j][2], xv[j][3]); w.z = pk2(xv[j][4], xv[j][5]); w.w = pk2(xv[j][6], xv[j][7]);
                *(u32x4*)(H + (size_t)row * DM + col) = w; }
#pragma unroll
            for (int o = 1; o < 64; o <<= 1) amax = fmaxf(amax, __shfl_xor(amax, o));
            amax = fmaxf(amax, 1e-20f);
            const float qs = 127.f / amax;
            if (lane == 0) HS[row] = amax * (1.f / 127.f);
#pragma unroll
            for (int j = 0; j < 4; ++j) { const int col = (j * 64 + lane) * 8;
                u32x2 w8; w8.x = q8x4(xv[j][0] * qs, xv[j][1] * qs, xv[j][2] * qs, xv[j][3] * qs); w8.y = q8x4(xv[j][4] * qs, xv[j][5] * qs, xv[j][6] * qs, xv[j][7] * qs);
                *(u32x2*)(H8 + (size_t)row * DM + col) = w8; }
        }
    }
}

constexpr int ATP = 144;
constexpr int ATT_WAVE_LDS = 2 * 64 * ATP;
#define ATT_BAR() asm volatile("s_waitcnt lgkmcnt(0)\n\ts_barrier" ::: "memory")
__device__ __forceinline__ void attn_item(const bf16_t* __restrict__ Q, const bf16_t* __restrict__ Kb, const bf16_t* __restrict__ VT, const bf16_t* __restrict__ GA,
                                          bf16_t* __restrict__ OA, const LAS float* btab, LAS unsigned char* pl  , int b, int c, int h, int half, int lane) {
    const int r = lane & 31, hh = lane >> 5;
    const int rl = lane >> 3, cl = lane & 7;
    const int tokq = b * SEQ + c * 64 + half * 32;
    const int qloc = half * 32 + r;
    const int pr = (r & ~12) | ((r & 4) << 1) | ((r & 8) >> 1);
    const int jmin = c >= 8 ? 0 : 8 - c;
    const int tk0 = b * SEQ + (c - 8 + jmin) * 64;
    const bf16_t* tg = half ? VT + (size_t)(h * 64 + rl) * PT + tk0 + cl * 8 : Kb + (size_t)(tk0 + rl) * DH + h * 64 + cl * 8;
    const size_t rstep = half ? (size_t)8 * PT : (size_t)8 * DH;
    const size_t tstep = half ? (size_t)64 : (size_t)64 * DH;
    const int stoff = (half ? 64 * ATP : 0) + rl * ATP + cl * 16;
    u32x4 tr[8];
#pragma unroll
    for (int i = 0; i < 8; ++i) tr[i] = *(const u32x4*)(tg + i * rstep);
    bf16x8 qf[4];
    { const bf16_t* qp = Q + (size_t)(tokq + r) * DH + h * 64 + 8 * hh;
#pragma unroll
      for (int d0 = 0; d0 < 4; ++d0) qf[d0] = *(const bf16x8*)(qp + d0 * 16); }
    int buf = 0;
#pragma unroll
    for (int i = 0; i < 8; ++i) *(LAS u32x4*)(pl + stoff + 8 * i * ATP) = tr[i];
    tg += (jmin + 1 <= 8) ? tstep : (size_t)0;
#pragma unroll
    for (int i = 0; i < 8; ++i) tr[i] = *(const u32x4*)(tg + i * rstep);
    ATT_BAR();
    f32x16 o0, o1, cinit;
#pragma unroll
    for (int i = 0; i < 16; ++i) { o0[i] = 0.f; o1[i] = 0.f; }
    constexpr float ATT_THR = 8.f;
    float mref = 0.f, lrun = 0.f;
    const float cfar = btab[NREL - 1];
#pragma unroll
    for (int i = 0; i < 16; ++i) cinit[i] = cfar;
    for (int j = jmin; j <= 8; ++j) {
        const LAS unsigned char* kfp = pl + buf * ATT_WAVE_LDS + pr * ATP + 16 * hh;
        const LAS unsigned char* vfp = pl + buf * ATT_WAVE_LDS + 64 * ATP + r * ATP + 16 * hh;
        f32x16 s0, s1;
        if (j <= 3) {
            const bf16x8 k0 = *(const LAS bf16x8*)(kfp), k1 = *(const LAS bf16x8*)(kfp + 32 * ATP);
            s0 = MFMA32(k0, qf[0], cinit); s1 = MFMA32(k1, qf[0], cinit);
        } else {
            const LAS float* bp = btab + (qloc + 64 * (8 - j) + 63 - 8 * hh);
#pragma unroll
            for (int i = 0; i < 16; ++i) {
                const int key = (i & 3) + 4 * ((i >> 2) & 1) + 16 * (i >> 3);
                s0[i] = bp[-key] - mref; s1[i] = bp[-key - 32] - mref;
            }
            const bf16x8 k0 = *(const LAS bf16x8*)(kfp), k1 = *(const LAS bf16x8*)(kfp + 32 * ATP);
            s0 = MFMA32(k0, qf[0], s0); s1 = MFMA32(k1, qf[0], s1);
        }
#pragma unroll
        for (int d0 = 1; d0 < 4; ++d0) {
            const bf16x8 k0 = *(const LAS bf16x8*)(kfp + d0 * 32), k1 = *(const LAS bf16x8*)(kfp + 32 * ATP + d0 * 32);
            s0 = MFMA32(k0, qf[d0], s0); s1 = MFMA32(k1, qf[d0], s1);
        }
        float tmax = fmaxf(s0[0], s1[0]);
#pragma unroll
        for (int i = 1; i < 16; ++i) tmax = fmaxf(tmax, fmaxf(s0[i], s1[i]));
        tmax = fmaxf(tmax, __shfl_xor(tmax, 32));
        if (j == jmin || __any(tmax > ATT_THR)) {
            const float dl = (j == jmin) ? tmax : fmaxf(tmax, 0.f);
            mref += dl;
            const float alpha = (j == jmin) ? 1.f : __builtin_amdgcn_exp2f(-dl);
            lrun *= alpha;
#pragma unroll
            for (int i = 0; i < 16; ++i) { s0[i] -= dl; s1[i] -= dl; o0[i] *= alpha; o1[i] *= alpha; cinit[i] = cfar - mref; }
        }
        float ls = 0.f;
#pragma unroll
        for (int i = 0; i < 16; ++i) { s0[i] = __builtin_amdgcn_exp2f(s0[i]); s1[i] = __builtin_amdgcn_exp2f(s1[i]); ls += s0[i] + s1[i]; }
        lrun += ls;
#pragma unroll
        for (int s = 0; s < 2; ++s) {
            u32x4 pa, pb;
            pa.x = pk2(s0[8 * s + 0], s0[8 * s + 1]); pa.y = pk2(s0[8 * s + 2], s0[8 * s + 3]); pa.z = pk2(s0[8 * s + 4], s0[8 * s + 5]); pa.w = pk2(s0[8 * s + 6], s0[8 * s + 7]);
            pb.x = pk2(s1[8 * s + 0], s1[8 * s + 1]); pb.y = pk2(s1[8 * s + 2], s1[8 * s + 3]); pb.z = pk2(s1[8 * s + 4], s1[8 * s + 5]); pb.w = pk2(s1[8 * s + 6], s1[8 * s + 7]);
            const bf16x8 va0 = *(const LAS bf16x8*)(vfp + 32 * s), va1 = *(const LAS bf16x8*)(vfp + 32 * ATP + 32 * s);
            const bf16x8 vb0 = *(const LAS bf16x8*)(vfp + 64 + 32 * s), vb1 = *(const LAS bf16x8*)(vfp + 32 * ATP + 64 + 32 * s);
            o0 = MFMA32(va0, __builtin_bit_cast(bf16x8, pa), o0); o1 = MFMA32(va1, __builtin_bit_cast(bf16x8, pa), o1);
            o0 = MFMA32(vb0, __builtin_bit_cast(bf16x8, pb), o0); o1 = MFMA32(vb1, __builtin_bit_cast(bf16x8, pb), o1);
        }
        buf ^= 1;
#pragma unroll
        for (int i = 0; i < 8; ++i) *(LAS u32x4*)(pl + buf * ATT_WAVE_LDS + stoff + 8 * i * ATP) = tr[i];
        tg += (j + 2 <= 8) ? tstep : (size_t)0;
#pragma unroll
        for (int i = 0; i < 8; ++i) tr[i] = *(const u32x4*)(tg + i * rstep);
        ATT_BAR();
    }
    const float l = lrun + __shfl_xor(lrun, 32);
    const float inv = 1.0f / l;
    LAS unsigned char* Ot = pl + half * ATT_WAVE_LDS;
#pragma unroll
    for (int g = 0; g < 4; ++g) {
#pragma unroll
        for (int db = 0; db < 2; ++db) {
            const f32x16& o = db ? o1 : o0;
            u32x2 w; w.x = pk2(o[4 * g + 0] * inv, o[4 * g + 1] * inv); w.y = pk2(o[4 * g + 2] * inv, o[4 * g + 3] * inv);
            *(LAS u32x2*)(Ot + r * ATP + (db * 32 + 8 * g + 4 * hh) * 2) = w;
        }
    }
#pragma unroll
    for (int i = 0; i < 4; ++i) {
        const int row = rl + 8 * i;
        const size_t a = (size_t)(tokq + row) * DH + h * 64 + cl * 8;
        const u32x4 gg = *(const u32x4*)(GA + a);
        const u32x4 ov = *(const LAS u32x4*)(Ot + row * ATP + cl * 16);
        u32x4 w; w.x = pk2(bflo(ov.x) * bflo(gg.x), bfhi(ov.x) * bfhi(gg.x)); w.y = pk2(bflo(ov.y) * bflo(gg.y), bfhi(ov.y) * bfhi(gg.y));
        w.z = pk2(bflo(ov.z) * bflo(gg.z), bfhi(ov.z) * bfhi(gg.z)); w.w = pk2(bflo(ov.w) * bflo(gg.w), bfhi(ov.w) * bfhi(gg.w));
        *(u32x4*)(OA + a) = w;
    }
    ATT_BAR();
}
#undef ATT_BAR

__device__ __forceinline__ void unpack8(const u32x4 w, float* v) { v[0] = bflo(w.x); v[1] = bfhi(w.x); v[2] = bflo(w.y); v[3] = bfhi(w.y); v[4] = bflo(w.z); v[5] = bfhi(w.z); v[6] = bflo(w.w); v[7] = bfhi(w.w); }
__device__ __forceinline__ void conv_unit(const bf16_t* __restrict__ BB, const bf16_t* __restrict__ CC, const bf16_t* __restrict__ HB, const bf16_t* __restrict__ GB,
                                          bf16_t* __restrict__ OB, const float* __restrict__ cw, int unit, int tid) {
    const int cgp = tid & 127, sub = tid >> 7, ch = cgp * 8;
    const int t0 = unit * 32 + sub * 8;
    float w0[8], w1[8], w2[8];
#pragma unroll
    for (int e = 0; e < 8; ++e) { w0[e] = cw[ch + e]; w1[e] = cw[DH + ch + e]; w2[e] = cw[2 * DH + ch + e]; }
    float p2[8], p1[8];
#pragma unroll
    for (int e = 0; e < 8; ++e) { p2[e] = 0.f; p1[e] = 0.f; }
    const int tpos = t0 & (SEQ - 1);
    if (tpos >= 2) { float a[8], b[8]; unpack8(*(const u32x4*)(CC + (size_t)(t0 - 2) * DH + ch), a); unpack8(*(const u32x4*)(HB + (size_t)(t0 - 2) * DH + ch), b);
#pragma unroll
        for (int e = 0; e < 8; ++e) p2[e] = a[e] * b[e]; }
    if (tpos >= 1) { float a[8], b[8]; unpack8(*(const u32x4*)(CC + (size_t)(t0 - 1) * DH + ch), a); unpack8(*(const u32x4*)(HB + (size_t)(t0 - 1) * DH + ch), b);
#pragma unroll
        for (int e = 0; e < 8; ++e) p1[e] = a[e] * b[e]; }
#pragma unroll
    for (int i = 0; i < 8; ++i) {
        const size_t off = (size_t)(t0 + i) * DH + ch;
        float a[8], b[8], g1[8], g2[8], o[8];
        unpack8(*(const u32x4*)(CC + off), a); unpack8(*(const u32x4*)(HB + off), b); unpack8(*(const u32x4*)(BB + off), g1); unpack8(*(const u32x4*)(GB + off), g2);
#pragma unroll
        for (int e = 0; e < 8; ++e) { const float cur = a[e] * b[e]; o[e] = g1[e] * (w0[e] * p2[e] + w1[e] * p1[e] + w2[e] * cur) * g2[e]; p2[e] = p1[e]; p1[e] = cur; }
        u32x4 w; w.x = pk2(o[0], o[1]); w.y = pk2(o[2], o[3]); w.z = pk2(o[4], o[5]); w.w = pk2(o[6], o[7]);
        *(u32x4*)(OB + off) = w;
    }
}

template <int tbA, int tbB>
__device__ __forceinline__ void sgu_groups(const bf16_t* __restrict__ VCT, const bf16_t* __restrict__ U, const bf16_t* __restrict__ GC, bf16_t* __restrict__ OC,
                                           const bf16_t* __restrict__ Wbf, const float* __restrict__ spb, const float* __restrict__ lng, const float* __restrict__ lnb,
                                           int tok0, int gh, int cb, int r, int hh, const LAS float* stat) {
    for (int gi = 0; gi < 4; ++gi) {
        const int g = gh * 4 + gi;
        const int ch = g * 128 + cb * 32 + r;
        const float gg = lng[ch], bb = lnb[ch];
        const bf16_t* ap = VCT + (size_t)ch * PT + tok0 + 8 * hh;
        const bf16_t* wp = Wbf + (size_t)g * 16384 + 8 * hh;
        constexpr int NSB = (tbB + 1) * 2, NSA = (tbA + 1) * 2;
        int so = 0; asm volatile("" : "+v"(so));
        u32x4 raw[NSB]; bf16x8 wB[NSB], wA[NSA];
#pragma unroll
        for (int k = 0; k < NSB; ++k) { raw[k] = *(const u32x4*)(ap + 16 * k); wB[k] = *(const bf16x8*)(wp + (size_t)(tbB * 32 + r) * 128 + 16 * k); }
#pragma unroll
        for (int k = 0; k < NSA; ++k) wA[k] = *(const bf16x8*)(wp + (size_t)(tbA * 32 + r) * 128 + 16 * k);
        f32x16 accA, accB;
#pragma unroll
        for (int i = 0; i < 16; ++i) { accA[i] = 0.f; accB[i] = 0.f; }
#pragma unroll
        for (int k = 0; k < NSB; ++k) {
            float v[8]; unpack8(raw[k], v);
#pragma unroll
            for (int jj = 0; jj < 8; ++jj) { const float mean = stat[(16 * k + 8 * hh + jj) * 2 + so], rstd = stat[(16 * k + 8 * hh + jj) * 2 + 1 + so]; v[jj] = (v[jj] - mean) * rstd * gg + bb; }
            u32x4 af; af.x = pk2(v[0], v[1]); af.y = pk2(v[2], v[3]); af.z = pk2(v[4], v[5]); af.w = pk2(v[6], v[7]);
            accB = MFMA32(__builtin_bit_cast(bf16x8, af), wB[k], accB);
            if (k < NSA) accA = MFMA32(__builtin_bit_cast(bf16x8, af), wA[k < NSA ? k : 0], accA);
        }
        u32x2 uu[2][4], gc[2][4]; float sb[2];
#pragma unroll
        for (int which = 0; which < 2; ++which) { const int t = (which ? tbB : tbA) * 32 + r; sb[which] = spb[g * 128 + t];
            const size_t rowoff = (size_t)(tok0 + t) * DH + g * 128 + cb * 32 + 4 * hh;
#pragma unroll
            for (int q = 0; q < 4; ++q) { uu[which][q] = *(const u32x2*)(U + rowoff + 8 * q); gc[which][q] = *(const u32x2*)(GC + rowoff + 8 * q); } }
#pragma unroll
        for (int which = 0; which < 2; ++which) {
            const int tb = which ? tbB : tbA; const f32x16& acc = which ? accB : accA;
            const int t = tb * 32 + r; const float sbv = sb[which];
            const size_t rowoff = (size_t)(tok0 + t) * DH + g * 128 + cb * 32 + 4 * hh;
#pragma unroll
            for (int q = 0; q < 4; ++q) {
                const u32x2 u2 = uu[which][q], g2 = gc[which][q];
                u32x2 o; o.x = pk2(bflo(u2.x) * (acc[4 * q + 0] + sbv) * bflo(g2.x), bfhi(u2.x) * (acc[4 * q + 1] + sbv) * bfhi(g2.x));
                o.y = pk2(bflo(u2.y) * (acc[4 * q + 2] + sbv) * bflo(g2.y), bfhi(u2.y) * (acc[4 * q + 3] + sbv) * bfhi(g2.y));
                *(u32x2*)(OC + rowoff + 8 * q) = o;
            }
        }
    }
}

__device__ __forceinline__ void sgu_unit(const bf16_t* __restrict__ VCT, const bf16_t* __restrict__ U, const bf16_t* __restrict__ GC, bf16_t* __restrict__ OC,
                                         const bf16_t* __restrict__ Wbf, const float* __restrict__ spb, const float* __restrict__ lng, const float* __restrict__ lnb,
                                         int b, int n, int gh, LAS unsigned char* lds, int tid) {
    const int lane = tid & 63, w = __builtin_amdgcn_readfirstlane(tid >> 6), r = lane & 31, hh = lane >> 5;
    const int tok0 = b * SEQ + n * 128;
    __syncthreads();
    LAS float* part = (LAS float*)lds;
    LAS float* stat = part + 8 * 128 * 2;
    {
        const int tl = lane & 15, cq = lane >> 4;
        const bf16_t* p = VCT + (size_t)(w * 128 + cq) * PT + tok0 + 8 * tl;
        float sm[8], sq[8];
#pragma unroll
        for (int e = 0; e < 8; ++e) { sm[e] = 0.f; sq[e] = 0.f; }
#pragma unroll 8
        for (int c4 = 0; c4 < 32; ++c4) { float v[8]; unpack8(*(const u32x4*)(p + (size_t)(c4 * 4) * PT), v);
#pragma unroll
            for (int e = 0; e < 8; ++e) { sm[e] += v[e]; sq[e] += v[e] * v[e]; } }
#pragma unroll
        for (int e = 0; e < 8; ++e) { sm[e] += __shfl_xor(sm[e], 16); sm[e] += __shfl_xor(sm[e], 32); sq[e] += __shfl_xor(sq[e], 16); sq[e] += __shfl_xor(sq[e], 32); }
        if (cq == 0) {
#pragma unroll
            for (int e = 0; e < 8; ++e) { part[(w * 128 + 8 * tl + e) * 2 + 0] = sm[e]; part[(w * 128 + 8 * tl + e) * 2 + 1] = sq[e]; }
        }
    }
    __syncthreads();
    if (tid < 128) {
        float S = 0.f, SS = 0.f;
#pragma unroll
        for (int ww = 0; ww < 8; ++ww) { S += part[(ww * 128 + tid) * 2]; SS += part[(ww * 128 + tid) * 2 + 1]; }
        const float mean = S * (1.0f / DH); const float var = fmaxf(SS * (1.0f / DH) - mean * mean, 0.f);
        stat[tid * 2] = mean; stat[tid * 2 + 1] = 1.0f / sqrtf(var + EPSN);
    }
    __syncthreads();
    if ((w >> 2) == 0) sgu_groups<0, 3>(VCT, U, GC, OC, Wbf, spb, lng, lnb, tok0, gh, w & 3, r, hh, stat);
    else sgu_groups<1, 2>(VCT, U, GC, OC, Wbf, spb, lng, lnb, tok0, gh, w & 3, r, hh, stat);
    __syncthreads();
}

#ifndef X_ATT
#define X_ATT 0
#endif
#ifndef X_CONV
#define X_CONV 0
#endif
#ifndef X_SGU
#define X_SGU 0
#endif
struct Args { const float* in[14]; float* out; unsigned char* ws; int ph_lo, ph_hi; };
constexpr int NPH = 11;

__device__ __forceinline__ void phase_prologue(const Args& args, LAS unsigned char* lds) {
    const int tid = threadIdx.x, lane = tid & 63, wave = __builtin_amdgcn_readfirstlane(tid >> 6);
    const int G = gridDim.x, blk = blockIdx.x, gw = blk * 8 + wave, NGW = G * 8;
    unsigned char* ws = args.ws;
    LAS float* scr = (LAS float*)(lds + wave * 16384);
    constexpr int I_IN = (DM / 64) * (NIN / 32), I_BR = (DH / 64) * (DM / 32), I_OUT = (DM / 64) * (DM / 32);
    constexpr int PER_L = I_IN + 3 * I_BR + I_OUT;
    for (int it = gw; it < 2 * PER_L; it += NGW) {
        const int l = it / PER_L; int r = it - l * PER_L;
        if (r < I_IN) { const int kb = r / (NIN / 32), nb = r - kb * (NIN / 32);
            if (nb * 32 < NBF) transpose_item(args.in[2] + (size_t)l * DM * NIN, DM, NIN, (bf16_t*)(ws + WS_WIN + (size_t)l * 68 * MiB), scr, r, lane);
            else gate_weight_item<false>(args.in[2] + (size_t)l * DM * NIN, DM, NIN, nullptr, (unsigned*)(ws + WS_COLMAX) + l * NI8, NBF, scr, kb * (NI8 / 32) + (nb - NBF / 32), lane);
            continue; } r -= I_IN;
        if (r < 3 * I_BR) { const int br = r / I_BR; r -= br * I_BR; const float* src = (br == 0 ? args.in[9] : (br == 1 ? args.in[10] : args.in[11])) + (size_t)l * DH * DM;
            transpose_item(src, DH, DM, (bf16_t*)(ws + WS_WBR + (size_t)(l * 3 + br) * 4 * MiB), scr, r, lane); continue; } r -= 3 * I_BR;
        transpose_item(args.in[12] + (size_t)l * DM * DM, DM, DM, (bf16_t*)(ws + WS_WOUT + (size_t)l * 8 * MiB), scr, r, lane);
    }
    { bf16_t* wb = (bf16_t*)(ws + WS_SGUW); const float* sp_w = args.in[7];
      for (int e = blk * 512 + tid; e < 2 * 8 * 128 * 128; e += G * 512) { const int t = (e >> 7) & 127, s = e & 127; const unsigned p = pk2(sp_w[e], 0.f); wb[e] = (s <= t) ? (bf16_t)(p & 0xffffu) : (bf16_t)0; } }
    row_pass<false, true>(args.in[0], nullptr, nullptr, nullptr, args.in[1], (bf16_t*)(ws + WS_H), ws + WS_H8, (float*)(ws + WS_HS), gw, NGW, lane);
}

__device__ __forceinline__ void phase_quant(const Args& args, LAS unsigned char* lds) {
    const int tid = threadIdx.x, lane = tid & 63, wave = __builtin_amdgcn_readfirstlane(tid >> 6);
    const int gw = blockIdx.x * 8 + wave, NGW = gridDim.x * 8;
    unsigned char* ws = args.ws;
    LAS float* scr = (LAS float*)(lds + wave * 16384);
    constexpr int PER_L = (DM / 64) * (NI8 / 32);
    for (int it = gw; it < 2 * PER_L; it += NGW) {
        const int l = it / PER_L, r = it - l * PER_L;
        gate_weight_item<true>(args.in[2] + (size_t)l * DM * NIN, DM, NIN, ws + WS_W8 + (size_t)l * 18 * MiB, (unsigned*)(ws + WS_COLMAX) + l * NI8, NBF, scr, r, lane);
    }
}

template <int L> __device__ __forceinline__ void phase_in(const Args& args, LAS unsigned char* lds) {
    unsigned char* ws = args.ws;
    {
        pg8::Gemm g{(const bf16_t*)(ws + WS_H), (const bf16_t*)(ws + WS_WIN + (size_t)L * 68 * MiB), MT, NBF, DM, 0, 0};
        pg8::TileOrder<1> S; S.init(MT, NBF, gridDim.x, blockIdx.x);
        pg8::EpiIn E{ws + WS_SEG, (bf16_t*)(ws + WS_GATES), (bf16_t*)(ws + WS_VT), (bf16_t*)(ws + WS_VCT)};
        pg8::gemm_phase<pg8::EpiIn, pg8::TileOrder<1>, true>(lds, g, S, E);
    }
    {
        pg8::Gemm g{(const bf16_t*)(ws + WS_H8), (const bf16_t*)(ws + WS_W8 + (size_t)L * 18 * MiB), MT, NI8, DM / 2, 0, 0};
        pg8::TileOrder<1> S; S.init(MT, NI8, gridDim.x, blockIdx.x);
        pg8::EpiIn8 E{ws + WS_SEG, (bf16_t*)(ws + WS_GATES), (bf16_t*)(ws + WS_VCT), (const float*)(ws + WS_HS), (const float*)(ws + WS_COLMAX) + L * NI8};
        pg8::gemm_phase<pg8::EpiIn8, pg8::TileOrder<1>, true, true>(lds, g, S, E);
    }
}

template <int L> __device__ __forceinline__ void phase_mix(const Args& args, LAS unsigned char* lds) {
    const int tid = threadIdx.x, lane = tid & 63, wave = __builtin_amdgcn_readfirstlane(tid >> 6);
    const int G = gridDim.x, blk = blockIdx.x;
    unsigned char* ws = args.ws;
    const bf16_t* segb = (const bf16_t*)(ws + WS_SEG);
    bf16_t* OA = (bf16_t*)(ws + WS_O);
    constexpr size_t SE = (size_t)MT * DH;
    LAS float* btab = (LAS float*)(lds + 8 * ATT_WAVE_LDS + wave * 1536);
    LAS unsigned char* wl = lds + (wave >> 1) * (2 * ATT_WAVE_LDS);
    int cur_h = -1;
    constexpr int XA = (L == 0 ? X_ATT : 0) * 1024, XC = (L == 0 ? X_CONV : 0) * 512, XS = (L == 0 ? X_SGU : 0) * 256;
    for (int uu = blk; uu < 1792 + XA + XC + XS; uu += G) {
        int u = uu;
        if (uu >= 1792) { const int x = uu - 1792; u = x < XA ? (x & 1023) : (x < XA + XC ? 1024 + ((x - XA) & 511) : 1536 + ((x - XA - XC) & 255)); }
        if (u < 1024) {
            const int hg = u & 3, b = (u >> 2) & 7, c = u >> 5;
            const int h = hg * 4 + (wave >> 1), half = wave & 1;
            if (h != cur_h) { const float* rb = args.in[3] + (size_t)(L * 16 + h) * NREL;
#pragma unroll
                for (int i = 0; i < 6; ++i) { const int idx = i * 64 + lane; btab[idx] = rb[idx < NREL ? idx : NREL - 1] * LOG2E; }
                cur_h = h; }
            attn_item(segb, segb + SE, (const bf16_t*)(ws + WS_VT), segb + 3 * SE, OA, btab, wl, b, c, h, half, lane);
        } else if (u < 1536) {
            conv_unit(segb + 4 * SE, segb + 5 * SE, segb + 6 * SE, segb + 7 * SE, OA + SE, args.in[4] + (size_t)L * 3 * DH, u - 1024, tid);
        } else {
            const int su = u - 1536; const int gh = su & 1, n = (su >> 1) & 15, b = su >> 5;
            sgu_unit((const bf16_t*)(ws + WS_VCT), segb + 8 * SE, segb + 10 * SE, OA + 2 * SE, (const bf16_t*)(ws + WS_SGUW) + (size_t)L * 8 * 16384, args.in[8] + (size_t)L * 8 * 128,
                     args.in[5] + (size_t)L * DH, args.in[6] + (size_t)L * DH, b, n, gh, lds, tid);
        }
    }
}

template <int L> __device__ __forceinline__ void phase_br(const Args& args, LAS unsigned char* lds) {
    unsigned char* ws = args.ws;
    pg8::Gemm g{(const bf16_t*)(ws + WS_O), (const bf16_t*)(ws + WS_WBR + (size_t)L * 12 * MiB), MT, DM, DH, (size_t)32 * MiB, (size_t)4 * MiB};
    pg8::TileOrder<3> S; S.init(MT, DM, gridDim.x, blockIdx.x);
    pg8::EpiMerge E{(const bf16_t*)(ws + WS_GATES), (bf16_t*)(ws + WS_MERGED16)};
    pg8::gemm_phase<pg8::EpiMerge, pg8::TileOrder<3>, true>(lds, g, S, E);
}

template <int L> __device__ __forceinline__ void phase_out(const Args& args, LAS unsigned char* lds) {
    unsigned char* ws = args.ws;
    pg8::Gemm g{(const bf16_t*)(ws + WS_MERGED16), (const bf16_t*)(ws + WS_WOUT + (size_t)L * 8 * MiB), MT, DM, DM, 0, 0};
    pg8::TileOrder<1> S; S.init(MT, DM, gridDim.x, blockIdx.x);
    pg8::EpiPlain E{(bf16_t*)(ws + WS_Y), DM};
    pg8::gemm_phase<pg8::EpiPlain, pg8::TileOrder<1>, true>(lds, g, S, E);
}

template <int L> __device__ __forceinline__ void phase_row(const Args& args) {
    const int tid = threadIdx.x, lane = tid & 63, wave = __builtin_amdgcn_readfirstlane(tid >> 6);
    const int gw = blockIdx.x * 8 + wave, NGW = gridDim.x * 8;
    unsigned char* ws = args.ws;
    if (L == 0) row_pass<true, true>(args.in[0], (const bf16_t*)(ws + WS_Y), args.in[13], args.out, args.in[1] + DM, (bf16_t*)(ws + WS_H), ws + WS_H8, (float*)(ws + WS_HS), gw, NGW, lane);
    else row_pass<true, false>(args.out, (const bf16_t*)(ws + WS_Y), args.in[13] + DM, args.out, nullptr, nullptr, nullptr, nullptr, gw, NGW, lane);
}

__global__ void __launch_bounds__(512, 2) mk_fwd(const Args args) {
    extern __shared__ __attribute__((aligned(16))) unsigned char lds_raw[];
    LAS unsigned char* lds = (LAS unsigned char*)lds_raw;
    const int lo = args.ph_lo, hi = args.ph_hi;
    volatile LAS unsigned* bst = (volatile LAS unsigned*)(lds + LDS_BYTES - 64);
    if (threadIdx.x < 2) bst[threadIdx.x] = 0u;
    __syncthreads();
    XcdBarrier xbar; xbar.bar = (unsigned*)args.ws; xbar.x = 0; xbar.st = nullptr;
    if (hi - lo > 1) xbar = xcd_barrier_post((unsigned*)args.ws, bst);
#define IN(k) (lo <= (k) && (k) < hi)
#define SEAM(k) do { if (IN((k) + 1)) xcd_barrier(xbar); } while (0)
    if (hi > NPH) cg::this_grid().sync();
#ifndef REP_PRO
#define REP_PRO 1
#endif
#ifndef REP_IN
#define REP_IN 1
#endif
#ifndef REP_MIX
#define REP_MIX 1
#endif
#ifndef REP_BR
#define REP_BR 1
#endif
#ifndef REP_OUT
#define REP_OUT 1
#endif
#ifndef REP_ROW
#define REP_ROW 1
#endif
#ifndef REP_SYNC
#define REP_SYNC 0
#endif
    if (IN(0)) { phase_prologue(args, lds); xcd_barrier(xbar); phase_quant(args, lds); SEAM(0); }
    if (IN(1)) { for (int rep = 0; rep < REP_IN; ++rep) phase_in<0>(args, lds); SEAM(1); }
    if (IN(2)) { for (int rep = 0; rep < REP_MIX; ++rep) phase_mix<0>(args, lds); SEAM(2); }
    if (IN(3)) { for (int rep = 0; rep < REP_BR; ++rep) phase_br<0>(args, lds); SEAM(3); }
    if (IN(4)) { for (int rep = 0; rep < REP_OUT; ++rep) phase_out<0>(args, lds); SEAM(4); }
    if (IN(5)) { for (int rep = 0; rep < REP_ROW; ++rep) phase_row<0>(args); SEAM(5); }
    if (IN(6)) { phase_in<1>(args, lds); SEAM(6); }
    if (IN(7)) { phase_mix<1>(args, lds); SEAM(7); }
    if (IN(8)) { phase_br<1>(args, lds); SEAM(8); }
    if (IN(9)) { phase_out<1>(args, lds); SEAM(9); }
    if (IN(10)) { phase_row<1>(args); }
#undef IN
#undef SEAM
}

extern "C" void kernel_launch(void* const* d_in, const int* in_sizes, int n_in, void* d_out, int out_size, void* d_ws, size_t ws_size, hipStream_t stream) {
    static int grid = 0;
    if (grid == 0) {
        if (n_in != 14 || out_size != MT * DM || ws_size < WS_END) { fprintf(stderr, "kernel_launch: unexpected shapes (n_in %d out %d ws %zu)\n", n_in, out_size, ws_size); grid = -1; return; }
        int dev = 0, cus = 0, per_cu = 0;
        hipGetDevice(&dev);
        hipDeviceGetAttribute(&cus, hipDeviceAttributeMultiprocessorCount, dev);
        if (hipFuncSetAttribute((const void*)mk_fwd, hipFuncAttributeMaxDynamicSharedMemorySize, LDS_BYTES) != hipSuccess) { fprintf(stderr, "kernel_launch: hipFuncSetAttribute failed\n"); grid = -1; return; }
        if (hipOccupancyMaxActiveBlocksPerMultiprocessor(&per_cu, (const void*)mk_fwd, 512, LDS_BYTES) != hipSuccess || per_cu < 1) { fprintf(stderr, "kernel_launch: occupancy query says %d\n", per_cu); per_cu = 1; }
        (void)hipGetLastError();
        grid = cus * 1;
    }
    if (grid < 0) return;
    (void)hipMemsetAsync(d_ws, 0, 98304, stream);
    Args a{};
    for (int i = 0; i < 14; ++i) a.in[i] = (const float*)d_in[i];
    a.out = (float*)d_out; a.ws = (unsigned char*)d_ws;
#if MK_N_LAUNCHES == 1
    a.ph_lo = 0; a.ph_hi = NPH;
    void* kargs[] = {&a};
    hipError_t e = hipLaunchCooperativeKernel((const void*)mk_fwd, dim3(grid), dim3(512), kargs, LDS_BYTES, stream);
    if (e != hipSuccess) fprintf(stderr, "cooperative launch failed: %s (grid %d)\n", hipGetErrorString(e), grid);
#else
    for (int p = 0; p < NPH; ++p) { a.ph_lo = p; a.ph_hi = p + 1; hipLaunchKernelGGL(mk_fwd, dim3(grid), dim3(512), LDS_BYTES, stream, a); }
#endif
}
```

```cpp
#include <hip/hip_runtime.h>
#include <hip/hip_cooperative_groups.h>
#include <cstdio>
#include <cstdint>
namespace cg = cooperative_groups;

#define LAS __attribute__((address_space(3)))
typedef unsigned short bf16_t;
typedef short bf16x8 __attribute__((ext_vector_type(8)));
typedef float f32x4 __attribute__((ext_vector_type(4)));
typedef float f32x2 __attribute__((ext_vector_type(2)));
typedef float f32x16 __attribute__((ext_vector_type(16)));
typedef unsigned u32x4 __attribute__((ext_vector_type(4)));
typedef unsigned u32x2 __attribute__((ext_vector_type(2)));
typedef __bf16 bf16x2_t __attribute__((ext_vector_type(2)));
typedef int i32x4 __attribute__((ext_vector_type(4)));

#ifndef MK_N_LAUNCHES
#define MK_N_LAUNCHES 1
#endif

constexpr int MT = 16384;
constexpr int SEQ = 2048;
constexpr int DM = 2048;
constexpr int NIN = 17408;
constexpr int DH = 1024;
constexpr int NREL = 320;
constexpr int PT = MT + 64;
constexpr float LOG2E = 1.4426950408889634f;
constexpr float QSCALE = 0.125f * LOG2E;
constexpr float EPSN = 1e-6f;
constexpr int NBF = 8 * 1024; constexpr int NI8 = NIN - NBF;

constexpr size_t MiB = 1u << 20;
constexpr size_t WS_WIN = 2 * MiB;
constexpr size_t WS_WBR = 138 * MiB;
constexpr size_t WS_WOUT = 162 * MiB;
constexpr size_t WS_H = 178 * MiB;
constexpr size_t WS_SEG = 242 * MiB;
constexpr size_t WS_GATES = 594 * MiB;
constexpr size_t WS_O = 786 * MiB;
constexpr size_t WS_SGUW = 882 * MiB;
constexpr size_t WS_VT = 884 * MiB;
constexpr size_t WS_VCT = 918 * MiB;
constexpr size_t WS_H8 = 952 * MiB;
constexpr size_t WS_W8 = 984 * MiB;
constexpr size_t WS_HS = 1020 * MiB;
constexpr size_t WS_END = 1021 * MiB;
constexpr size_t WS_COLMAX = 16384;
constexpr size_t SEGB = 32 * MiB;
constexpr size_t WS_MERGED16 = WS_SEG + 4 * SEGB;
constexpr size_t WS_Y = WS_SEG + 6 * SEGB;

constexpr int LDS_BYTES = 163840;

__device__ __forceinline__ unsigned pk2(float lo, float hi) { f32x2 v = {lo, hi}; bf16x2_t b = __builtin_convertvector(v, bf16x2_t); return __builtin_bit_cast(unsigned, b); }
__device__ __forceinline__ unsigned q8x4(float a, float b, float c, float d) {
    const int ia = (int)__builtin_rintf(a), ib = (int)__builtin_rintf(b), ic = (int)__builtin_rintf(c), id = (int)__builtin_rintf(d);
    return (unsigned)(ia & 0xff) | ((unsigned)(ib & 0xff) << 8) | ((unsigned)(ic & 0xff) << 16) | ((unsigned)id << 24); }
__device__ __forceinline__ float bflo(unsigned u) { return __uint_as_float(u << 16); }
__device__ __forceinline__ float bfhi(unsigned u) { return __uint_as_float(u & 0xffff0000u); }
__device__ __forceinline__ float fast_sigmoid(float w) { return __builtin_amdgcn_rcpf(1.0f + __builtin_amdgcn_exp2f(-w * LOG2E)); }
__device__ __forceinline__ float wave_sum(float v) {
#pragma unroll
    for (int o = 1; o < 64; o <<= 1) v += __shfl_xor(v, o);
    return v;
}
#define MFMA32(a, b, c) __builtin_amdgcn_mfma_f32_32x32x16_bf16((a), (b), (c), 0, 0, 0)

namespace pg8 {
constexpr int BM = 256, BK = 64, HALF = 128, HTB = HALF * BK * 2, STAGE_BYTES = 8 * HTB, NXCD = 8, WGM = 8;
__device__ __forceinline__ int lds_byte(int r, int c) { const int st = (r >> 4) * 2 + (c >> 5), rr = r & 15, cc = c & 31, ob = rr * 64 + cc * 2; return st * 1024 + (ob ^ (((ob >> 9) & 1) << 5)); }
__device__ __forceinline__ void stage_rc(int b, int& R, int& C) { const int st = b / 1024, sb = b % 1024, swz = sb ^ (((sb >> 9) & 1) << 5); R = (st >> 1) * 16 + swz / 64; C = (st & 1) * 32 + (swz % 64) / 2; }
__device__ __forceinline__ int perm32(int rho) { const int n = rho >> 4, i = rho & 15; return 8 * (i >> 2) + 4 * n + (i & 3); }

struct Unit { int pm, pn, z; };
struct Gemm { const bf16_t* A; const bf16_t* Bt; int M, N, K; size_t zA, zB; };

template <int NZ> struct TileOrder {
    int nM, nN, nwg, G, c, wgm;
    __device__ void init(int M, int N, int G_, int c_, int wgm_ = WGM) { nM = M / BM; nN = N / BM; nwg = nM * nN; G = G_; c = c_; wgm = wgm_; }
    __device__ bool next(int i, Unit& u) const {
        const int ti = i / NZ; u.z = i - ti * NZ;
        const long L = (long)ti * G + c; if (L >= nwg) return false;
        int wgid = (int)L; { const int q = nwg / NXCD, r = nwg % NXCD, xcd = wgid % NXCD, off = wgid / NXCD; wgid = (xcd < r ? xcd * (q + 1) : r * (q + 1) + (xcd - r) * q) + off; }
        const int nig = wgm * nN, gid = wgid / nig, fm = gid * wgm, gsz = (nM - fm) < wgm ? (nM - fm) : wgm;
        u.pm = fm + ((wgid % nig) % gsz); u.pn = (wgid % nig) / gsz; return true;
    }
};


template <int MODE> __device__ __forceinline__ f32x2 act2(f32x2 v, float sc) {
    if constexpr (MODE == 0) return v * sc;
    f32x2 t;
    if constexpr (MODE == 2) { const f32x2 x2 = v * v; t = v * (x2 * (-0.10294325f) + (-2.3022082f)); }
    else t = v * (-LOG2E);
    if constexpr (MODE == 3) { t.x = fminf(t.x, 20.f); t.y = fminf(t.y, 20.f); }
    f32x2 d; d.x = __builtin_amdgcn_exp2f(t.x); d.y = __builtin_amdgcn_exp2f(t.y);
    d = d + 1.0f;
    f32x2 r; r.x = __builtin_amdgcn_rcpf(d.x); r.y = __builtin_amdgcn_rcpf(d.y);
    if constexpr (MODE == 3) return r;
    return v * r;
}
template <int MODE, bool TR, bool I8 = false>
__device__ __forceinline__ void epi_in_tile(const f32x4 (&acc)[2][2][4][2], bf16_t* __restrict__ base, int ldc, int row0, int col0, float sc,
                                            const float* __restrict__ hs = nullptr, const float* __restrict__ cmx = nullptr) {
    f32x4 cs[2][2];
    if constexpr (I8) {
#pragma unroll
        for (int bj = 0; bj < 2; ++bj) { cs[bj][0] = *(const f32x4*)(cmx + bj * HALF) * (1.f / 127.f); cs[bj][1] = *(const f32x4*)(cmx + bj * HALF + 4) * (1.f / 127.f); }
    }
#pragma unroll
    for (int ai = 0; ai < 2; ++ai)
#pragma unroll
        for (int m = 0; m < 4; ++m) {
            const int row = row0 + ai * HALF + m * 16;
            float rs = 1.f; if constexpr (I8) rs = hs[row];
#pragma unroll
            for (int bj = 0; bj < 2; ++bj) {
                f32x4 a0 = acc[ai][bj][m][0], a1 = acc[ai][bj][m][1];
                if constexpr (I8) { const i32x4 i0 = __builtin_bit_cast(i32x4, a0), i1 = __builtin_bit_cast(i32x4, a1);
                    a0 = (f32x4){(float)i0[0], (float)i0[1], (float)i0[2], (float)i0[3]} * rs * cs[bj][0];
                    a1 = (f32x4){(float)i1[0], (float)i1[1], (float)i1[2], (float)i1[3]} * rs * cs[bj][1]; }
                const f32x2 p0 = act2<MODE>((f32x2){a0[0], a0[1]}, sc), p1 = act2<MODE>((f32x2){a0[2], a0[3]}, sc);
                const f32x2 p2 = act2<MODE>((f32x2){a1[0], a1[1]}, sc), p3 = act2<MODE>((f32x2){a1[2], a1[3]}, sc);
                u32x4 w; w.x = pk2(p0.x, p0.y); w.y = pk2(p1.x, p1.y); w.z = pk2(p2.x, p2.y); w.w = pk2(p3.x, p3.y);
                if constexpr (!TR) {
                    *(u32x4*)(base + (size_t)row * ldc + col0 + bj * HALF) = w;
                } else {
                    bf16_t* tp = base + (size_t)(col0 + bj * HALF) * PT + row;
                    tp[0 * (size_t)PT] = (bf16_t)(w.x & 0xffffu); tp[1 * (size_t)PT] = (bf16_t)(w.x >> 16);
                    tp[2 * (size_t)PT] = (bf16_t)(w.y & 0xffffu); tp[3 * (size_t)PT] = (bf16_t)(w.y >> 16);
                    tp[4 * (size_t)PT] = (bf16_t)(w.z & 0xffffu); tp[5 * (size_t)PT] = (bf16_t)(w.z >> 16);
                    tp[6 * (size_t)PT] = (bf16_t)(w.w & 0xffffu); tp[7 * (size_t)PT] = (bf16_t)(w.w >> 16);
                }
            }
        }
}
struct EpiIn {
    static constexpr bool PERM = true;
    unsigned char* seg;
    bf16_t* gates;
    bf16_t* vt; bf16_t* vct;
    __device__ __forceinline__ bool reset(const Unit&) const { return true; }
    __device__ __forceinline__ void operator()(const f32x4 (&acc)[2][2][4][2], const Unit& u, int wr, int wc, int fr, int fq) const {
        const int colt = u.pn * BM;
        const int row0 = u.pm * BM + wr * 64 + fr;
        const int lc = wc * 32 + 8 * fq;
        const int s = colt >> 10; const int col0 = (colt & 1023) + lc;
        bf16_t* base = (bf16_t*)(seg + (size_t)s * SEGB);
        if (s == 3 || s == 7) epi_in_tile<1, false>(acc, base, DH, row0, col0, 1.f);
        else if (s == 2) epi_in_tile<0, true>(acc, vt, 0, row0, col0, 1.f);
        else epi_in_tile<0, false>(acc, base, DH, row0, col0, s == 0 ? QSCALE : 1.f);
    }
};

struct EpiIn8 {
    static constexpr bool PERM = true;
    unsigned char* seg; bf16_t* gates; bf16_t* vct; const float* hs; const float* colmax;
    __device__ __forceinline__ bool reset(const Unit&) const { return true; }
    __device__ __forceinline__ void operator()(const f32x4 (&acc)[2][2][4][2], const Unit& u, int wr, int wc, int fr, int fq) const {
        const int colt = NBF + u.pn * BM;
        const int row0 = u.pm * BM + wr * 64 + fr;
        const int lc = wc * 32 + 8 * fq;
        const float* cmx = colmax + u.pn * BM + lc;
        if (colt >= 11 * DH) { epi_in_tile<3, false, true>(acc, gates, 3 * DM, row0, colt - 11 * DH + lc, 1.f, hs, cmx); return; }
        const int s = colt >> 10; const int col0 = (colt & 1023) + lc;
        bf16_t* base = (bf16_t*)(seg + (size_t)s * SEGB);
        if (s == 10) epi_in_tile<1, false, true>(acc, base, DH, row0, col0, 1.f, hs, cmx);
        else if (s == 9) epi_in_tile<2, true, true>(acc, vct, 0, row0, col0, 1.f, hs, cmx);
        else epi_in_tile<2, false, true>(acc, base, DH, row0, col0, 1.f, hs, cmx);
    }
};

struct EpiPlain {
    static constexpr bool PERM = true;
    bf16_t* O; int ldc;
    __device__ __forceinline__ bool reset(const Unit&) const { return true; }
    __device__ __forceinline__ void operator()(const f32x4 (&acc)[2][2][4][2], const Unit& u, int wr, int wc, int fr, int fq) const {
        const int row0 = u.pm * BM + wr * 64 + fr, col0 = u.pn * BM + wc * 32 + 8 * fq;
#pragma unroll
        for (int ai = 0; ai < 2; ++ai)
#pragma unroll
            for (int m = 0; m < 4; ++m) { bf16_t* rowp = O + (size_t)(row0 + ai * HALF + m * 16) * ldc + col0;
#pragma unroll
                for (int bj = 0; bj < 2; ++bj) { const f32x4 v0 = acc[ai][bj][m][0], v1 = acc[ai][bj][m][1];
                    u32x4 w; w.x = pk2(v0[0], v0[1]); w.y = pk2(v0[2], v0[3]); w.z = pk2(v1[0], v1[1]); w.w = pk2(v1[2], v1[3]);
                    *(u32x4*)(rowp + bj * HALF) = w; } }
    }
};

struct EpiMerge {
    static constexpr bool PERM = true;
    const bf16_t* __restrict__ gates; bf16_t* __restrict__ out;
    __device__ __forceinline__ bool reset(const Unit& u) const { return u.z == 2; }
    __device__ __forceinline__ void operator()(f32x4 (&acc)[2][2][4][2], const Unit& u, int wr, int wc, int fr, int fq) const {
        const int row0 = u.pm * BM + wr * 64 + fr, col0 = u.pn * BM + wc * 32 + 8 * fq;
        const int z = u.z;
        const bf16_t* gz = gates + (size_t)row0 * (3 * DM) + z * DM + col0;
        if (z < 2) {
#pragma unroll
            for (int ai = 0; ai < 2; ++ai) {
                u32x4 gn[4][2], gd[4][2];
#pragma unroll
                for (int m = 0; m < 4; ++m)
#pragma unroll
                    for (int bj = 0; bj < 2; ++bj) { const bf16_t* p = gz + (size_t)(ai * HALF + m * 16) * (3 * DM) + bj * HALF; gn[m][bj] = *(const u32x4*)p; gd[m][bj] = *(const u32x4*)(p + DM); }
#pragma unroll
                for (int m = 0; m < 4; ++m)
#pragma unroll
                    for (int bj = 0; bj < 2; ++bj) {
                        const u32x4 a = gn[m][bj], d = gd[m][bj];
                        f32x4& v0 = acc[ai][bj][m][0]; f32x4& v1 = acc[ai][bj][m][1];
                        v0[0] *= bflo(a.x) * __builtin_amdgcn_rcpf(bflo(d.x)); v0[1] *= bfhi(a.x) * __builtin_amdgcn_rcpf(bfhi(d.x));
                        v0[2] *= bflo(a.y) * __builtin_amdgcn_rcpf(bflo(d.y)); v0[3] *= bfhi(a.y) * __builtin_amdgcn_rcpf(bfhi(d.y));
                        v1[0] *= bflo(a.z) * __builtin_amdgcn_rcpf(bflo(d.z)); v1[1] *= bfhi(a.z) * __builtin_amdgcn_rcpf(bfhi(d.z));
                        v1[2] *= bflo(a.w) * __builtin_amdgcn_rcpf(bflo(d.w)); v1[3] *= bfhi(a.w) * __builtin_amdgcn_rcpf(bfhi(d.w));
                    }
            }
        } else {
#pragma unroll
            for (int ai = 0; ai < 2; ++ai) {
                u32x4 gn[4][2];
#pragma unroll
                for (int m = 0; m < 4; ++m)
#pragma unroll
                    for (int bj = 0; bj < 2; ++bj) gn[m][bj] = *(const u32x4*)(gz + (size_t)(ai * HALF + m * 16) * (3 * DM) + bj * HALF);
#pragma unroll
                for (int m = 0; m < 4; ++m)
#pragma unroll
                    for (int bj = 0; bj < 2; ++bj) {
                        const u32x4 a = gn[m][bj];
                        const f32x4 v0 = acc[ai][bj][m][0], v1 = acc[ai][bj][m][1];
                        u32x4 w; w.x = pk2(v0[0] * bflo(a.x), v0[1] * bfhi(a.x)); w.y = pk2(v0[2] * bflo(a.y), v0[3] * bfhi(a.y));
                        w.z = pk2(v1[0] * bflo(a.z), v1[1] * bfhi(a.z)); w.w = pk2(v1[2] * bflo(a.w), v1[3] * bfhi(a.w));
                        *(u32x4*)(out + (size_t)(row0 + ai * HALF + m * 16) * DM + col0 + bj * HALF) = w;
                    }
            }
        }
    }
};

template <class Epi, class Sched, bool ALIGN_EPI, bool I8 = false>
__device__ __forceinline__ void gemm_phase(LAS unsigned char* lds, const Gemm g, const Sched& S, const Epi& E) {
    const int tid = threadIdx.x, wid = __builtin_amdgcn_readfirstlane(tid >> 6), lane = tid & 63, wr = wid >> 2, wc = wid & 3, fr = lane & 15, fq = lane >> 4;
    const int K = g.K, nt = K / BK;
    unsigned voffA[2], voffB[2];
#pragma unroll
    for (int i = 0; i < 2; ++i) { int R, C; stage_rc(tid * 16 + i * 8192, R, C); const int Rb = Epi::PERM ? ((R & ~31) + perm32(R & 31)) : R;
        voffA[i] = (unsigned)(R * K + C) * 2u; voffB[i] = (unsigned)(Rb * K + C) * 2u; }
    const size_t kstep = (size_t)(BK * 2);
    const size_t hstep = (size_t)HALF * K * 2;
    const size_t tstep = 2 * hstep;
    const unsigned ldsw = (unsigned)wid * 1024u;
    const int aoff = lds_byte(wr * 64 + fr, fq * 8), boff = lds_byte(wc * 32 + fr, fq * 8);
#define PG8_SA(b, h) (((b) * 2 + (h)) * HTB)
#define PG8_SB(b, h) ((4 + (b) * 2 + (h)) * HTB)
#define PG8_STAGE(bufoff, gbase, voff) do { _Pragma("unroll") for (int _i = 0; _i < 2; ++_i) \
        __builtin_amdgcn_global_load_lds((const unsigned*)((const char*)(gbase) + (voff)[_i]), (LAS unsigned*)(lds + (bufoff) + ldsw + _i * 8192), 16, 0, 0); } while (0)
#define PG8_LDA(dst, b, h) do { _Pragma("unroll") for (int m = 0; m < 4; ++m) _Pragma("unroll") for (int k = 0; k < 2; ++k) dst[m][k] = *(const LAS bf16x8*)(lds + PG8_SA(b, h) + aoff + m * 2048 + k * 1024); } while (0)
#define PG8_LDB(dst, b, h) do { _Pragma("unroll") for (int n = 0; n < 2; ++n) _Pragma("unroll") for (int k = 0; k < 2; ++k) dst[n][k] = *(const LAS bf16x8*)(lds + PG8_SB(b, h) + boff + n * 2048 + k * 1024); } while (0)
#define PG8_MMA(ai, bj, At, Bt) do { __builtin_amdgcn_s_setprio(1); _Pragma("unroll") for (int m = 0; m < 4; ++m) _Pragma("unroll") for (int n = 0; n < 2; ++n) _Pragma("unroll") for (int k = 0; k < 2; ++k) { \
        if constexpr (I8) acc[ai][bj][m][n] = __builtin_bit_cast(f32x4, __builtin_amdgcn_mfma_i32_16x16x64_i8(__builtin_bit_cast(i32x4, Bt[n][k]), __builtin_bit_cast(i32x4, At[m][k]), __builtin_bit_cast(i32x4, acc[ai][bj][m][n]), 0, 0, 0)); \
        else acc[ai][bj][m][n] = __builtin_amdgcn_mfma_f32_16x16x32_bf16(Bt[n][k], At[m][k], acc[ai][bj][m][n], 0, 0, 0); } __builtin_amdgcn_s_setprio(0); } while (0)
#define PG8_WAIT_V(n) asm volatile("s_waitcnt vmcnt(" #n ")" ::: "memory")
#define PG8_WAIT_L(n) asm volatile("s_waitcnt lgkmcnt(" #n ")" ::: "memory")
#define PG8_BAR __builtin_amdgcn_s_barrier()
#define PG8_SCHED __builtin_amdgcn_sched_barrier(0)
    Unit cur, nxt; int ui = 0;
    if (!S.next(0, cur)) return;
    f32x4 acc[2][2][4][2];
#pragma unroll
    for (int a = 0; a < 2; ++a)
#pragma unroll
        for (int b = 0; b < 2; ++b)
#pragma unroll
            for (int m = 0; m < 4; ++m)
#pragma unroll
                for (int n = 0; n < 2; ++n) acc[a][b][m][n] = (f32x4){0.f, 0.f, 0.f, 0.f};
    bf16x8 At[4][2], B0[2][2], B1[2][2];
    const char* cA = (const char*)g.A + (size_t)cur.z * g.zA + (size_t)cur.pm * tstep; const char* cB = (const char*)g.Bt + (size_t)cur.z * g.zB + (size_t)cur.pn * tstep;
    PG8_STAGE(PG8_SB(0, 0), cB, voffB); PG8_STAGE(PG8_SB(0, 1), cB + hstep, voffB); PG8_STAGE(PG8_SA(0, 0), cA, voffA); PG8_STAGE(PG8_SA(0, 1), cA + hstep, voffA);
    if (wr == 1) PG8_BAR;
    PG8_WAIT_V(2); PG8_BAR;
    PG8_STAGE(PG8_SB(1, 0), cB + kstep, voffB); PG8_STAGE(PG8_SA(1, 0), cA + kstep, voffA); PG8_STAGE(PG8_SB(1, 1), cB + hstep + kstep, voffB);
    PG8_WAIT_V(6); PG8_BAR;
    for (;;) {
        const bool has_next = S.next(ui + 1, nxt);
        const char* nA = has_next ? (const char*)g.A + (size_t)nxt.z * g.zA + (size_t)nxt.pm * tstep : cA;
        const char* nB = has_next ? (const char*)g.Bt + (size_t)nxt.z * g.zB + (size_t)nxt.pn * tstep : cB;
        for (int t = 0; t < nt; t += 2) {
            const bool last = (t == nt - 2);
            const char* a1 = cA + (size_t)(t + 1) * kstep;
            const char* a2 = last ? nA : cA + (size_t)(t + 2) * kstep; const char* b2 = last ? nB : cB + (size_t)(t + 2) * kstep;
            const char* a3 = a2 + kstep; const char* b3 = b2 + kstep;
            PG8_LDB(B0, 0, 0); PG8_LDB(B1, 0, 1); PG8_SCHED; PG8_LDA(At, 0, 0); PG8_STAGE(PG8_SA(1, 1), a1 + hstep, voffA);
            PG8_WAIT_V(8); PG8_WAIT_L(0); PG8_BAR; PG8_MMA(0, 0, At, B0); PG8_MMA(0, 1, At, B1); PG8_BAR; PG8_SCHED;
            PG8_LDA(At, 0, 1); PG8_STAGE(PG8_SB(0, 0), b2, voffB); PG8_STAGE(PG8_SB(0, 1), b2 + hstep, voffB); PG8_STAGE(PG8_SA(0, 0), a2, voffA);
            PG8_WAIT_V(8); PG8_WAIT_L(0); PG8_BAR; PG8_MMA(1, 0, At, B0); PG8_MMA(1, 1, At, B1); PG8_BAR; PG8_SCHED;
            PG8_LDB(B0, 1, 0); PG8_LDB(B1, 1, 1); PG8_SCHED; PG8_LDA(At, 1, 0); PG8_STAGE(PG8_SA(0, 1), a2 + hstep, voffA);
            PG8_WAIT_V(8); PG8_WAIT_L(0); PG8_BAR; PG8_MMA(0, 0, At, B0); PG8_MMA(0, 1, At, B1); PG8_BAR; PG8_SCHED;
            PG8_LDA(At, 1, 1); PG8_STAGE(PG8_SB(1, 0), b3, voffB); PG8_STAGE(PG8_SB(1, 1), b3 + hstep, voffB); PG8_STAGE(PG8_SA(1, 0), a3, voffA);
            PG8_WAIT_V(8); PG8_WAIT_L(0); PG8_BAR; PG8_MMA(1, 0, At, B0); PG8_MMA(1, 1, At, B1); PG8_BAR; PG8_SCHED;
        }
        if constexpr (ALIGN_EPI) { if (wr == 0) PG8_BAR; }
        E(acc, cur, wr, wc, fr, fq);
        if (!has_next) break;
        if (E.reset(cur)) {
#pragma unroll
        for (int a = 0; a < 2; ++a)
#pragma unroll
            for (int b = 0; b < 2; ++b)
#pragma unroll
                for (int m = 0; m < 4; ++m)
#pragma unroll
                    for (int n = 0; n < 2; ++n) acc[a][b][m][n] = (f32x4){0.f, 0.f, 0.f, 0.f};
        }
        cur = nxt; cA = nA; cB = nB; ++ui;
        if constexpr (ALIGN_EPI) { if (wr == 1) PG8_BAR; }
    }
    PG8_WAIT_V(0);
    if constexpr (!ALIGN_EPI) { if (wr == 0) PG8_BAR; }
    PG8_BAR;
#undef PG8_SA
#undef PG8_SB
#undef PG8_STAGE
#undef PG8_LDA
#undef PG8_LDB
#undef PG8_MMA
#undef PG8_WAIT_V
#undef PG8_WAIT_L
#undef PG8_BAR
#undef PG8_SCHED
}
}

#define GAS __attribute__((address_space(1)))
#define RLX_AGENT __ATOMIC_RELAXED, __HIP_MEMORY_SCOPE_AGENT
#define XB_TMO      128
#define XB_XCNT(j)  (256  + 64 * (j))
#define XB_XSUB(j)  (1280 + 64 * (j))
#define XB_XGEN(j)  (2304 + 64 * (j))
#define XB_TOP      3328
#define XB_TOPGEN   3392
#define XCD_BAR_WORDS 3456
#define XB_SPIN_CAP (1u << 18)

__device__ __forceinline__ unsigned xb_ld(unsigned* p)              { return __hip_atomic_load(p, __ATOMIC_RELAXED, __HIP_MEMORY_SCOPE_AGENT); }
__device__ __forceinline__ unsigned xb_add(unsigned* p, unsigned v) { return __hip_atomic_fetch_add(p, v, __ATOMIC_RELAXED, __HIP_MEMORY_SCOPE_AGENT); }
__device__ __forceinline__ unsigned xb_xcc_id() { return (unsigned)__builtin_amdgcn_s_getreg((3 << 11) | 20) & 0xFu; }
#define XB_SPIN(cond, bar) do { unsigned _sp = 0; while (cond) { __builtin_amdgcn_s_sleep(1); \
    if ((++_sp & 255u) == 0u) { if (xb_ld(&(bar)[XB_TMO])) break; if (_sp > XB_SPIN_CAP) { atomicAdd(&(bar)[XB_TMO], 1u); break; } } } } while (0)

struct XcdBarrier {
    unsigned* bar; unsigned x;
    volatile LAS unsigned* st;
};

__device__ __forceinline__ XcdBarrier xcd_barrier_post(unsigned* bar, volatile LAS unsigned* st) {
    XcdBarrier b; b.bar = bar; b.x = xb_xcc_id(); b.st = st;
    if (threadIdx.x == 0) (void)xb_add(&bar[XB_XCNT(b.x)], 1u);
    return b;
}
__device__ __forceinline__ void xcd_barrier_complete(unsigned* bar, unsigned x, unsigned& nloc, unsigned& nx) {
    const unsigned G = gridDim.x * gridDim.y * gridDim.z;
    unsigned sum, cnt, mine, sp = 0u;
    for (;;) {
        sum = 0u; cnt = 0u; mine = 0u;
#pragma unroll
        for (unsigned j = 0; j < 16; ++j) { const unsigned c = xb_ld(&bar[XB_XCNT(j)]); sum += c; cnt += (c > 0u) ? 1u : 0u; mine = (j == x) ? c : mine; }
        if (sum == G) break;
        __builtin_amdgcn_s_sleep(1);
        if ((++sp & 255u) == 0u) { if (xb_ld(&bar[XB_TMO])) break; if (sp > XB_SPIN_CAP) { atomicAdd(&bar[XB_TMO], 1u); break; } }
    }
    nloc = mine > 0u ? mine : 1u; nx = cnt > 0u ? cnt : 1u;
}

__device__ __forceinline__ void xcd_barrier(const XcdBarrier& b) {
    asm volatile("s_waitcnt vmcnt(0)" ::: "memory");
    __syncthreads();
    if (threadIdx.x == 0) {
        unsigned* bar = b.bar;
        __builtin_amdgcn_s_waitcnt(0);
        unsigned nloc = b.st[0], nx = b.st[1];
        if (nloc == 0u) { xcd_barrier_complete(bar, b.x, nloc, nx); b.st[0] = nloc; b.st[1] = nx; }
        const unsigned old = xb_add(&bar[XB_XSUB(b.x)], 1u);
        const unsigned gen = old / nloc;
        if (old + 1u == (gen + 1u) * nloc) {
            __builtin_amdgcn_fence(__ATOMIC_RELEASE, "agent");
            asm volatile("s_waitcnt vmcnt(0)" ::: "memory");
            const unsigned og = xb_add(&bar[XB_TOP], 1u);
            const unsigned tg = og / nx;
            if (og + 1u == (tg + 1u) * nx) xb_add(&bar[XB_TOPGEN], 1u);
            else XB_SPIN(xb_ld(&bar[XB_TOPGEN]) == tg, bar);
            __builtin_amdgcn_fence(__ATOMIC_ACQUIRE, "agent");
            xb_add(&bar[XB_XGEN(b.x)], 1u);
            asm volatile("s_waitcnt vmcnt(0)" ::: "memory");
        } else {
            XB_SPIN(xb_ld(&bar[XB_XGEN(b.x)]) == gen, bar);
            __builtin_amdgcn_fence(__ATOMIC_ACQUIRE, "agent");
            asm volatile("s_waitcnt vmcnt(0)" ::: "memory");
        }
    }
    __syncthreads();
}

__device__ __forceinline__ void transpose_item(const float* __restrict__ W, int K, int N, bf16_t* __restrict__ WT, LAS float* scr, int item, int lane) {
    const int nblk = N / 32, kb = item / nblk, nb = item - kb * nblk, k0 = 64 * kb, n0 = 32 * nb;
    float tv[32];
#pragma unroll
    for (int i = 0; i < 32; ++i) { const int kk = 2 * i + (lane >> 5); tv[i] = W[(size_t)(k0 + kk) * N + n0 + (lane & 31)]; }
#pragma unroll
    for (int i = 0; i < 32; ++i) { const int kk = 2 * i + (lane >> 5); scr[kk * 33 + (lane & 31)] = tv[i]; }
    asm volatile("s_waitcnt lgkmcnt(0)" ::: "memory");
    const int c = lane & 7;
#pragma unroll
    for (int j = 0; j < 4; ++j) { const int n = (lane >> 3) + 8 * j; const LAS float* s = scr + (8 * c) * 33 + n;
        u32x4 o; o.x = pk2(s[0 * 33], s[1 * 33]); o.y = pk2(s[2 * 33], s[3 * 33]); o.z = pk2(s[4 * 33], s[5 * 33]); o.w = pk2(s[6 * 33], s[7 * 33]);
        *(u32x4*)(WT + (size_t)(n0 + n) * K + k0 + 8 * c) = o; }
    asm volatile("s_waitcnt lgkmcnt(0)" ::: "memory");
}

template <bool QUANT>
__device__ __forceinline__ void gate_weight_item(const float* __restrict__ W, int K, int N, unsigned char* __restrict__ W8, unsigned* colmax, int nbase, LAS float* scr, int item, int lane) {
    constexpr int NBG = NI8 / 32;
    const int kb = item / NBG, nb = item - kb * NBG, k0 = 64 * kb, n0 = nbase + 32 * nb;
    float tv[32];
#pragma unroll
    for (int i = 0; i < 32; ++i) { const int kk = 2 * i + (lane >> 5); tv[i] = W[(size_t)(k0 + kk) * N + n0 + (lane & 31)]; }
    if constexpr (!QUANT) {
        float mx = 0.f;
#pragma unroll
        for (int i = 0; i < 32; ++i) mx = fmaxf(mx, fabsf(tv[i]));
        mx = fmaxf(mx, __shfl_xor(mx, 32));
        if (lane < 32) atomicMax(colmax + (n0 - nbase) + lane, __float_as_uint(mx));
    } else {
        const float qs = 127.f / fmaxf(__uint_as_float(colmax[(n0 - nbase) + (lane & 31)]), 1e-30f);
#pragma unroll
        for (int i = 0; i < 32; ++i) { const int kk = 2 * i + (lane >> 5); scr[kk * 33 + (lane & 31)] = tv[i] * qs; }
        asm volatile("s_waitcnt lgkmcnt(0)" ::: "memory");
        const int n = lane >> 1, kh = (lane & 1) * 32;
        const LAS float* s = scr + kh * 33 + n;
        u32x4 o0, o1;
        o0.x = q8x4(s[0 * 33], s[1 * 33], s[2 * 33], s[3 * 33]);     o0.y = q8x4(s[4 * 33], s[5 * 33], s[6 * 33], s[7 * 33]);
        o0.z = q8x4(s[8 * 33], s[9 * 33], s[10 * 33], s[11 * 33]);   o0.w = q8x4(s[12 * 33], s[13 * 33], s[14 * 33], s[15 * 33]);
        o1.x = q8x4(s[16 * 33], s[17 * 33], s[18 * 33], s[19 * 33]); o1.y = q8x4(s[20 * 33], s[21 * 33], s[22 * 33], s[23 * 33]);
        o1.z = q8x4(s[24 * 33], s[25 * 33], s[26 * 33], s[27 * 33]); o1.w = q8x4(s[28 * 33], s[29 * 33], s[30 * 33], s[31 * 33]);
        unsigned char* dst = W8 + (size_t)(n0 - nbase + n) * K + k0 + kh;
        *(u32x4*)dst = o0; *(u32x4*)(dst + 16) = o1;
        asm volatile("s_waitcnt lgkmcnt(0)" ::: "memory");
    }
}

template <bool HAS_Y, bool WRITE_H>
__device__ __forceinline__ void row_pass(const float* __restrict__ xin, const bf16_t* __restrict__ Y, const float* __restrict__ post_g, float* xout,
                                         const float* __restrict__ pre_g, bf16_t* __restrict__ H, unsigned char* __restrict__ H8, float* __restrict__ HS, int gw, int NGW, int lane) {
    for (int row = gw; row < MT; row += NGW) {
        float xv[4][8];
#pragma unroll
        for (int j = 0; j < 4; ++j) { const int col = (j * 64 + lane) * 8; const f32x4 a = *(const f32x4*)(xin + (size_t)row * DM + col), b = *(const f32x4*)(xin + (size_t)row * DM + col + 4);
#pragma unroll
            for (int e = 0; e < 4; ++e) { xv[j][e] = a[e]; xv[j][4 + e] = b[e]; } }
        if constexpr (HAS_Y) {
            float yv[4][8]; float ss = 0.f;
#pragma unroll
            for (int j = 0; j < 4; ++j) { const int col = (j * 64 + lane) * 8; const u32x4 w = *(const u32x4*)(Y + (size_t)row * DM + col);
                yv[j][0] = bflo(w.x); yv[j][1] = bfhi(w.x); yv[j][2] = bflo(w.y); yv[j][3] = bfhi(w.y); yv[j][4] = bflo(w.z); yv[j][5] = bfhi(w.z); yv[j][6] = bflo(w.w); yv[j][7] = bfhi(w.w);
#pragma unroll
                for (int e = 0; e < 8; ++e) ss += yv[j][e] * yv[j][e]; }
            const float r = 1.0f / sqrtf(wave_sum(ss) * (1.0f / DM) + EPSN);
#pragma unroll
            for (int j = 0; j < 4; ++j) { const int col = (j * 64 + lane) * 8; const f32x4 ga = *(const f32x4*)(post_g + col), gb = *(const f32x4*)(post_g + col + 4);
#pragma unroll
                for (int e = 0; e < 4; ++e) { xv[j][e] += yv[j][e] * r * ga[e]; xv[j][4 + e] += yv[j][4 + e] * r * gb[e]; }
                *(f32x4*)(xout + (size_t)row * DM + col) = (f32x4){xv[j][0], xv[j][1], xv[j][2], xv[j][3]};
                *(f32x4*)(xout + (size_t)row * DM + col + 4) = (f32x4){xv[j][4], xv[j][5], xv[j][6], xv[j][7]}; }
        }
        if constexpr (WRITE_H) {
            float ss = 0.f;
#pragma unroll
            for (int j = 0; j < 4; ++j)
#pragma unroll
                for (int e = 0; e < 8; ++e) ss += xv[j][e] * xv[j][e];
            const float r = 1.0f / sqrtf(wave_sum(ss) * (1.0f / DM) + EPSN);
            float amax = 0.f;
#pragma unroll
            for (int j = 0; j < 4; ++j) { const int col = (j * 64 + lane) * 8; const f32x4 ga = *(const f32x4*)(pre_g + col), gb = *(const f32x4*)(pre_g + col + 4);
#pragma unroll
                for (int e = 0; e < 4; ++e) { xv[j][e] *= r * ga[e]; xv[j][4 + e] *= r * gb[e]; amax = fmaxf(amax, fmaxf(fabsf(xv[j][e]), fabsf(xv[j][4 + e]))); }
                u32x4 w; w.x = pk2(xv[j][0], xv[j][1]); w.y = pk2(xv[j][2], xv[j][3]); w.z = pk2(xv[j][4], xv[j][5]); w.w = pk2(xv[j][6], xv[j][7]);
                *(u32x4*)(H + (size_t)row * DM + col) = w; }
#pragma unroll
            for (int o = 1; o < 64; o <<= 1) amax = fmaxf(amax, __shfl_xor(amax, o));
            amax = fmaxf(amax, 1e-20f);
            const float qs = 127.f / amax;
            if (lane == 0) HS[row] = amax * (1.f / 127.f);
#pragma unroll
            for (int j = 0; j < 4; ++j) { const int col = (j * 64 + lane) * 8;
                u32x2 w8; w8.x = q8x4(xv[j][0] * qs, xv[j][1] * qs, xv[j][2] * qs, xv[j][3] * qs); w8.y = q8x4(xv[j][4] * qs, xv[j][5] * qs, xv[j][6] * qs, xv[j][7] * qs);
                *(u32x2*)(H8 + (size_t)row * DM + col) = w8; }
        }
    }
}

constexpr int ATP = 144;
constexpr int ATT_WAVE_LDS = 2 * 64 * ATP;
#define ATT_BAR() asm volatile("s_waitcnt lgkmcnt(0)\n\ts_barrier" ::: "memory")
__device__ __forceinline__ void attn_item(const bf16_t* __restrict__ Q, const bf16_t* __restrict__ Kb, const bf16_t* __restrict__ VT, const bf16_t* __restrict__ GA,
                                          bf16_t* __restrict__ OA, const LAS float* btab, LAS unsigned char* pl  , int b, int c, int h, int half, int lane) {
    const int r = lane & 31, hh = lane >> 5;
    const int rl = lane >> 3, cl = lane & 7;
    const int tokq = b * SEQ + c * 64 + half * 32;
    const int qloc = half * 32 + r;
    const int pr = (r & ~12) | ((r & 4) << 1) | ((r & 8) >> 1);
    const int jmin = c >= 8 ? 0 : 8 - c;
    const int tk0 = b * SEQ + (c - 8 + jmin) * 64;
    const bf16_t* tg = half ? VT + (size_t)(h * 64 + rl) * PT + tk0 + cl * 8 : Kb + (size_t)(tk0 + rl) * DH + h * 64 + cl * 8;
    const size_t rstep = half ? (size_t)8 * PT : (size_t)8 * DH;
    const size_t tstep = half ? (size_t)64 : (size_t)64 * DH;
    const int stoff = (half ? 64 * ATP : 0) + rl * ATP + cl * 16;
    u32x4 tr[8];
#pragma unroll
    for (int i = 0; i < 8; ++i) tr[i] = *(const u32x4*)(tg + i * rstep);
    bf16x8 qf[4];
    { const bf16_t* qp = Q + (size_t)(tokq + r) * DH + h * 64 + 8 * hh;
#pragma unroll
      for (int d0 = 0; d0 < 4; ++d0) qf[d0] = *(const bf16x8*)(qp + d0 * 16); }
    int buf = 0;
#pragma unroll
    for (int i = 0; i < 8; ++i) *(LAS u32x4*)(pl + stoff + 8 * i * ATP) = tr[i];
    tg += (jmin + 1 <= 8) ? tstep : (size_t)0;
#pragma unroll
    for (int i = 0; i < 8; ++i) tr[i] = *(const u32x4*)(tg + i * rstep);
    ATT_BAR();
    f32x16 o0, o1, cinit;
#pragma unroll
    for (int i = 0; i < 16; ++i) { o0[i] = 0.f; o1[i] = 0.f; }
    constexpr float ATT_THR = 8.f;
    float mref = 0.f, lrun = 0.f;
    const float cfar = btab[NREL - 1];
#pragma unroll
    for (int i = 0; i < 16; ++i) cinit[i] = cfar;
    for (int j = jmin; j <= 8; ++j) {
        const LAS unsigned char* kfp = pl + buf * ATT_WAVE_LDS + pr * ATP + 16 * hh;
        const LAS unsigned char* vfp = pl + buf * ATT_WAVE_LDS + 64 * ATP + r * ATP + 16 * hh;
        f32x16 s0, s1;
        if (j <= 3) {
            const bf16x8 k0 = *(const LAS bf16x8*)(kfp), k1 = *(const LAS bf16x8*)(kfp + 32 * ATP);
            s0 = MFMA32(k0, qf[0], cinit); s1 = MFMA32(k1, qf[0], cinit);
        } else {
            const LAS float* bp = btab + (qloc + 64 * (8 - j) + 63 - 8 * hh);
#pragma unroll
            for (int i = 0; i < 16; ++i) {
                const int key = (i & 3) + 4 * ((i >> 2) & 1) + 16 * (i >> 3);
                s0[i] = bp[-key] - mref; s1[i] = bp[-key - 32] - mref;
            }
            const bf16x8 k0 = *(const LAS bf16x8*)(kfp), k1 = *(const LAS bf16x8*)(kfp + 32 * ATP);
            s0 = MFMA32(k0, qf[0], s0); s1 = MFMA32(k1, qf[0], s1);
        }
#pragma unroll
        for (int d0 = 1; d0 < 4; ++d0) {
            const bf16x8 k0 = *(const LAS bf16x8*)(kfp + d0 * 32), k1 = *(const LAS bf16x8*)(kfp + 32 * ATP + d0 * 32);
            s0 = MFMA32(k0, qf[d0], s0); s1 = MFMA32(k1, qf[d0], s1);
        }
        float tmax = fmaxf(s0[0], s1[0]);
#pragma unroll
        for (int i = 1; i < 16; ++i) tmax = fmaxf(tmax, fmaxf(s0[i], s1[i]));
        tmax = fmaxf(tmax, __shfl_xor(tmax, 32));
        if (j == jmin || __any(tmax > ATT_THR)) {
            const float dl = (j == jmin) ? tmax : fmaxf(tmax, 0.f);
            mref += dl;
            const float alpha = (j == jmin) ? 1.f : __builtin_amdgcn_exp2f(-dl);
            lrun *= alpha;
#pragma unroll
            for (int i = 0; i < 16; ++i) { s0[i] -= dl; s1[i] -= dl; o0[i] *= alpha; o1[i] *= alpha; cinit[i] = cfar - mref; }
        }
        float ls = 0.f;
#pragma unroll
        for (int i = 0; i < 16; ++i) { s0[i] = __builtin_amdgcn_exp2f(s0[i]); s1[i] = __builtin_amdgcn_exp2f(s1[i]); ls += s0[i] + s1[i]; }
        lrun += ls;
#pragma unroll
        for (int s = 0; s < 2; ++s) {
            u32x4 pa, pb;
            pa.x = pk2(s0[8 * s + 0], s0[8 * s + 1]); pa.y = pk2(s0[8 * s + 2], s0[8 * s + 3]); pa.z = pk2(s0[8 * s + 4], s0[8 * s + 5]); pa.w = pk2(s0[8 * s + 6], s0[8 * s + 7]);
            pb.x = pk2(s1[8 * s + 0], s1[8 * s + 1]); pb.y = pk2(s1[8 * s + 2], s1[8 * s + 3]); pb.z = pk2(s1[8 * s + 4], s1[8 * s + 5]); pb.w = pk2(s1[8 * s + 6], s1[8 * s + 7]);
            const bf16x8 va0 = *(const LAS bf16x8*)(vfp + 32 * s), va1 = *(const LAS bf16x8*)(vfp + 32 * ATP + 32 * s);
            const bf16x8 vb0 = *(const LAS bf16x8*)(vfp + 64 + 32 * s), vb1 = *(const LAS bf16x8*)(vfp + 32 * ATP + 64 + 32 * s);
            o0 = MFMA32(va0, __builtin_bit_cast(bf16x8, pa), o0); o1 = MFMA32(va1, __builtin_bit_cast(bf16x8, pa), o1);
            o0 = MFMA32(vb0, __builtin_bit_cast(bf16x8, pb), o0); o1 = MFMA32(vb1, __builtin_bit_cast(bf16x8, pb), o1);
        }
        buf ^= 1;
#pragma unroll
        for (int i = 0; i < 8; ++i) *(LAS u32x4*)(pl + buf * ATT_WAVE_LDS + stoff + 8 * i * ATP) = tr[i];
        tg += (j + 2 <= 8) ? tstep : (size_t)0;
#pragma unroll
        for (int i = 0; i < 8; ++i) tr[i] = *(const u32x4*)(tg + i * rstep);
        ATT_BAR();
    }
    const float l = lrun + __shfl_xor(lrun, 32);
    const float inv = 1.0f / l;
    LAS unsigned char* Ot = pl + half * ATT_WAVE_LDS;
#pragma unroll
    for (int g = 0; g < 4; ++g) {
#pragma unroll
        for (int db = 0; db < 2; ++db) {
            const f32x16& o = db ? o1 : o0;
            u32x2 w; w.x = pk2(o[4 * g + 0] * inv, o[4 * g + 1] * inv); w.y = pk2(o[4 * g + 2] * inv, o[4 * g + 3] * inv);
            *(LAS u32x2*)(Ot + r * ATP + (db * 32 + 8 * g + 4 * hh) * 2) = w;
        }
    }
#pragma unroll
    for (int i = 0; i < 4; ++i) {
        const int row = rl + 8 * i;
        const size_t a = (size_t)(tokq + row) * DH + h * 64 + cl * 8;
        const u32x4 gg = *(const u32x4*)(GA + a);
        const u32x4 ov = *(const LAS u32x4*)(Ot + row * ATP + cl * 16);
        u32x4 w; w.x = pk2(bflo(ov.x) * bflo(gg.x), bfhi(ov.x) * bfhi(gg.x)); w.y = pk2(bflo(ov.y) * bflo(gg.y), bfhi(ov.y) * bfhi(gg.y));
        w.z = pk2(bflo(ov.z) * bflo(gg.z), bfhi(ov.z) * bfhi(gg.z)); w.w = pk2(bflo(ov.w) * bflo(gg.w), bfhi(ov.w) * bfhi(gg.w));
        *(u32x4*)(OA + a) = w;
    }
    ATT_BAR();
}
#undef ATT_BAR

__device__ __forceinline__ void unpack8(const u32x4 w, float* v) { v[0] = bflo(w.x); v[1] = bfhi(w.x); v[2] = bflo(w.y); v[3] = bfhi(w.y); v[4] = bflo(w.z); v[5] = bfhi(w.z); v[6] = bflo(w.w); v[7] = bfhi(w.w); }
__device__ __forceinline__ void conv_unit(const bf16_t* __restrict__ BB, const bf16_t* __restrict__ CC, const bf16_t* __restrict__ HB, const bf16_t* __restrict__ GB,
                                          bf16_t* __restrict__ OB, const float* __restrict__ cw, int unit, int tid) {
    const int cgp = tid & 127, sub = tid >> 7, ch = cgp * 8;
    const int t0 = unit * 32 + sub * 8;
    float w0[8], w1[8], w2[8];
#pragma unroll
    for (int e = 0; e < 8; ++e) { w0[e] = cw[ch + e]; w1[e] = cw[DH + ch + e]; w2[e] = cw[2 * DH + ch + e]; }
    float p2[8], p1[8];
#pragma unroll
    for (int e = 0; e < 8; ++e) { p2[e] = 0.f; p1[e] = 0.f; }
    const int tpos = t0 & (SEQ - 1);
    if (tpos >= 2) { float a[8], b[8]; unpack8(*(const u32x4*)(CC + (size_t)(t0 - 2) * DH + ch), a); unpack8(*(const u32x4*)(HB + (size_t)(t0 - 2) * DH + ch), b);
#pragma unroll
        for (int e = 0; e < 8; ++e) p2[e] = a[e] * b[e]; }
    if (tpos >= 1) { float a[8], b[8]; unpack8(*(const u32x4*)(CC + (size_t)(t0 - 1) * DH + ch), a); unpack8(*(const u32x4*)(HB + (size_t)(t0 - 1) * DH + ch), b);
#pragma unroll
        for (int e = 0; e < 8; ++e) p1[e] = a[e] * b[e]; }
#pragma unroll
    for (int i = 0; i < 8; ++i) {
        const size_t off = (size_t)(t0 + i) * DH + ch;
        float a[8], b[8], g1[8], g2[8], o[8];
        unpack8(*(const u32x4*)(CC + off), a); unpack8(*(const u32x4*)(HB + off), b); unpack8(*(const u32x4*)(BB + off), g1); unpack8(*(const u32x4*)(GB + off), g2);
#pragma unroll
        for (int e = 0; e < 8; ++e) { const float cur = a[e] * b[e]; o[e] = g1[e] * (w0[e] * p2[e] + w1[e] * p1[e] + w2[e] * cur) * g2[e]; p2[e] = p1[e]; p1[e] = cur; }
        u32x4 w; w.x = pk2(o[0], o[1]); w.y = pk2(o[2], o[3]); w.z = pk2(o[4], o[5]); w.w = pk2(o[6], o[7]);
        *(u32x4*)(OB + off) = w;
    }
}

template <int tbA, int tbB>
__device__ __forceinline__ void sgu_groups(const bf16_t* __restrict__ VCT, const bf16_t* __restrict__ U, const bf16_t* __restrict__ GC, bf16_t* __restrict__ OC,
                                           const bf16_t* __restrict__ Wbf, const float* __restrict__ spb, const float* __restrict__ lng, const float* __restrict__ lnb,
                                           int tok0, int gh, int cb, int r, int hh, const LAS float* stat, LAS unsigned char* stg, int lane) {
    for (int gi = 0; gi < 4; ++gi) {
        const int g = gh * 4 + gi;
        const int ch = g * 128 + cb * 32 + r;
        const float gg = lng[ch], bb = lnb[ch];
        const bf16_t* ap = VCT + (size_t)ch * PT + tok0 + 8 * hh;
        const bf16_t* wp = Wbf + (size_t)g * 16384 + 8 * hh;
        constexpr int NSB = (tbB + 1) * 2, NSA = (tbA + 1) * 2;
        int so = 0; asm volatile("" : "+v"(so));
        u32x4 raw[NSB]; bf16x8 wB[NSB], wA[NSA];
#pragma unroll
        for (int k = 0; k < NSB; ++k) { raw[k] = *(const u32x4*)(ap + 16 * k); wB[k] = *(const bf16x8*)(wp + (size_t)(tbB * 32 + r) * 128 + 16 * k); }
#pragma unroll
        for (int k = 0; k < NSA; ++k) wA[k] = *(const bf16x8*)(wp + (size_t)(tbA * 32 + r) * 128 + 16 * k);
        f32x16 accA, accB;
#pragma unroll
        for (int i = 0; i < 16; ++i) { accA[i] = 0.f; accB[i] = 0.f; }
#pragma unroll
        for (int k = 0; k < NSB; ++k) {
            float v[8]; unpack8(raw[k], v);
#pragma unroll
            for (int jj = 0; jj < 8; ++jj) { const float mean = stat[(16 * k + 8 * hh + jj) * 2 + so], rstd = stat[(16 * k + 8 * hh + jj) * 2 + 1 + so]; v[jj] = (v[jj] - mean) * rstd * gg + bb; }
            u32x4 af; af.x = pk2(v[0], v[1]); af.y = pk2(v[2], v[3]); af.z = pk2(v[4], v[5]); af.w = pk2(v[6], v[7]);
            accB = MFMA32(__builtin_bit_cast(bf16x8, af), wB[k], accB);
            if (k < NSA) accA = MFMA32(__builtin_bit_cast(bf16x8, af), wA[k < NSA ? k : 0], accA);
        }
#pragma unroll
        for (int which = 0; which < 2; ++which) {
            const int tb = which ? tbB : tbA; const f32x16& acc = which ? accB : accA;
            const float sbv = spb[g * 128 + tb * 32 + r];
#pragma unroll
            for (int q = 0; q < 4; ++q) {
                u32x2 w; w.x = pk2(acc[4 * q + 0] + sbv, acc[4 * q + 1] + sbv); w.y = pk2(acc[4 * q + 2] + sbv, acc[4 * q + 3] + sbv);
                *(LAS u32x2*)(stg + which * 2560 + r * 80 + (8 * q + 4 * hh) * 2) = w;
            }
        }
#pragma unroll
        for (int which = 0; which < 2; ++which) {
            const int tb = which ? tbB : tbA;
#pragma unroll
            for (int i = 0; i < 2; ++i) {
                const int t = (lane >> 2) + 16 * i, ck = lane & 3;
                const size_t a = (size_t)(tok0 + tb * 32 + t) * DH + g * 128 + cb * 32 + ck * 8;
                const u32x4 uu = *(const u32x4*)(U + a), gc = *(const u32x4*)(GC + a);
                const u32x4 mv = *(const LAS u32x4*)(stg + which * 2560 + t * 80 + ck * 16);
                u32x4 o; o.x = pk2(bflo(uu.x) * bflo(mv.x) * bflo(gc.x), bfhi(uu.x) * bfhi(mv.x) * bfhi(gc.x)); o.y = pk2(bflo(uu.y) * bflo(mv.y) * bflo(gc.y), bfhi(uu.y) * bfhi(mv.y) * bfhi(gc.y));
                o.z = pk2(bflo(uu.z) * bflo(mv.z) * bflo(gc.z), bfhi(uu.z) * bfhi(mv.z) * bfhi(gc.z)); o.w = pk2(bflo(uu.w) * bflo(mv.w) * bflo(gc.w), bfhi(uu.w) * bfhi(mv.w) * bfhi(gc.w));
                *(u32x4*)(OC + a) = o;
            }
        }
    }
}

__device__ __forceinline__ void sgu_unit(const bf16_t* __restrict__ VCT, const bf16_t* __restrict__ U, const bf16_t* __restrict__ GC, bf16_t* __restrict__ OC,
                                         const bf16_t* __restrict__ Wbf, const float* __restrict__ spb, const float* __restrict__ lng, const float* __restrict__ lnb,
                                         int b, int n, int gh, LAS unsigned char* lds, int tid) {
    const int lane = tid & 63, w = __builtin_amdgcn_readfirstlane(tid >> 6), r = lane & 31, hh = lane >> 5;
    const int tok0 = b * SEQ + n * 128;
    __syncthreads();
    LAS float* part = (LAS float*)lds;
    LAS float* stat = part + 8 * 128 * 2;
    {
        const int tl = lane & 15, cq = lane >> 4;
        const bf16_t* p = VCT + (size_t)(w * 128 + cq) * PT + tok0 + 8 * tl;
        float sm[8], sq[8];
#pragma unroll
        for (int e = 0; e < 8; ++e) { sm[e] = 0.f; sq[e] = 0.f; }
#pragma unroll 8
        for (int c4 = 0; c4 < 32; ++c4) { float v[8]; unpack8(*(const u32x4*)(p + (size_t)(c4 * 4) * PT), v);
#pragma unroll
            for (int e = 0; e < 8; ++e) { sm[e] += v[e]; sq[e] += v[e] * v[e]; } }
#pragma unroll
        for (int e = 0; e < 8; ++e) { sm[e] += __shfl_xor(sm[e], 16); sm[e] += __shfl_xor(sm[e], 32); sq[e] += __shfl_xor(sq[e], 16); sq[e] += __shfl_xor(sq[e], 32); }
        if (cq == 0) {
#pragma unroll
            for (int e = 0; e < 8; ++e) { part[(w * 128 + 8 * tl + e) * 2 + 0] = sm[e]; part[(w * 128 + 8 * tl + e) * 2 + 1] = sq[e]; }
        }
    }
    __syncthreads();
    if (tid < 128) {
        float S = 0.f, SS = 0.f;
#pragma unroll
        for (int ww = 0; ww < 8; ++ww) { S += part[(ww * 128 + tid) * 2]; SS += part[(ww * 128 + tid) * 2 + 1]; }
        const float mean = S * (1.0f / DH); const float var = fmaxf(SS * (1.0f / DH) - mean * mean, 0.f);
        stat[tid * 2] = mean; stat[tid * 2 + 1] = 1.0f / sqrtf(var + EPSN);
    }
    __syncthreads();
    LAS unsigned char* stg = lds + 16384 + w * 5120;
    if ((w >> 2) == 0) sgu_groups<0, 3>(VCT, U, GC, OC, Wbf, spb, lng, lnb, tok0, gh, w & 3, r, hh, stat, stg, lane);
    else sgu_groups<1, 2>(VCT, U, GC, OC, Wbf, spb, lng, lnb, tok0, gh, w & 3, r, hh, stat, stg, lane);
    __syncthreads();
}

struct Args { const float* in[14]; float* out; unsigned char* ws; int ph_lo, ph_hi; };
constexpr int NPH = 11;

__device__ __forceinline__ void phase_prologue(const Args& args, LAS unsigned char* lds) {
    const int tid = threadIdx.x, lane = tid & 63, wave = __builtin_amdgcn_readfirstlane(tid >> 6);
    const int G = gridDim.x, blk = blockIdx.x, gw = blk * 8 + wave, NGW = G * 8;
    unsigned char* ws = args.ws;
    LAS float* scr = (LAS float*)(lds + wave * 16384);
    constexpr int I_IN = (DM / 64) * (NIN / 32), I_BR = (DH / 64) * (DM / 32), I_OUT = (DM / 64) * (DM / 32);
    constexpr int PER_L = I_IN + 3 * I_BR + I_OUT;
    for (int it = gw; it < 2 * PER_L; it += NGW) {
        const int l = it / PER_L; int r = it - l * PER_L;
        if (r < I_IN) { const int kb = r / (NIN / 32), nb = r - kb * (NIN / 32);
            if (nb * 32 < NBF) transpose_item(args.in[2] + (size_t)l * DM * NIN, DM, NIN, (bf16_t*)(ws + WS_WIN + (size_t)l * 68 * MiB), scr, r, lane);
            else gate_weight_item<false>(args.in[2] + (size_t)l * DM * NIN, DM, NIN, nullptr, (unsigned*)(ws + WS_COLMAX) + l * NI8, NBF, scr, kb * (NI8 / 32) + (nb - NBF / 32), lane);
            continue; } r -= I_IN;
        if (r < 3 * I_BR) { const int br = r / I_BR; r -= br * I_BR; const float* src = (br == 0 ? args.in[9] : (br == 1 ? args.in[10] : args.in[11])) + (size_t)l * DH * DM;
            transpose_item(src, DH, DM, (bf16_t*)(ws + WS_WBR + (size_t)(l * 3 + br) * 4 * MiB), scr, r, lane); continue; } r -= 3 * I_BR;
        transpose_item(args.in[12] + (size_t)l * DM * DM, DM, DM, (bf16_t*)(ws + WS_WOUT + (size_t)l * 8 * MiB), scr, r, lane);
    }
    { bf16_t* wb = (bf16_t*)(ws + WS_SGUW); const float* sp_w = args.in[7];
      for (int e = blk * 512 + tid; e < 2 * 8 * 128 * 128; e += G * 512) { const int t = (e >> 7) & 127, s = e & 127; const unsigned p = pk2(sp_w[e], 0.f); wb[e] = (s <= t) ? (bf16_t)(p & 0xffffu) : (bf16_t)0; } }
    row_pass<false, true>(args.in[0], nullptr, nullptr, nullptr, args.in[1], (bf16_t*)(ws + WS_H), ws + WS_H8, (float*)(ws + WS_HS), gw, NGW, lane);
}

__device__ __forceinline__ void phase_quant(const Args& args, LAS unsigned char* lds) {
    const int tid = threadIdx.x, lane = tid & 63, wave = __builtin_amdgcn_readfirstlane(tid >> 6);
    const int gw = blockIdx.x * 8 + wave, NGW = gridDim.x * 8;
    unsigned char* ws = args.ws;
    LAS float* scr = (LAS float*)(lds + wave * 16384);
    constexpr int PER_L = (DM / 64) * (NI8 / 32);
    for (int it = gw; it < 2 * PER_L; it += NGW) {
        const int l = it / PER_L, r = it - l * PER_L;
        gate_weight_item<true>(args.in[2] + (size_t)l * DM * NIN, DM, NIN, ws + WS_W8 + (size_t)l * 18 * MiB, (unsigned*)(ws + WS_COLMAX) + l * NI8, NBF, scr, r, lane);
    }
}

template <int L> __device__ __forceinline__ void phase_in(const Args& args, LAS unsigned char* lds) {
    unsigned char* ws = args.ws;
    {
        pg8::Gemm g{(const bf16_t*)(ws + WS_H), (const bf16_t*)(ws + WS_WIN + (size_t)L * 68 * MiB), MT, NBF, DM, 0, 0};
        pg8::TileOrder<1> S; S.init(MT, NBF, gridDim.x, blockIdx.x);
        pg8::EpiIn E{ws + WS_SEG, (bf16_t*)(ws + WS_GATES), (bf16_t*)(ws + WS_VT), (bf16_t*)(ws + WS_VCT)};
        pg8::gemm_phase<pg8::EpiIn, pg8::TileOrder<1>, true>(lds, g, S, E);
    }
    {
        pg8::Gemm g{(const bf16_t*)(ws + WS_H8), (const bf16_t*)(ws + WS_W8 + (size_t)L * 18 * MiB), MT, NI8, DM / 2, 0, 0};
        pg8::TileOrder<1> S; S.init(MT, NI8, gridDim.x, blockIdx.x);
        pg8::EpiIn8 E{ws + WS_SEG, (bf16_t*)(ws + WS_GATES), (bf16_t*)(ws + WS_VCT), (const float*)(ws + WS_HS), (const float*)(ws + WS_COLMAX) + L * NI8};
        pg8::gemm_phase<pg8::EpiIn8, pg8::TileOrder<1>, true, true>(lds, g, S, E);
    }
}

template <int L> __device__ __forceinline__ void phase_mix(const Args& args, LAS unsigned char* lds) {
    const int tid = threadIdx.x, lane = tid & 63, wave = __builtin_amdgcn_readfirstlane(tid >> 6);
    const int G = gridDim.x, blk = blockIdx.x;
    unsigned char* ws = args.ws;
    const bf16_t* segb = (const bf16_t*)(ws + WS_SEG);
    bf16_t* OA = (bf16_t*)(ws + WS_O);
    constexpr size_t SE = (size_t)MT * DH;
    LAS float* btab = (LAS float*)(lds + 8 * ATT_WAVE_LDS + wave * 1536);
    LAS unsigned char* wl = lds + (wave >> 1) * (2 * ATT_WAVE_LDS);
    int cur_h = -1;
    for (int u = blk; u < 1024 + 512 + 256; u += G) {
        if (u < 1024) {
            const int hg = u & 3, b = (u >> 2) & 7, c = u >> 5;
            const int h = hg * 4 + (wave >> 1), half = wave & 1;
            if (h != cur_h) { const float* rb = args.in[3] + (size_t)(L * 16 + h) * NREL;
#pragma unroll
                for (int i = 0; i < 6; ++i) { const int idx = i * 64 + lane; btab[idx] = rb[idx < NREL ? idx : NREL - 1] * LOG2E; }
                cur_h = h; }
            attn_item(segb, segb + SE, (const bf16_t*)(ws + WS_VT), segb + 3 * SE, OA, btab, wl, b, c, h, half, lane);
        } else if (u < 1536) {
            conv_unit(segb + 4 * SE, segb + 5 * SE, segb + 6 * SE, segb + 7 * SE, OA + SE, args.in[4] + (size_t)L * 3 * DH, u - 1024, tid);
        } else {
            const int su = u - 1536; const int gh = su & 1, n = (su >> 1) & 15, b = su >> 5;
            sgu_unit((const bf16_t*)(ws + WS_VCT), segb + 8 * SE, segb + 10 * SE, OA + 2 * SE, (const bf16_t*)(ws + WS_SGUW) + (size_t)L * 8 * 16384, args.in[8] + (size_t)L * 8 * 128,
                     args.in[5] + (size_t)L * DH, args.in[6] + (size_t)L * DH, b, n, gh, lds, tid);
        }
    }
}

template <int L> __device__ __forceinline__ void phase_br(const Args& args, LAS unsigned char* lds) {
    unsigned char* ws = args.ws;
    pg8::Gemm g{(const bf16_t*)(ws + WS_O), (const bf16_t*)(ws + WS_WBR + (size_t)L * 12 * MiB), MT, DM, DH, (size_t)32 * MiB, (size_t)4 * MiB};
    pg8::TileOrder<3> S; S.init(MT, DM, gridDim.x, blockIdx.x);
    pg8::EpiMerge E{(const bf16_t*)(ws + WS_GATES), (bf16_t*)(ws + WS_MERGED16)};
    pg8::gemm_phase<pg8::EpiMerge, pg8::TileOrder<3>, true>(lds, g, S, E);
}

template <int L> __device__ __forceinline__ void phase_out(const Args& args, LAS unsigned char* lds) {
    unsigned char* ws = args.ws;
    pg8::Gemm g{(const bf16_t*)(ws + WS_MERGED16), (const bf16_t*)(ws + WS_WOUT + (size_t)L * 8 * MiB), MT, DM, DM, 0, 0};
    pg8::TileOrder<1> S; S.init(MT, DM, gridDim.x, blockIdx.x);
    pg8::EpiPlain E{(bf16_t*)(ws + WS_Y), DM};
    pg8::gemm_phase<pg8::EpiPlain, pg8::TileOrder<1>, true>(lds, g, S, E);
}

template <int L> __device__ __forceinline__ void phase_row(const Args& args) {
    const int tid = threadIdx.x, lane = tid & 63, wave = __builtin_amdgcn_readfirstlane(tid >> 6);
    const int gw = blockIdx.x * 8 + wave, NGW = gridDim.x * 8;
    unsigned char* ws = args.ws;
    if (L == 0) row_pass<true, true>(args.in[0], (const bf16_t*)(ws + WS_Y), args.in[13], args.out, args.in[1] + DM, (bf16_t*)(ws + WS_H), ws + WS_H8, (float*)(ws + WS_HS), gw, NGW, lane);
    else row_pass<true, false>(args.out, (const bf16_t*)(ws + WS_Y), args.in[13] + DM, args.out, nullptr, nullptr, nullptr, nullptr, gw, NGW, lane);
}

__global__ void __launch_bounds__(512, 2) mk_fwd(const Args args) {
    extern __shared__ __attribute__((aligned(16))) unsigned char lds_raw[];
    LAS unsigned char* lds = (LAS unsigned char*)lds_raw;
    const int lo = args.ph_lo, hi = args.ph_hi;
    volatile LAS unsigned* bst = (volatile LAS unsigned*)(lds + LDS_BYTES - 64);
    if (threadIdx.x < 2) bst[threadIdx.x] = 0u;
    __syncthreads();
    XcdBarrier xbar; xbar.bar = (unsigned*)args.ws; xbar.x = 0; xbar.st = nullptr;
    if (hi - lo > 1) xbar = xcd_barrier_post((unsigned*)args.ws, bst);
#define IN(k) (lo <= (k) && (k) < hi)
#define SEAM(k) do { if (IN((k) + 1)) xcd_barrier(xbar); } while (0)
    if (hi > NPH) cg::this_grid().sync();
    if (IN(0)) { phase_prologue(args, lds); xcd_barrier(xbar); phase_quant(args, lds); SEAM(0); }
    if (IN(1)) { phase_in<0>(args, lds); SEAM(1); }
    if (IN(2)) { phase_mix<0>(args, lds); SEAM(2); }
    if (IN(3)) { phase_br<0>(args, lds); SEAM(3); }
    if (IN(4)) { phase_out<0>(args, lds); SEAM(4); }
    if (IN(5)) { phase_row<0>(args); SEAM(5); }
    if (IN(6)) { phase_in<1>(args, lds); SEAM(6); }
    if (IN(7)) { phase_mix<1>(args, lds); SEAM(7); }
    if (IN(8)) { phase_br<1>(args, lds); SEAM(8); }
    if (IN(9)) { phase_out<1>(args, lds); SEAM(9); }
    if (IN(10)) { phase_row<1>(args); }
#undef IN
#undef SEAM
}

extern "C" void kernel_launch(void* const* d_in, const int* in_sizes, int n_in, void* d_out, int out_size, void* d_ws, size_t ws_size, hipStream_t stream) {
    static int grid = 0;
    if (grid == 0) {
        if (n_in != 14 || out_size != MT * DM || ws_size < WS_END) { fprintf(stderr, "kernel_launch: unexpected shapes (n_in %d out %d ws %zu)\n", n_in, out_size, ws_size); grid = -1; return; }
        int dev = 0, cus = 0, per_cu = 0;
        hipGetDevice(&dev);
        hipDeviceGetAttribute(&cus, hipDeviceAttributeMultiprocessorCount, dev);
        if (hipFuncSetAttribute((const void*)mk_fwd, hipFuncAttributeMaxDynamicSharedMemorySize, LDS_BYTES) != hipSuccess) { fprintf(stderr, "kernel_launch: hipFuncSetAttribute failed\n"); grid = -1; return; }
        if (hipOccupancyMaxActiveBlocksPerMultiprocessor(&per_cu, (const void*)mk_fwd, 512, LDS_BYTES) != hipSuccess || per_cu < 1) { fprintf(stderr, "kernel_launch: occupancy query says %d\n", per_cu); per_cu = 1; }
        (void)hipGetLastError();
        grid = cus * 1;
    }
    if (grid < 0) return;
    (void)hipMemsetAsync(d_ws, 0, 98304, stream);
    Args a{};
    for (int i = 0; i < 14; ++i) a.in[i] = (const float*)d_in[i];
    a.out = (float*)d_out; a.ws = (unsigned char*)d_ws;
#if MK_N_LAUNCHES == 1
    a.ph_lo = 0; a.ph_hi = NPH;
    void* kargs[] = {&a};
    hipError_t e = hipLaunchCooperativeKernel((const void*)mk_fwd, dim3(grid), dim3(512), kargs, LDS_BYTES, stream);
    if (e != hipSuccess) fprintf(stderr, "cooperative launch failed: %s (grid %d)\n", hipGetErrorString(e), grid);
#else
    for (int p = 0; p < NPH; ++p) { a.ph_lo = p; a.ph_hi = p + 1; hipLaunchKernelGGL(mk_fwd, dim3(grid), dim3(512), LDS_BYTES, stream, a); }
#endif
}
```

```cpp
#include <hip/hip_runtime.h>
#include <hip/hip_cooperative_groups.h>
#include <cstdio>
#include <cstdint>
namespace cg = cooperative_groups;

#define LAS __attribute__((address_space(3)))
typedef unsigned short bf16_t;
typedef short bf16x8 __attribute__((ext_vector_type(8)));
typedef float f32x4 __attribute__((ext_vector_type(4)));
typedef float f32x2 __attribute__((ext_vector_type(2)));
typedef float f32x16 __attribute__((ext_vector_type(16)));
typedef unsigned u32x4 __attribute__((ext_vector_type(4)));
typedef unsigned u32x2 __attribute__((ext_vector_type(2)));
typedef __bf16 bf16x2_t __attribute__((ext_vector_type(2)));
typedef int i32x4 __attribute__((ext_vector_type(4)));

#ifndef MK_N_LAUNCHES
#define MK_N_LAUNCHES 1
#endif

constexpr int MT = 16384;
constexpr int SEQ = 2048;
constexpr int DM = 2048;
constexpr int NIN = 17408;
constexpr int DH = 1024;
constexpr int NREL = 320;
constexpr int PT = MT + 64;
constexpr float LOG2E = 1.4426950408889634f;
constexpr float QSCALE = 0.125f * LOG2E;
constexpr float EPSN = 1e-6f;
constexpr int NBF = 8 * 1024; constexpr int NI8 = NIN - NBF;

constexpr size_t MiB = 1u << 20;
constexpr size_t WS_WIN = 2 * MiB;
constexpr size_t WS_WBR = 138 * MiB;
constexpr size_t WS_WOUT = 162 * MiB;
constexpr size_t WS_H = 178 * MiB;
constexpr size_t WS_SEG = 242 * MiB;
constexpr size_t WS_GATES = 594 * MiB;
constexpr size_t WS_O = 786 * MiB;
constexpr size_t WS_SGUW = 882 * MiB;
constexpr size_t WS_VT = 884 * MiB;
constexpr size_t WS_VCT = 918 * MiB;
constexpr size_t WS_H8 = 952 * MiB;
constexpr size_t WS_W8 = 984 * MiB;
constexpr size_t WS_HS = 1020 * MiB;
constexpr size_t WS_END = 1021 * MiB;
constexpr size_t WS_COLMAX = 16384;
constexpr size_t SEGB = 32 * MiB;
constexpr size_t WS_MERGED16 = WS_SEG + 4 * SEGB;
constexpr size_t WS_Y = WS_SEG + 6 * SEGB;

constexpr int LDS_BYTES = 163840;

__device__ __forceinline__ unsigned pk2(float lo, float hi) { f32x2 v = {lo, hi}; bf16x2_t b = __builtin_convertvector(v, bf16x2_t); return __builtin_bit_cast(unsigned, b); }
__device__ __forceinline__ unsigned q8x4(float a, float b, float c, float d) {
    const int ia = (int)__builtin_rintf(a), ib = (int)__builtin_rintf(b), ic = (int)__builtin_rintf(c), id = (int)__builtin_rintf(d);
    return (unsigned)(ia & 0xff) | ((unsigned)(ib & 0xff) << 8) | ((unsigned)(ic & 0xff) << 16) | ((unsigned)id << 24); }
__device__ __forceinline__ float bflo(unsigned u) { return __uint_as_float(u << 16); }
__device__ __forceinline__ float bfhi(unsigned u) { return __uint_as_float(u & 0xffff0000u); }
__device__ __forceinline__ float fast_sigmoid(float w) { return __builtin_amdgcn_rcpf(1.0f + __builtin_amdgcn_exp2f(-w * LOG2E)); }
__device__ __forceinline__ float wave_sum(float v) {
#pragma unroll
    for (int o = 1; o < 64; o <<= 1) v += __shfl_xor(v, o);
    return v;
}
#define MFMA32(a, b, c) __builtin_amdgcn_mfma_f32_32x32x16_bf16((a), (b), (c), 0, 0, 0)

namespace pg8 {
constexpr int BM = 256, BK = 64, HALF = 128, HTB = HALF * BK * 2, STAGE_BYTES = 8 * HTB, NXCD = 8, WGM = 8;
__device__ __forceinline__ int lds_byte(int r, int c) { const int st = (r >> 4) * 2 + (c >> 5), rr = r & 15, cc = c & 31, ob = rr * 64 + cc * 2; return st * 1024 + (ob ^ (((ob >> 9) & 1) << 5)); }
__device__ __forceinline__ void stage_rc(int b, int& R, int& C) { const int st = b / 1024, sb = b % 1024, swz = sb ^ (((sb >> 9) & 1) << 5); R = (st >> 1) * 16 + swz / 64; C = (st & 1) * 32 + (swz % 64) / 2; }
__device__ __forceinline__ int perm32(int rho) { const int n = rho >> 4, i = rho & 15; return 8 * (i >> 2) + 4 * n + (i & 3); }

struct Unit { int pm, pn, z; };
struct Gemm { const bf16_t* A; const bf16_t* Bt; int M, N, K; size_t zA, zB; };

template <int NZ> struct TileOrder {
    int nM, nN, nwg, G, c, wgm;
    __device__ void init(int M, int N, int G_, int c_, int wgm_ = WGM) { nM = M / BM; nN = N / BM; nwg = nM * nN; G = G_; c = c_; wgm = wgm_; }
    __device__ bool next(int i, Unit& u) const {
        const int ti = i / NZ; u.z = i - ti * NZ;
        const long L = (long)ti * G + c; if (L >= nwg) return false;
        int wgid = (int)L; { const int q = nwg / NXCD, r = nwg % NXCD, xcd = wgid % NXCD, off = wgid / NXCD; wgid = (xcd < r ? xcd * (q + 1) : r * (q + 1) + (xcd - r) * q) + off; }
        const int nig = wgm * nN, gid = wgid / nig, fm = gid * wgm, gsz = (nM - fm) < wgm ? (nM - fm) : wgm;
        u.pm = fm + ((wgid % nig) % gsz); u.pn = (wgid % nig) / gsz; return true;
    }
};


template <int MODE> __device__ __forceinline__ f32x2 act2(f32x2 v, float sc) {
    if constexpr (MODE == 0) return v * sc;
    f32x2 t;
    if constexpr (MODE == 2) { const f32x2 x2 = v * v; t = v * (x2 * (-0.10294325f) + (-2.3022082f)); }
    else t = v * (-LOG2E);
    if constexpr (MODE == 3) { t.x = fminf(t.x, 20.f); t.y = fminf(t.y, 20.f); }
    f32x2 d; d.x = __builtin_amdgcn_exp2f(t.x); d.y = __builtin_amdgcn_exp2f(t.y);
    d = d + 1.0f;
    f32x2 r; r.x = __builtin_amdgcn_rcpf(d.x); r.y = __builtin_amdgcn_rcpf(d.y);
    if constexpr (MODE == 3) return r;
    return v * r;
}
template <int MODE, bool TR, bool I8 = false>
__device__ __forceinline__ void epi_in_tile(const f32x4 (&acc)[2][2][4][2], bf16_t* __restrict__ base, int ldc, int row0, int col0, float sc,
                                            const float* __restrict__ hs = nullptr, const float* __restrict__ cmx = nullptr) {
    f32x4 cs[2][2];
    if constexpr (I8) {
#pragma unroll
        for (int bj = 0; bj < 2; ++bj) { cs[bj][0] = *(const f32x4*)(cmx + bj * HALF) * (1.f / 127.f); cs[bj][1] = *(const f32x4*)(cmx + bj * HALF + 4) * (1.f / 127.f); }
    }
#pragma unroll
    for (int ai = 0; ai < 2; ++ai)
#pragma unroll
        for (int m = 0; m < 4; ++m) {
            const int row = row0 + ai * HALF + m * 16;
            float rs = 1.f; if constexpr (I8) rs = hs[row];
#pragma unroll
            for (int bj = 0; bj < 2; ++bj) {
                f32x4 a0 = acc[ai][bj][m][0], a1 = acc[ai][bj][m][1];
                if constexpr (I8) { const i32x4 i0 = __builtin_bit_cast(i32x4, a0), i1 = __builtin_bit_cast(i32x4, a1);
                    a0 = (f32x4){(float)i0[0], (float)i0[1], (float)i0[2], (float)i0[3]} * rs * cs[bj][0];
                    a1 = (f32x4){(float)i1[0], (float)i1[1], (float)i1[2], (float)i1[3]} * rs * cs[bj][1]; }
                const f32x2 p0 = act2<MODE>((f32x2){a0[0], a0[1]}, sc), p1 = act2<MODE>((f32x2){a0[2], a0[3]}, sc);
                const f32x2 p2 = act2<MODE>((f32x2){a1[0], a1[1]}, sc), p3 = act2<MODE>((f32x2){a1[2], a1[3]}, sc);
                u32x4 w; w.x = pk2(p0.x, p0.y); w.y = pk2(p1.x, p1.y); w.z = pk2(p2.x, p2.y); w.w = pk2(p3.x, p3.y);
                if constexpr (!TR) {
                    *(u32x4*)(base + (size_t)row * ldc + col0 + bj * HALF) = w;
                } else {
                    bf16_t* tp = base + (size_t)(col0 + bj * HALF) * PT + row;
                    tp[0 * (size_t)PT] = (bf16_t)(w.x & 0xffffu); tp[1 * (size_t)PT] = (bf16_t)(w.x >> 16);
                    tp[2 * (size_t)PT] = (bf16_t)(w.y & 0xffffu); tp[3 * (size_t)PT] = (bf16_t)(w.y >> 16);
                    tp[4 * (size_t)PT] = (bf16_t)(w.z & 0xffffu); tp[5 * (size_t)PT] = (bf16_t)(w.z >> 16);
                    tp[6 * (size_t)PT] = (bf16_t)(w.w & 0xffffu); tp[7 * (size_t)PT] = (bf16_t)(w.w >> 16);
                }
            }
        }
}
struct EpiIn {
    static constexpr bool PERM = true;
    unsigned char* seg;
    bf16_t* gates;
    bf16_t* vt; bf16_t* vct;
    __device__ __forceinline__ bool reset(const Unit&) const { return true; }
    __device__ __forceinline__ void operator()(const f32x4 (&acc)[2][2][4][2], const Unit& u, int wr, int wc, int fr, int fq) const {
        const int colt = u.pn * BM;
        const int row0 = u.pm * BM + wr * 64 + fr;
        const int lc = wc * 32 + 8 * fq;
        const int s = colt >> 10; const int col0 = (colt & 1023) + lc;
        bf16_t* base = (bf16_t*)(seg + (size_t)s * SEGB);
        if (s == 3 || s == 7) epi_in_tile<1, false>(acc, base, DH, row0, col0, 1.f);
        else if (s == 2) epi_in_tile<0, true>(acc, vt, 0, row0, col0, 1.f);
        else epi_in_tile<0, false>(acc, base, DH, row0, col0, s == 0 ? QSCALE : 1.f);
    }
};

struct EpiIn8 {
    static constexpr bool PERM = true;
    unsigned char* seg; bf16_t* gates; bf16_t* vct; const float* hs; const float* colmax;
    __device__ __forceinline__ bool reset(const Unit&) const { return true; }
    __device__ __forceinline__ void operator()(const f32x4 (&acc)[2][2][4][2], const Unit& u, int wr, int wc, int fr, int fq) const {
        const int colt = NBF + u.pn * BM;
        const int row0 = u.pm * BM + wr * 64 + fr;
        const int lc = wc * 32 + 8 * fq;
        const float* cmx = colmax + u.pn * BM + lc;
        if (colt >= 11 * DH) { epi_in_tile<3, false, true>(acc, gates, 3 * DM, row0, colt - 11 * DH + lc, 1.f, hs, cmx); return; }
        const int s = colt >> 10; const int col0 = (colt & 1023) + lc;
        bf16_t* base = (bf16_t*)(seg + (size_t)s * SEGB);
        if (s == 10) epi_in_tile<1, false, true>(acc, base, DH, row0, col0, 1.f, hs, cmx);
        else if (s == 9) epi_in_tile<2, true, true>(acc, vct, 0, row0, col0, 1.f, hs, cmx);
        else epi_in_tile<2, false, true>(acc, base, DH, row0, col0, 1.f, hs, cmx);
    }
};

struct EpiPlain {
    static constexpr bool PERM = true;
    bf16_t* O; int ldc;
    __device__ __forceinline__ bool reset(const Unit&) const { return true; }
    __device__ __forceinline__ void operator()(const f32x4 (&acc)[2][2][4][2], const Unit& u, int wr, int wc, int fr, int fq) const {
        const int row0 = u.pm * BM + wr * 64 + fr, col0 = u.pn * BM + wc * 32 + 8 * fq;
#pragma unroll
        for (int ai = 0; ai < 2; ++ai)
#pragma unroll
            for (int m = 0; m < 4; ++m) { bf16_t* rowp = O + (size_t)(row0 + ai * HALF + m * 16) * ldc + col0;
#pragma unroll
                for (int bj = 0; bj < 2; ++bj) { const f32x4 v0 = acc[ai][bj][m][0], v1 = acc[ai][bj][m][1];
                    u32x4 w; w.x = pk2(v0[0], v0[1]); w.y = pk2(v0[2], v0[3]); w.z = pk2(v1[0], v1[1]); w.w = pk2(v1[2], v1[3]);
                    *(u32x4*)(rowp + bj * HALF) = w; } }
    }
};

struct EpiMerge {
    static constexpr bool PERM = true;
    const bf16_t* __restrict__ gates; bf16_t* __restrict__ out;
    __device__ __forceinline__ bool reset(const Unit& u) const { return u.z == 2; }
    __device__ __forceinline__ void operator()(f32x4 (&acc)[2][2][4][2], const Unit& u, int wr, int wc, int fr, int fq) const {
        const int row0 = u.pm * BM + wr * 64 + fr, col0 = u.pn * BM + wc * 32 + 8 * fq;
        const int z = u.z;
        const bf16_t* gz = gates + (size_t)row0 * (3 * DM) + z * DM + col0;
        if (z < 2) {
#pragma unroll
            for (int ai = 0; ai < 2; ++ai) {
                u32x4 gn[4][2], gd[4][2];
#pragma unroll
                for (int m = 0; m < 4; ++m)
#pragma unroll
                    for (int bj = 0; bj < 2; ++bj) { const bf16_t* p = gz + (size_t)(ai * HALF + m * 16) * (3 * DM) + bj * HALF; gn[m][bj] = *(const u32x4*)p; gd[m][bj] = *(const u32x4*)(p + DM); }
#pragma unroll
                for (int m = 0; m < 4; ++m)
#pragma unroll
                    for (int bj = 0; bj < 2; ++bj) {
                        const u32x4 a = gn[m][bj], d = gd[m][bj];
                        f32x4& v0 = acc[ai][bj][m][0]; f32x4& v1 = acc[ai][bj][m][1];
                        v0[0] *= bflo(a.x) * __builtin_amdgcn_rcpf(bflo(d.x)); v0[1] *= bfhi(a.x) * __builtin_amdgcn_rcpf(bfhi(d.x));
                        v0[2] *= bflo(a.y) * __builtin_amdgcn_rcpf(bflo(d.y)); v0[3] *= bfhi(a.y) * __builtin_amdgcn_rcpf(bfhi(d.y));
                        v1[0] *= bflo(a.z) * __builtin_amdgcn_rcpf(bflo(d.z)); v1[1] *= bfhi(a.z) * __builtin_amdgcn_rcpf(bfhi(d.z));
                        v1[2] *= bflo(a.w) * __builtin_amdgcn_rcpf(bflo(d.w)); v1[3] *= bfhi(a.w) * __builtin_amdgcn_rcpf(bfhi(d.w));
                    }
            }
        } else {
#pragma unroll
            for (int ai = 0; ai < 2; ++ai) {
                u32x4 gn[4][2];
#pragma unroll
                for (int m = 0; m < 4; ++m)
#pragma unroll
                    for (int bj = 0; bj < 2; ++bj) gn[m][bj] = *(const u32x4*)(gz + (size_t)(ai * HALF + m * 16) * (3 * DM) + bj * HALF);
#pragma unroll
                for (int m = 0; m < 4; ++m)
#pragma unroll
                    for (int bj = 0; bj < 2; ++bj) {
                        const u32x4 a = gn[m][bj];
                        const f32x4 v0 = acc[ai][bj][m][0], v1 = acc[ai][bj][m][1];
                        u32x4 w; w.x = pk2(v0[0] * bflo(a.x), v0[1] * bfhi(a.x)); w.y = pk2(v0[2] * bflo(a.y), v0[3] * bfhi(a.y));
                        w.z = pk2(v1[0] * bflo(a.z), v1[1] * bfhi(a.z)); w.w = pk2(v1[2] * bflo(a.w), v1[3] * bfhi(a.w));
                        *(u32x4*)(out + (size_t)(row0 + ai * HALF + m * 16) * DM + col0 + bj * HALF) = w;
                    }
            }
        }
    }
};

template <class Epi, class Sched, bool ALIGN_EPI, bool I8 = false>
__device__ __forceinline__ void gemm_phase(LAS unsigned char* lds, const Gemm g, const Sched& S, const Epi& E) {
    const int tid = threadIdx.x, wid = __builtin_amdgcn_readfirstlane(tid >> 6), lane = tid & 63, wr = wid >> 2, wc = wid & 3, fr = lane & 15, fq = lane >> 4;
    const int K = g.K, nt = K / BK;
    unsigned voffA[2], voffB[2];
#pragma unroll
    for (int i = 0; i < 2; ++i) { int R, C; stage_rc(tid * 16 + i * 8192, R, C); const int Rb = Epi::PERM ? ((R & ~31) + perm32(R & 31)) : R;
        voffA[i] = (unsigned)(R * K + C) * 2u; voffB[i] = (unsigned)(Rb * K + C) * 2u; }
    const size_t kstep = (size_t)(BK * 2);
    const size_t hstep = (size_t)HALF * K * 2;
    const size_t tstep = 2 * hstep;
    const unsigned ldsw = (unsigned)wid * 1024u;
    const int aoff = lds_byte(wr * 64 + fr, fq * 8), boff = lds_byte(wc * 32 + fr, fq * 8);
#define PG8_SA(b, h) (((b) * 2 + (h)) * HTB)
#define PG8_SB(b, h) ((4 + (b) * 2 + (h)) * HTB)
#define PG8_STAGE(bufoff, gbase, voff) do { _Pragma("unroll") for (int _i = 0; _i < 2; ++_i) \
        __builtin_amdgcn_global_load_lds((const unsigned*)((const char*)(gbase) + (voff)[_i]), (LAS unsigned*)(lds + (bufoff) + ldsw + _i * 8192), 16, 0, 0); } while (0)
#define PG8_LDA(dst, b, h) do { _Pragma("unroll") for (int m = 0; m < 4; ++m) _Pragma("unroll") for (int k = 0; k < 2; ++k) dst[m][k] = *(const LAS bf16x8*)(lds + PG8_SA(b, h) + aoff + m * 2048 + k * 1024); } while (0)
#define PG8_LDB(dst, b, h) do { _Pragma("unroll") for (int n = 0; n < 2; ++n) _Pragma("unroll") for (int k = 0; k < 2; ++k) dst[n][k] = *(const LAS bf16x8*)(lds + PG8_SB(b, h) + boff + n * 2048 + k * 1024); } while (0)
#define PG8_MMA(ai, bj, At, Bt) do { __builtin_amdgcn_s_setprio(1); _Pragma("unroll") for (int m = 0; m < 4; ++m) _Pragma("unroll") for (int n = 0; n < 2; ++n) _Pragma("unroll") for (int k = 0; k < 2; ++k) { \
        if constexpr (I8) acc[ai][bj][m][n] = __builtin_bit_cast(f32x4, __builtin_amdgcn_mfma_i32_16x16x64_i8(__builtin_bit_cast(i32x4, Bt[n][k]), __builtin_bit_cast(i32x4, At[m][k]), __builtin_bit_cast(i32x4, acc[ai][bj][m][n]), 0, 0, 0)); \
        else acc[ai][bj][m][n] = __builtin_amdgcn_mfma_f32_16x16x32_bf16(Bt[n][k], At[m][k], acc[ai][bj][m][n], 0, 0, 0); } __builtin_amdgcn_s_setprio(0); } while (0)
#define PG8_WAIT_V(n) asm volatile("s_waitcnt vmcnt(" #n ")" ::: "memory")
#define PG8_WAIT_L(n) asm volatile("s_waitcnt lgkmcnt(" #n ")" ::: "memory")
#define PG8_BAR __builtin_amdgcn_s_barrier()
#define PG8_SCHED __builtin_amdgcn_sched_barrier(0)
    Unit cur, nxt; int ui = 0;
    if (!S.next(0, cur)) return;
    f32x4 acc[2][2][4][2];
#pragma unroll
    for (int a = 0; a < 2; ++a)
#pragma unroll
        for (int b = 0; b < 2; ++b)
#pragma unroll
            for (int m = 0; m < 4; ++m)
#pragma unroll
                for (int n = 0; n < 2; ++n) acc[a][b][m][n] = (f32x4){0.f, 0.f, 0.f, 0.f};
    bf16x8 At[4][2], B0[2][2], B1[2][2];
    const char* cA = (const char*)g.A + (size_t)cur.z * g.zA + (size_t)cur.pm * tstep; const char* cB = (const char*)g.Bt + (size_t)cur.z * g.zB + (size_t)cur.pn * tstep;
    PG8_STAGE(PG8_SB(0, 0), cB, voffB); PG8_STAGE(PG8_SB(0, 1), cB + hstep, voffB); PG8_STAGE(PG8_SA(0, 0), cA, voffA); PG8_STAGE(PG8_SA(0, 1), cA + hstep, voffA);
    if (wr == 1) PG8_BAR;
    PG8_WAIT_V(2); PG8_BAR;
    PG8_STAGE(PG8_SB(1, 0), cB + kstep, voffB); PG8_STAGE(PG8_SA(1, 0), cA + kstep, voffA); PG8_STAGE(PG8_SB(1, 1), cB + hstep + kstep, voffB);
    PG8_WAIT_V(6); PG8_BAR;
    for (;;) {
        const bool has_next = S.next(ui + 1, nxt);
        const char* nA = has_next ? (const char*)g.A + (size_t)nxt.z * g.zA + (size_t)nxt.pm * tstep : cA;
        const char* nB = has_next ? (const char*)g.Bt + (size_t)nxt.z * g.zB + (size_t)nxt.pn * tstep : cB;
        for (int t = 0; t < nt; t += 2) {
            const bool last = (t == nt - 2);
            const char* a1 = cA + (size_t)(t + 1) * kstep;
            const char* a2 = last ? nA : cA + (size_t)(t + 2) * kstep; const char* b2 = last ? nB : cB + (size_t)(t + 2) * kstep;
            const char* a3 = a2 + kstep; const char* b3 = b2 + kstep;
            PG8_LDB(B0, 0, 0); PG8_LDB(B1, 0, 1); PG8_SCHED; PG8_LDA(At, 0, 0); PG8_STAGE(PG8_SA(1, 1), a1 + hstep, voffA);
            PG8_WAIT_V(8); PG8_WAIT_L(0); PG8_BAR; PG8_MMA(0, 0, At, B0); PG8_MMA(0, 1, At, B1); PG8_BAR; PG8_SCHED;
            PG8_LDA(At, 0, 1); PG8_STAGE(PG8_SB(0, 0), b2, voffB); PG8_STAGE(PG8_SB(0, 1), b2 + hstep, voffB); PG8_STAGE(PG8_SA(0, 0), a2, voffA);
            PG8_WAIT_V(8); PG8_WAIT_L(0); PG8_BAR; PG8_MMA(1, 0, At, B0); PG8_MMA(1, 1, At, B1); PG8_BAR; PG8_SCHED;
            PG8_LDB(B0, 1, 0); PG8_LDB(B1, 1, 1); PG8_SCHED; PG8_LDA(At, 1, 0); PG8_STAGE(PG8_SA(0, 1), a2 + hstep, voffA);
            PG8_WAIT_V(8); PG8_WAIT_L(0); PG8_BAR; PG8_MMA(0, 0, At, B0); PG8_MMA(0, 1, At, B1); PG8_BAR; PG8_SCHED;
            PG8_LDA(At, 1, 1); PG8_STAGE(PG8_SB(1, 0), b3, voffB); PG8_STAGE(PG8_SB(1, 1), b3 + hstep, voffB); PG8_STAGE(PG8_SA(1, 0), a3, voffA);
            PG8_WAIT_V(8); PG8_WAIT_L(0); PG8_BAR; PG8_MMA(1, 0, At, B0); PG8_MMA(1, 1, At, B1); PG8_BAR; PG8_SCHED;
        }
        if constexpr (ALIGN_EPI) { if (wr == 0) PG8_BAR; }
        E(acc, cur, wr, wc, fr, fq);
        if (!has_next) break;
        if (E.reset(cur)) {
#pragma unroll
        for (int a = 0; a < 2; ++a)
#pragma unroll
            for (int b = 0; b < 2; ++b)
#pragma unroll
                for (int m = 0; m < 4; ++m)
#pragma unroll
                    for (int n = 0; n < 2; ++n) acc[a][b][m][n] = (f32x4){0.f, 0.f, 0.f, 0.f};
        }
        cur = nxt; cA = nA; cB = nB; ++ui;
        if constexpr (ALIGN_EPI) { if (wr == 1) PG8_BAR; }
    }
    PG8_WAIT_V(0);
    if constexpr (!ALIGN_EPI) { if (wr == 0) PG8_BAR; }
    PG8_BAR;
#undef PG8_SA
#undef PG8_SB
#undef PG8_STAGE
#undef PG8_LDA
#undef PG8_LDB
#undef PG8_MMA
#undef PG8_WAIT_V
#undef PG8_WAIT_L
#undef PG8_BAR
#undef PG8_SCHED
}
}

#define GAS __attribute__((address_space(1)))
#define RLX_AGENT __ATOMIC_RELAXED, __HIP_MEMORY_SCOPE_AGENT
#define XB_TMO      128
#define XB_XCNT(j)  (256  + 64 * (j))
#define XB_XSUB(j)  (1280 + 64 * (j))
#define XB_XGEN(j)  (2304 + 64 * (j))
#define XB_TOP      3328
#define XB_TOPGEN   3392
#define XCD_BAR_WORDS 3456
#define XB_SPIN_CAP (1u << 18)

__device__ __forceinline__ unsigned xb_ld(unsigned* p)              { return __hip_atomic_load(p, __ATOMIC_RELAXED, __HIP_MEMORY_SCOPE_AGENT); }
__device__ __forceinline__ unsigned xb_add(unsigned* p, unsigned v) { return __hip_atomic_fetch_add(p, v, __ATOMIC_RELAXED, __HIP_MEMORY_SCOPE_AGENT); }
__device__ __forceinline__ unsigned xb_xcc_id() { return (unsigned)__builtin_amdgcn_s_getreg((3 << 11) | 20) & 0xFu; }
#define XB_SPIN(cond, bar) do { unsigned _sp = 0; while (cond) { __builtin_amdgcn_s_sleep(1); \
    if ((++_sp & 255u) == 0u) { if (xb_ld(&(bar)[XB_TMO])) break; if (_sp > XB_SPIN_CAP) { atomicAdd(&(bar)[XB_TMO], 1u); break; } } } } while (0)

struct XcdBarrier {
    unsigned* bar; unsigned x;
    volatile LAS unsigned* st;
};

__device__ __forceinline__ XcdBarrier xcd_barrier_post(unsigned* bar, volatile LAS unsigned* st) {
    XcdBarrier b; b.bar = bar; b.x = xb_xcc_id(); b.st = st;
    if (threadIdx.x == 0) (void)xb_add(&bar[XB_XCNT(b.x)], 1u);
    return b;
}
__device__ __forceinline__ void xcd_barrier_complete(unsigned* bar, unsigned x, unsigned& nloc, unsigned& nx) {
    const unsigned G = gridDim.x * gridDim.y * gridDim.z;
    unsigned sum, cnt, mine, sp = 0u;
    for (;;) {
        sum = 0u; cnt = 0u; mine = 0u;
#pragma unroll
        for (unsigned j = 0; j < 16; ++j) { const unsigned c = xb_ld(&bar[XB_XCNT(j)]); sum += c; cnt += (c > 0u) ? 1u : 0u; mine = (j == x) ? c : mine; }
        if (sum == G) break;
        __builtin_amdgcn_s_sleep(1);
        if ((++sp & 255u) == 0u) { if (xb_ld(&bar[XB_TMO])) break; if (sp > XB_SPIN_CAP) { atomicAdd(&bar[XB_TMO], 1u); break; } }
    }
    nloc = mine > 0u ? mine : 1u; nx = cnt > 0u ? cnt : 1u;
}

__device__ __forceinline__ void xcd_barrier(const XcdBarrier& b) {
    asm volatile("s_waitcnt vmcnt(0)" ::: "memory");
    __syncthreads();
    if (threadIdx.x == 0) {
        unsigned* bar = b.bar;
        __builtin_amdgcn_s_waitcnt(0);
        unsigned nloc = b.st[0], nx = b.st[1];
        if (nloc == 0u) { xcd_barrier_complete(bar, b.x, nloc, nx); b.st[0] = nloc; b.st[1] = nx; }
        const unsigned old = xb_add(&bar[XB_XSUB(b.x)], 1u);
        const unsigned gen = old / nloc;
        if (old + 1u == (gen + 1u) * nloc) {
            __builtin_amdgcn_fence(__ATOMIC_RELEASE, "agent");
            asm volatile("s_waitcnt vmcnt(0)" ::: "memory");
            const unsigned og = xb_add(&bar[XB_TOP], 1u);
            const unsigned tg = og / nx;
            if (og + 1u == (tg + 1u) * nx) xb_add(&bar[XB_TOPGEN], 1u);
            else XB_SPIN(xb_ld(&bar[XB_TOPGEN]) == tg, bar);
            __builtin_amdgcn_fence(__ATOMIC_ACQUIRE, "agent");
            xb_add(&bar[XB_XGEN(b.x)], 1u);
            asm volatile("s_waitcnt vmcnt(0)" ::: "memory");
        } else {
            XB_SPIN(xb_ld(&bar[XB_XGEN(b.x)]) == gen, bar);
            __builtin_amdgcn_fence(__ATOMIC_ACQUIRE, "agent");
            asm volatile("s_waitcnt vmcnt(0)" ::: "memory");
        }
    }
    __syncthreads();
}

__device__ __forceinline__ void transpose_item(const float* __restrict__ W, int K, int N, bf16_t* __restrict__ WT, LAS float* scr, int kb, int nb, int lane) {
    const int k0 = 64 * kb, n0 = 32 * nb;
    float tv[32];
#pragma unroll
    for (int i = 0; i < 32; ++i) { const int kk = 2 * i + (lane >> 5); tv[i] = W[(size_t)(k0 + kk) * N + n0 + (lane & 31)]; }
#pragma unroll
    for (int i = 0; i < 32; ++i) { const int kk = 2 * i + (lane >> 5); scr[kk * 33 + (lane & 31)] = tv[i]; }
    asm volatile("s_waitcnt lgkmcnt(0)" ::: "memory");
    const int c = lane & 7;
#pragma unroll
    for (int j = 0; j < 4; ++j) { const int n = (lane >> 3) + 8 * j; const LAS float* s = scr + (8 * c) * 33 + n;
        u32x4 o; o.x = pk2(s[0 * 33], s[1 * 33]); o.y = pk2(s[2 * 33], s[3 * 33]); o.z = pk2(s[4 * 33], s[5 * 33]); o.w = pk2(s[6 * 33], s[7 * 33]);
        *(u32x4*)(WT + (size_t)(n0 + n) * K + k0 + 8 * c) = o; }
    asm volatile("s_waitcnt lgkmcnt(0)" ::: "memory");
}

__device__ __forceinline__ void quant_cols_unit(const float* __restrict__ W, unsigned char* __restrict__ W8, float* __restrict__ colmax, int cb, LAS unsigned char* lds, int tid) {
    const int lane = tid & 63, w = __builtin_amdgcn_readfirstlane(tid >> 6);
    const int n0 = NBF + 32 * cb;
    LAS float* scr = (LAS float*)(lds + w * 16384);
    LAS float* pm = (LAS float*)(lds + 131072);
    float tv[4][32];
#pragma unroll
    for (int q = 0; q < 4; ++q) { const int k0 = 64 * (w + 8 * q);
#pragma unroll
        for (int i = 0; i < 32; ++i) { const int kk = 2 * i + (lane >> 5); tv[q][i] = W[(size_t)(k0 + kk) * NIN + n0 + (lane & 31)]; } }
    float mx = 0.f;
#pragma unroll
    for (int q = 0; q < 4; ++q)
#pragma unroll
        for (int i = 0; i < 32; ++i) mx = fmaxf(mx, fabsf(tv[q][i]));
    mx = fmaxf(mx, __shfl_xor(mx, 32));
    if (lane < 32) pm[w * 32 + lane] = mx;
    __syncthreads();
    float cm = 0.f;
#pragma unroll
    for (int ww = 0; ww < 8; ++ww) cm = fmaxf(cm, pm[ww * 32 + (lane & 31)]);
    if (w == 0 && lane < 32) colmax[n0 - NBF + lane] = cm;
    const float qs = 127.f / fmaxf(cm, 1e-30f);
    const int n = lane >> 1, kh = (lane & 1) * 32;
#pragma unroll
    for (int q = 0; q < 4; ++q) { const int k0 = 64 * (w + 8 * q);
#pragma unroll
        for (int i = 0; i < 32; ++i) { const int kk = 2 * i + (lane >> 5); scr[kk * 33 + (lane & 31)] = tv[q][i] * qs; }
        asm volatile("s_waitcnt lgkmcnt(0)" ::: "memory");
        const LAS float* s = scr + kh * 33 + n;
        u32x4 o0, o1;
        o0.x = q8x4(s[0 * 33], s[1 * 33], s[2 * 33], s[3 * 33]);     o0.y = q8x4(s[4 * 33], s[5 * 33], s[6 * 33], s[7 * 33]);
        o0.z = q8x4(s[8 * 33], s[9 * 33], s[10 * 33], s[11 * 33]);   o0.w = q8x4(s[12 * 33], s[13 * 33], s[14 * 33], s[15 * 33]);
        o1.x = q8x4(s[16 * 33], s[17 * 33], s[18 * 33], s[19 * 33]); o1.y = q8x4(s[20 * 33], s[21 * 33], s[22 * 33], s[23 * 33]);
        o1.z = q8x4(s[24 * 33], s[25 * 33], s[26 * 33], s[27 * 33]); o1.w = q8x4(s[28 * 33], s[29 * 33], s[30 * 33], s[31 * 33]);
        unsigned char* dst = W8 + (size_t)(n0 - NBF + n) * DM + k0 + kh;
        *(u32x4*)dst = o0; *(u32x4*)(dst + 16) = o1;
        asm volatile("s_waitcnt lgkmcnt(0)" ::: "memory");
    }
    __syncthreads();
}

template <bool HAS_Y, bool WRITE_H>
__device__ __forceinline__ void row_pass(const float* __restrict__ xin, const bf16_t* __restrict__ Y, const float* __restrict__ post_g, float* xout,
                                         const float* __restrict__ pre_g, bf16_t* __restrict__ H, unsigned char* __restrict__ H8, float* __restrict__ HS, int gw, int NGW, int lane) {
    for (int row = gw; row < MT; row += NGW) {
        float xv[4][8];
#pragma unroll
        for (int j = 0; j < 4; ++j) { const int col = (j * 64 + lane) * 8; const f32x4 a = *(const f32x4*)(xin + (size_t)row * DM + col), b = *(const f32x4*)(xin + (size_t)row * DM + col + 4);
#pragma unroll
            for (int e = 0; e < 4; ++e) { xv[j][e] = a[e]; xv[j][4 + e] = b[e]; } }
        if constexpr (HAS_Y) {
            float yv[4][8]; float ss = 0.f;
#pragma unroll
            for (int j = 0; j < 4; ++j) { const int col = (j * 64 + lane) * 8; const u32x4 w = *(const u32x4*)(Y + (size_t)row * DM + col);
                yv[j][0] = bflo(w.x); yv[j][1] = bfhi(w.x); yv[j][2] = bflo(w.y); yv[j][3] = bfhi(w.y); yv[j][4] = bflo(w.z); yv[j][5] = bfhi(w.z); yv[j][6] = bflo(w.w); yv[j][7] = bfhi(w.w);
#pragma unroll
                for (int e = 0; e < 8; ++e) ss += yv[j][e] * yv[j][e]; }
            const float r = 1.0f / sqrtf(wave_sum(ss) * (1.0f / DM) + EPSN);
#pragma unroll
            for (int j = 0; j < 4; ++j) { const int col = (j * 64 + lane) * 8; const f32x4 ga = *(const f32x4*)(post_g + col), gb = *(const f32x4*)(post_g + col + 4);
#pragma unroll
                for (int e = 0; e < 4; ++e) { xv[j][e] += yv[j][e] * r * ga[e]; xv[j][4 + e] += yv[j][4 + e] * r * gb[e]; }
                *(f32x4*)(xout + (size_t)row * DM + col) = (f32x4){xv[j][0], xv[j][1], xv[j][2], xv[j][3]};
                *(f32x4*)(xout + (size_t)row * DM + col + 4) = (f32x4){xv[j][4], xv[j][5], xv[j][6], xv[j][7]}; }
        }
        if constexpr (WRITE_H) {
            float ss = 0.f;
#pragma unroll
            for (int j = 0; j < 4; ++j)
#pragma unroll
                for (int e = 0; e < 8; ++e) ss += xv[j][e] * xv[j][e];
            const float r = 1.0f / sqrtf(wave_sum(ss) * (1.0f / DM) + EPSN);
            float amax = 0.f;
#pragma unroll
            for (int j = 0; j < 4; ++j) { const int col = (j * 64 + lane) * 8; const f32x4 ga = *(const f32x4*)(pre_g + col), gb = *(const f32x4*)(pre_g + col + 4);
#pragma unroll
                for (int e = 0; e < 4; ++e) { xv[j][e] *= r * ga[e]; xv[j][4 + e] *= r * gb[e]; amax = fmaxf(amax, fmaxf(fabsf(xv[j][e]), fabsf(xv[j][4 + e]))); }
                u32x4 w; w.x = pk2(xv[j][0], xv[j][1]); w.y = pk2(xv[j][2], xv[j][3]); w.z = pk2(xv[j][4], xv[j][5]); w.w = pk2(xv[j][6], xv[j][7]);
                *(u32x4*)(H + (size_t)row * DM + col) = w; }
#pragma unroll
            for (int o = 1; o < 64; o <<= 1) amax = fmaxf(amax, __shfl_xor(amax, o));
            amax = fmaxf(amax, 1e-20f);
            const float qs = 127.f / amax;
            if (lane == 0) HS[row] = amax * (1.f / 127.f);
#pragma unroll
            for (int j = 0; j < 4; ++j) { const int col = (j * 64 + lane) * 8;
                u32x2 w8; w8.x = q8x4(xv[j][0] * qs, xv[j][1] * qs, xv[j][2] * qs, xv[j][3] * qs); w8.y = q8x4(xv[j][4] * qs, xv[j][5] * qs, xv[j][6] * qs, xv[j][7] * qs);
                *(u32x2*)(H8 + (size_t)row * DM + col) = w8; }
        }
    }
}

constexpr int ATP = 144;
constexpr int ATT_WAVE_LDS = 2 * 64 * ATP;
#define ATT_BAR() asm volatile("s_waitcnt lgkmcnt(0)\n\ts_barrier" ::: "memory")
__device__ __forceinline__ void attn_item(const bf16_t* __restrict__ Q, const bf16_t* __restrict__ Kb, const bf16_t* __restrict__ VT, const bf16_t* __restrict__ GA,
                                          bf16_t* __restrict__ OA, const LAS float* btab, LAS unsigned char* pl  , int b, int c, int h, int half, int lane) {
    const int r = lane & 31, hh = lane >> 5;
    const int rl = lane >> 3, cl = lane & 7;
    const int tokq = b * SEQ + c * 64 + half * 32;
    const int qloc = half * 32 + r;
    const int pr = (r & ~12) | ((r & 4) << 1) | ((r & 8) >> 1);
    const int jmin = c >= 8 ? 0 : 8 - c;
    const int tk0 = b * SEQ + (c - 8 + jmin) * 64;
    const bf16_t* tg = half ? VT + (size_t)(h * 64 + rl) * PT + tk0 + cl * 8 : Kb + (size_t)(tk0 + rl) * DH + h * 64 + cl * 8;
    const size_t rstep = half ? (size_t)8 * PT : (size_t)8 * DH;
    const size_t tstep = half ? (size_t)64 : (size_t)64 * DH;
    const int stoff = (half ? 64 * ATP : 0) + rl * ATP + cl * 16;
    u32x4 tr[8];
#pragma unroll
    for (int i = 0; i < 8; ++i) tr[i] = *(const u32x4*)(tg + i * rstep);
    bf16x8 qf[4];
    { const bf16_t* qp = Q + (size_t)(tokq + r) * DH + h * 64 + 8 * hh;
#pragma unroll
      for (int d0 = 0; d0 < 4; ++d0) qf[d0] = *(const bf16x8*)(qp + d0 * 16); }
    int buf = 0;
#pragma unroll
    for (int i = 0; i < 8; ++i) *(LAS u32x4*)(pl + stoff + 8 * i * ATP) = tr[i];
    tg += (jmin + 1 <= 8) ? tstep : (size_t)0;
#pragma unroll
    for (int i = 0; i < 8; ++i) tr[i] = *(const u32x4*)(tg + i * rstep);
    ATT_BAR();
    f32x16 o0, o1, cinit;
#pragma unroll
    for (int i = 0; i < 16; ++i) { o0[i] = 0.f; o1[i] = 0.f; }
    constexpr float ATT_THR = 8.f;
    float mref = 0.f, lrun = 0.f;
    const float cfar = btab[NREL - 1];
#pragma unroll
    for (int i = 0; i < 16; ++i) cinit[i] = cfar;
    for (int j = jmin; j <= 8; ++j) {
        const LAS unsigned char* kfp = pl + buf * ATT_WAVE_LDS + pr * ATP + 16 * hh;
        const LAS unsigned char* vfp = pl + buf * ATT_WAVE_LDS + 64 * ATP + r * ATP + 16 * hh;
        f32x16 s0, s1;
        if (j <= 3) {
            const bf16x8 k0 = *(const LAS bf16x8*)(kfp), k1 = *(const LAS bf16x8*)(kfp + 32 * ATP);
            s0 = MFMA32(k0, qf[0], cinit); s1 = MFMA32(k1, qf[0], cinit);
        } else {
            const LAS float* bp = btab + (qloc + 64 * (8 - j) + 63 - 8 * hh);
#pragma unroll
            for (int i = 0; i < 16; ++i) {
                const int key = (i & 3) + 4 * ((i >> 2) & 1) + 16 * (i >> 3);
                s0[i] = bp[-key] - mref; s1[i] = bp[-key - 32] - mref;
            }
            const bf16x8 k0 = *(const LAS bf16x8*)(kfp), k1 = *(const LAS bf16x8*)(kfp + 32 * ATP);
            s0 = MFMA32(k0, qf[0], s0); s1 = MFMA32(k1, qf[0], s1);
        }
#pragma unroll
        for (int d0 = 1; d0 < 4; ++d0) {
            const bf16x8 k0 = *(const LAS bf16x8*)(kfp + d0 * 32), k1 = *(const LAS bf16x8*)(kfp + 32 * ATP + d0 * 32);
            s0 = MFMA32(k0, qf[d0], s0); s1 = MFMA32(k1, qf[d0], s1);
        }
        float tmax = fmaxf(s0[0], s1[0]);
#pragma unroll
        for (int i = 1; i < 16; ++i) tmax = fmaxf(tmax, fmaxf(s0[i], s1[i]));
        tmax = fmaxf(tmax, __shfl_xor(tmax, 32));
        if (j == jmin || __any(tmax > ATT_THR)) {
            const float dl = (j == jmin) ? tmax : fmaxf(tmax, 0.f);
            mref += dl;
            const float alpha = (j == jmin) ? 1.f : __builtin_amdgcn_exp2f(-dl);
            lrun *= alpha;
#pragma unroll
            for (int i = 0; i < 16; ++i) { s0[i] -= dl; s1[i] -= dl; o0[i] *= alpha; o1[i] *= alpha; cinit[i] = cfar - mref; }
        }
        float ls = 0.f;
#pragma unroll
        for (int i = 0; i < 16; ++i) { s0[i] = __builtin_amdgcn_exp2f(s0[i]); s1[i] = __builtin_amdgcn_exp2f(s1[i]); ls += s0[i] + s1[i]; }
        lrun += ls;
#pragma unroll
        for (int s = 0; s < 2; ++s) {
            u32x4 pa, pb;
            pa.x = pk2(s0[8 * s + 0], s0[8 * s + 1]); pa.y = pk2(s0[8 * s + 2], s0[8 * s + 3]); pa.z = pk2(s0[8 * s + 4], s0[8 * s + 5]); pa.w = pk2(s0[8 * s + 6], s0[8 * s + 7]);
            pb.x = pk2(s1[8 * s + 0], s1[8 * s + 1]); pb.y = pk2(s1[8 * s + 2], s1[8 * s + 3]); pb.z = pk2(s1[8 * s + 4], s1[8 * s + 5]); pb.w = pk2(s1[8 * s + 6], s1[8 * s + 7]);
            const bf16x8 va0 = *(const LAS bf16x8*)(vfp + 32 * s), va1 = *(const LAS bf16x8*)(vfp + 32 * ATP + 32 * s);
            const bf16x8 vb0 = *(const LAS bf16x8*)(vfp + 64 + 32 * s), vb1 = *(const LAS bf16x8*)(vfp + 32 * ATP + 64 + 32 * s);
            o0 = MFMA32(va0, __builtin_bit_cast(bf16x8, pa), o0); o1 = MFMA32(va1, __builtin_bit_cast(bf16x8, pa), o1);
            o0 = MFMA32(vb0, __builtin_bit_cast(bf16x8, pb), o0); o1 = MFMA32(vb1, __builtin_bit_cast(bf16x8, pb), o1);
        }
        buf ^= 1;
#pragma unroll
        for (int i = 0; i < 8; ++i) *(LAS u32x4*)(pl + buf * ATT_WAVE_LDS + stoff + 8 * i * ATP) = tr[i];
        tg += (j + 2 <= 8) ? tstep : (size_t)0;
#pragma unroll
        for (int i = 0; i < 8; ++i) tr[i] = *(const u32x4*)(tg + i * rstep);
        ATT_BAR();
    }
    const float l = lrun + __shfl_xor(lrun, 32);
    const float inv = 1.0f / l;
    LAS unsigned char* Ot = pl + half * ATT_WAVE_LDS;
#pragma unroll
    for (int g = 0; g < 4; ++g) {
#pragma unroll
        for (int db = 0; db < 2; ++db) {
            const f32x16& o = db ? o1 : o0;
            u32x2 w; w.x = pk2(o[4 * g + 0] * inv, o[4 * g + 1] * inv); w.y = pk2(o[4 * g + 2] * inv, o[4 * g + 3] * inv);
            *(LAS u32x2*)(Ot + r * ATP + (db * 32 + 8 * g + 4 * hh) * 2) = w;
        }
    }
#pragma unroll
    for (int i = 0; i < 4; ++i) {
        const int row = rl + 8 * i;
        const size_t a = (size_t)(tokq + row) * DH + h * 64 + cl * 8;
        const u32x4 gg = *(const u32x4*)(GA + a);
        const u32x4 ov = *(const LAS u32x4*)(Ot + row * ATP + cl * 16);
        u32x4 w; w.x = pk2(bflo(ov.x) * bflo(gg.x), bfhi(ov.x) * bfhi(gg.x)); w.y = pk2(bflo(ov.y) * bflo(gg.y), bfhi(ov.y) * bfhi(gg.y));
        w.z = pk2(bflo(ov.z) * bflo(gg.z), bfhi(ov.z) * bfhi(gg.z)); w.w = pk2(bflo(ov.w) * bflo(gg.w), bfhi(ov.w) * bfhi(gg.w));
        *(u32x4*)(OA + a) = w;
    }
    ATT_BAR();
}
#undef ATT_BAR

__device__ __forceinline__ void unpack8(const u32x4 w, float* v) { v[0] = bflo(w.x); v[1] = bfhi(w.x); v[2] = bflo(w.y); v[3] = bfhi(w.y); v[4] = bflo(w.z); v[5] = bfhi(w.z); v[6] = bflo(w.w); v[7] = bfhi(w.w); }
__device__ __forceinline__ void conv_unit(const bf16_t* __restrict__ BB, const bf16_t* __restrict__ CC, const bf16_t* __restrict__ HB, const bf16_t* __restrict__ GB,
                                          bf16_t* __restrict__ OB, const float* __restrict__ cw, int unit, int tid) {
    const int cgp = tid & 127, sub = tid >> 7, ch = cgp * 8;
    const int t0 = unit * 32 + sub * 8;
    float w0[8], w1[8], w2[8];
#pragma unroll
    for (int e = 0; e < 8; ++e) { w0[e] = cw[ch + e]; w1[e] = cw[DH + ch + e]; w2[e] = cw[2 * DH + ch + e]; }
    float p2[8], p1[8];
#pragma unroll
    for (int e = 0; e < 8; ++e) { p2[e] = 0.f; p1[e] = 0.f; }
    const int tpos = t0 & (SEQ - 1);
    if (tpos >= 2) { float a[8], b[8]; unpack8(*(const u32x4*)(CC + (size_t)(t0 - 2) * DH + ch), a); unpack8(*(const u32x4*)(HB + (size_t)(t0 - 2) * DH + ch), b);
#pragma unroll
        for (int e = 0; e < 8; ++e) p2[e] = a[e] * b[e]; }
    if (tpos >= 1) { float a[8], b[8]; unpack8(*(const u32x4*)(CC + (size_t)(t0 - 1) * DH + ch), a); unpack8(*(const u32x4*)(HB + (size_t)(t0 - 1) * DH + ch), b);
#pragma unroll
        for (int e = 0; e < 8; ++e) p1[e] = a[e] * b[e]; }
#pragma unroll
    for (int i = 0; i < 8; ++i) {
        const size_t off = (size_t)(t0 + i) * DH + ch;
        float a[8], b[8], g1[8], g2[8], o[8];
        unpack8(*(const u32x4*)(CC + off), a); unpack8(*(const u32x4*)(HB + off), b); unpack8(*(const u32x4*)(BB + off), g1); unpack8(*(const u32x4*)(GB + off), g2);
#pragma unroll
        for (int e = 0; e < 8; ++e) { const float cur = a[e] * b[e]; o[e] = g1[e] * (w0[e] * p2[e] + w1[e] * p1[e] + w2[e] * cur) * g2[e]; p2[e] = p1[e]; p1[e] = cur; }
        u32x4 w; w.x = pk2(o[0], o[1]); w.y = pk2(o[2], o[3]); w.z = pk2(o[4], o[5]); w.w = pk2(o[6], o[7]);
        *(u32x4*)(OB + off) = w;
    }
}

template <int tbA, int tbB>
__device__ __forceinline__ void sgu_groups(const bf16_t* __restrict__ VCT, const bf16_t* __restrict__ U, const bf16_t* __restrict__ GC, bf16_t* __restrict__ OC,
                                           const bf16_t* __restrict__ Wbf, const float* __restrict__ spb, const float* __restrict__ lng, const float* __restrict__ lnb,
                                           int tok0, int gh, int cb, int r, int hh, const LAS float* stat, LAS unsigned char* stg, int lane) {
    for (int gi = 0; gi < 4; ++gi) {
        const int g = gh * 4 + gi;
        const int ch = g * 128 + cb * 32 + r;
        const float gg = lng[ch], bb = lnb[ch];
        const bf16_t* ap = VCT + (size_t)ch * PT + tok0 + 8 * hh;
        const bf16_t* wp = Wbf + (size_t)g * 16384 + 8 * hh;
        constexpr int NSB = (tbB + 1) * 2, NSA = (tbA + 1) * 2;
        int so = 0; asm volatile("" : "+v"(so));
        u32x4 raw[NSB]; bf16x8 wB[NSB], wA[NSA];
#pragma unroll
        for (int k = 0; k < NSB; ++k) { raw[k] = *(const u32x4*)(ap + 16 * k); wB[k] = *(const bf16x8*)(wp + (size_t)(tbB * 32 + r) * 128 + 16 * k); }
#pragma unroll
        for (int k = 0; k < NSA; ++k) wA[k] = *(const bf16x8*)(wp + (size_t)(tbA * 32 + r) * 128 + 16 * k);
        f32x16 accA, accB;
#pragma unroll
        for (int i = 0; i < 16; ++i) { accA[i] = 0.f; accB[i] = 0.f; }
#pragma unroll
        for (int k = 0; k < NSB; ++k) {
            float v[8]; unpack8(raw[k], v);
#pragma unroll
            for (int jj = 0; jj < 8; ++jj) { const float mean = stat[(16 * k + 8 * hh + jj) * 2 + so], rstd = stat[(16 * k + 8 * hh + jj) * 2 + 1 + so]; v[jj] = (v[jj] - mean) * rstd * gg + bb; }
            u32x4 af; af.x = pk2(v[0], v[1]); af.y = pk2(v[2], v[3]); af.z = pk2(v[4], v[5]); af.w = pk2(v[6], v[7]);
            accB = MFMA32(__builtin_bit_cast(bf16x8, af), wB[k], accB);
            if (k < NSA) accA = MFMA32(__builtin_bit_cast(bf16x8, af), wA[k < NSA ? k : 0], accA);
        }
#pragma unroll
        for (int which = 0; which < 2; ++which) {
            const int tb = which ? tbB : tbA; const f32x16& acc = which ? accB : accA;
            const float sbv = spb[g * 128 + tb * 32 + r];
#pragma unroll
            for (int q = 0; q < 4; ++q) {
                u32x2 w; w.x = pk2(acc[4 * q + 0] + sbv, acc[4 * q + 1] + sbv); w.y = pk2(acc[4 * q + 2] + sbv, acc[4 * q + 3] + sbv);
                *(LAS u32x2*)(stg + which * 2560 + r * 80 + (8 * q + 4 * hh) * 2) = w;
            }
        }
#pragma unroll
        for (int which = 0; which < 2; ++which) {
            const int tb = which ? tbB : tbA;
#pragma unroll
            for (int i = 0; i < 2; ++i) {
                const int t = (lane >> 2) + 16 * i, ck = lane & 3;
                const size_t a = (size_t)(tok0 + tb * 32 + t) * DH + g * 128 + cb * 32 + ck * 8;
                const u32x4 uu = *(const u32x4*)(U + a), gc = *(const u32x4*)(GC + a);
                const u32x4 mv = *(const LAS u32x4*)(stg + which * 2560 + t * 80 + ck * 16);
                u32x4 o; o.x = pk2(bflo(uu.x) * bflo(mv.x) * bflo(gc.x), bfhi(uu.x) * bfhi(mv.x) * bfhi(gc.x)); o.y = pk2(bflo(uu.y) * bflo(mv.y) * bflo(gc.y), bfhi(uu.y) * bfhi(mv.y) * bfhi(gc.y));
                o.z = pk2(bflo(uu.z) * bflo(mv.z) * bflo(gc.z), bfhi(uu.z) * bfhi(mv.z) * bfhi(gc.z)); o.w = pk2(bflo(uu.w) * bflo(mv.w) * bflo(gc.w), bfhi(uu.w) * bfhi(mv.w) * bfhi(gc.w));
                *(u32x4*)(OC + a) = o;
            }
        }
    }
}

__device__ __forceinline__ void sgu_unit(const bf16_t* __restrict__ VCT, const bf16_t* __restrict__ U, const bf16_t* __restrict__ GC, bf16_t* __restrict__ OC,
                                         const bf16_t* __restrict__ Wbf, const float* __restrict__ spb, const float* __restrict__ lng, const float* __restrict__ lnb,
                                         int b, int n, int gh, LAS unsigned char* lds, int tid) {
    const int lane = tid & 63, w = __builtin_amdgcn_readfirstlane(tid >> 6), r = lane & 31, hh = lane >> 5;
    const int tok0 = b * SEQ + n * 128;
    __syncthreads();
    LAS float* part = (LAS float*)lds;
    LAS float* stat = part + 8 * 128 * 2;
    {
        const int tl = lane & 15, cq = lane >> 4;
        const bf16_t* p = VCT + (size_t)(w * 128 + cq) * PT + tok0 + 8 * tl;
        float sm[8], sq[8];
#pragma unroll
        for (int e = 0; e < 8; ++e) { sm[e] = 0.f; sq[e] = 0.f; }
#pragma unroll 8
        for (int c4 = 0; c4 < 32; ++c4) { float v[8]; unpack8(*(const u32x4*)(p + (size_t)(c4 * 4) * PT), v);
#pragma unroll
            for (int e = 0; e < 8; ++e) { sm[e] += v[e]; sq[e] += v[e] * v[e]; } }
#pragma unroll
        for (int e = 0; e < 8; ++e) { sm[e] += __shfl_xor(sm[e], 16); sm[e] += __shfl_xor(sm[e], 32); sq[e] += __shfl_xor(sq[e], 16); sq[e] += __shfl_xor(sq[e], 32); }
        if (cq == 0) {
#pragma unroll
            for (int e = 0; e < 8; ++e) { part[(w * 128 + 8 * tl + e) * 2 + 0] = sm[e]; part[(w * 128 + 8 * tl + e) * 2 + 1] = sq[e]; }
        }
    }
    __syncthreads();
    if (tid < 128) {
        float S = 0.f, SS = 0.f;
#pragma unroll
        for (int ww = 0; ww < 8; ++ww) { S += part[(ww * 128 + tid) * 2]; SS += part[(ww * 128 + tid) * 2 + 1]; }
        const float mean = S * (1.0f / DH); const float var = fmaxf(SS * (1.0f / DH) - mean * mean, 0.f);
        stat[tid * 2] = mean; stat[tid * 2 + 1] = 1.0f / sqrtf(var + EPSN);
    }
    __syncthreads();
    LAS unsigned char* stg = lds + 16384 + w * 5120;
    if ((w >> 2) == 0) sgu_groups<0, 3>(VCT, U, GC, OC, Wbf, spb, lng, lnb, tok0, gh, w & 3, r, hh, stat, stg, lane);
    else sgu_groups<1, 2>(VCT, U, GC, OC, Wbf, spb, lng, lnb, tok0, gh, w & 3, r, hh, stat, stg, lane);
    __syncthreads();
}

struct Args { const float* in[14]; float* out; unsigned char* ws; int ph_lo, ph_hi; };
constexpr int NPH = 11;

__device__ __forceinline__ void phase_prologue(const Args& args, LAS unsigned char* lds) {
    const int tid = threadIdx.x, lane = tid & 63, wave = __builtin_amdgcn_readfirstlane(tid >> 6);
    const int G = gridDim.x, blk = blockIdx.x, gw = blk * 8 + wave, NGW = G * 8;
    unsigned char* ws = args.ws;
    LAS float* scr = (LAS float*)(lds + wave * 16384);
    for (int cu = blk; cu < 2 * (NI8 / 32); cu += G) { const int l = cu / (NI8 / 32), cb = cu - l * (NI8 / 32);
        quant_cols_unit(args.in[2] + (size_t)l * DM * NIN, ws + WS_W8 + (size_t)l * 18 * MiB, (float*)(ws + WS_COLMAX) + l * NI8, cb, lds, tid); }
    constexpr int I_IN = (DM / 64) * (NBF / 32), I_BR = (DH / 64) * (DM / 32), I_OUT = (DM / 64) * (DM / 32);
    constexpr int PER_L = I_IN + 3 * I_BR + I_OUT;
    for (int it = gw; it < 2 * PER_L; it += NGW) {
        const int l = it / PER_L; int r = it - l * PER_L;
        if (r < I_IN) { transpose_item(args.in[2] + (size_t)l * DM * NIN, DM, NIN, (bf16_t*)(ws + WS_WIN + (size_t)l * 68 * MiB), scr, r / (NBF / 32), r % (NBF / 32), lane); continue; } r -= I_IN;
        if (r < 3 * I_BR) { const int br = r / I_BR; r -= br * I_BR; const float* src = (br == 0 ? args.in[9] : (br == 1 ? args.in[10] : args.in[11])) + (size_t)l * DH * DM;
            transpose_item(src, DH, DM, (bf16_t*)(ws + WS_WBR + (size_t)(l * 3 + br) * 4 * MiB), scr, r / (DM / 32), r % (DM / 32), lane); continue; } r -= 3 * I_BR;
        transpose_item(args.in[12] + (size_t)l * DM * DM, DM, DM, (bf16_t*)(ws + WS_WOUT + (size_t)l * 8 * MiB), scr, r / (DM / 32), r % (DM / 32), lane);
    }
    { bf16_t* wb = (bf16_t*)(ws + WS_SGUW); const float* sp_w = args.in[7];
      for (int e = blk * 512 + tid; e < 2 * 8 * 128 * 128; e += G * 512) { const int t = (e >> 7) & 127, s = e & 127; const unsigned p = pk2(sp_w[e], 0.f); wb[e] = (s <= t) ? (bf16_t)(p & 0xffffu) : (bf16_t)0; } }
    row_pass<false, true>(args.in[0], nullptr, nullptr, nullptr, args.in[1], (bf16_t*)(ws + WS_H), ws + WS_H8, (float*)(ws + WS_HS), gw, NGW, lane);
}

template <int L> __device__ __forceinline__ void phase_in(const Args& args, LAS unsigned char* lds) {
    unsigned char* ws = args.ws;
    {
        pg8::Gemm g{(const bf16_t*)(ws + WS_H), (const bf16_t*)(ws + WS_WIN + (size_t)L * 68 * MiB), MT, NBF, DM, 0, 0};
        pg8::TileOrder<1> S; S.init(MT, NBF, gridDim.x, blockIdx.x);
        pg8::EpiIn E{ws + WS_SEG, (bf16_t*)(ws + WS_GATES), (bf16_t*)(ws + WS_VT), (bf16_t*)(ws + WS_VCT)};
        pg8::gemm_phase<pg8::EpiIn, pg8::TileOrder<1>, true>(lds, g, S, E);
    }
    {
        pg8::Gemm g{(const bf16_t*)(ws + WS_H8), (const bf16_t*)(ws + WS_W8 + (size_t)L * 18 * MiB), MT, NI8, DM / 2, 0, 0};
        pg8::TileOrder<1> S; S.init(MT, NI8, gridDim.x, blockIdx.x);
        pg8::EpiIn8 E{ws + WS_SEG, (bf16_t*)(ws + WS_GATES), (bf16_t*)(ws + WS_VCT), (const float*)(ws + WS_HS), (const float*)(ws + WS_COLMAX) + L * NI8};
        pg8::gemm_phase<pg8::EpiIn8, pg8::TileOrder<1>, true, true>(lds, g, S, E);
    }
}

template <int L> __device__ __forceinline__ void phase_mix(const Args& args, LAS unsigned char* lds) {
    const int tid = threadIdx.x, lane = tid & 63, wave = __builtin_amdgcn_readfirstlane(tid >> 6);
    const int G = gridDim.x, blk = blockIdx.x;
    unsigned char* ws = args.ws;
    const bf16_t* segb = (const bf16_t*)(ws + WS_SEG);
    bf16_t* OA = (bf16_t*)(ws + WS_O);
    constexpr size_t SE = (size_t)MT * DH;
    LAS float* btab = (LAS float*)(lds + 8 * ATT_WAVE_LDS + wave * 1536);
    LAS unsigned char* wl = lds + (wave >> 1) * (2 * ATT_WAVE_LDS);
    int cur_h = -1;
    for (int u = blk; u < 1024 + 512 + 256; u += G) {
        if (u < 1024) {
            const int hg = u & 3, b = (u >> 2) & 7, c = u >> 5;
            const int h = hg * 4 + (wave >> 1), half = wave & 1;
            if (h != cur_h) { const float* rb = args.in[3] + (size_t)(L * 16 + h) * NREL;
#pragma unroll
                for (int i = 0; i < 6; ++i) { const int idx = i * 64 + lane; btab[idx] = rb[idx < NREL ? idx : NREL - 1] * LOG2E; }
                cur_h = h; }
            attn_item(segb, segb + SE, (const bf16_t*)(ws + WS_VT), segb + 3 * SE, OA, btab, wl, b, c, h, half, lane);
        } else if (u < 1536) {
            conv_unit(segb + 4 * SE, segb + 5 * SE, segb + 6 * SE, segb + 7 * SE, OA + SE, args.in[4] + (size_t)L * 3 * DH, u - 1024, tid);
        } else {
            const int su = u - 1536; const int gh = su & 1, n = (su >> 1) & 15, b = su >> 5;
            sgu_unit((const bf16_t*)(ws + WS_VCT), segb + 8 * SE, segb + 10 * SE, OA + 2 * SE, (const bf16_t*)(ws + WS_SGUW) + (size_t)L * 8 * 16384, args.in[8] + (size_t)L * 8 * 128,
                     args.in[5] + (size_t)L * DH, args.in[6] + (size_t)L * DH, b, n, gh, lds, tid);
        }
    }
}

template <int L> __device__ __forceinline__ void phase_br(const Args& args, LAS unsigned char* lds) {
    unsigned char* ws = args.ws;
    pg8::Gemm g{(const bf16_t*)(ws + WS_O), (const bf16_t*)(ws + WS_WBR + (size_t)L * 12 * MiB), MT, DM, DH, (size_t)32 * MiB, (size_t)4 * MiB};
    pg8::TileOrder<3> S; S.init(MT, DM, gridDim.x, blockIdx.x);
    pg8::EpiMerge E{(const bf16_t*)(ws + WS_GATES), (bf16_t*)(ws + WS_MERGED16)};
    pg8::gemm_phase<pg8::EpiMerge, pg8::TileOrder<3>, true>(lds, g, S, E);
}

template <int L> __device__ __forceinline__ void phase_out(const Args& args, LAS unsigned char* lds) {
    unsigned char* ws = args.ws;
    pg8::Gemm g{(const bf16_t*)(ws + WS_MERGED16), (const bf16_t*)(ws + WS_WOUT + (size_t)L * 8 * MiB), MT, DM, DM, 0, 0};
    pg8::TileOrder<1> S; S.init(MT, DM, gridDim.x, blockIdx.x);
    pg8::EpiPlain E{(bf16_t*)(ws + WS_Y), DM};
    pg8::gemm_phase<pg8::EpiPlain, pg8::TileOrder<1>, true>(lds, g, S, E);
}

template <int L> __device__ __forceinline__ void phase_row(const Args& args) {
    const int tid = threadIdx.x, lane = tid & 63, wave = __builtin_amdgcn_readfirstlane(tid >> 6);
    const int gw = blockIdx.x * 8 + wave, NGW = gridDim.x * 8;
    unsigned char* ws = args.ws;
    if (L == 0) row_pass<true, true>(args.in[0], (const bf16_t*)(ws + WS_Y), args.in[13], args.out, args.in[1] + DM, (bf16_t*)(ws + WS_H), ws + WS_H8, (float*)(ws + WS_HS), gw, NGW, lane);
    else row_pass<true, false>(args.out, (const bf16_t*)(ws + WS_Y), args.in[13] + DM, args.out, nullptr, nullptr, nullptr, nullptr, gw, NGW, lane);
}

__global__ void __launch_bounds__(512, 2) mk_fwd(const Args args) {
    extern __shared__ __attribute__((aligned(16))) unsigned char lds_raw[];
    LAS unsigned char* lds = (LAS unsigned char*)lds_raw;
    const int lo = args.ph_lo, hi = args.ph_hi;
    volatile LAS unsigned* bst = (volatile LAS unsigned*)(lds + LDS_BYTES - 64);
    if (threadIdx.x < 2) bst[threadIdx.x] = 0u;
    __syncthreads();
    XcdBarrier xbar; xbar.bar = (unsigned*)args.ws; xbar.x = 0; xbar.st = nullptr;
    if (hi - lo > 1) xbar = xcd_barrier_post((unsigned*)args.ws, bst);
#define IN(k) (lo <= (k) && (k) < hi)
#define SEAM(k) do { if (IN((k) + 1)) xcd_barrier(xbar); } while (0)
    if (hi > NPH) cg::this_grid().sync();
    if (IN(0)) { phase_prologue(args, lds); SEAM(0); }
    if (IN(1)) { phase_in<0>(args, lds); SEAM(1); }
    if (IN(2)) { phase_mix<0>(args, lds); SEAM(2); }
    if (IN(3)) { phase_br<0>(args, lds); SEAM(3); }
    if (IN(4)) { phase_out<0>(args, lds); SEAM(4); }
    if (IN(5)) { phase_row<0>(args); SEAM(5); }
    if (IN(6)) { phase_in<1>(args, lds); SEAM(6); }
    if (IN(7)) { phase_mix<1>(args, lds); SEAM(7); }
    if (IN(8)) { phase_br<1>(args, lds); SEAM(8); }
    if (IN(9)) { phase_out<1>(args, lds); SEAM(9); }
    if (IN(10)) { phase_row<1>(args); }
#undef IN
#undef SEAM
}

extern "C" void kernel_launch(void* const* d_in, const int* in_sizes, int n_in, void* d_out, int out_size, void* d_ws, size_t ws_size, hipStream_t stream) {
    static int grid = 0;
    if (grid == 0) {
        if (n_in != 14 || out_size != MT * DM || ws_size < WS_END) { fprintf(stderr, "kernel_launch: unexpected shapes (n_in %d out %d ws %zu)\n", n_in, out_size, ws_size); grid = -1; return; }
        int dev = 0, cus = 0, per_cu = 0;
        hipGetDevice(&dev);
        hipDeviceGetAttribute(&cus, hipDeviceAttributeMultiprocessorCount, dev);
        if (hipFuncSetAttribute((const void*)mk_fwd, hipFuncAttributeMaxDynamicSharedMemorySize, LDS_BYTES) != hipSuccess) { fprintf(stderr, "kernel_launch: hipFuncSetAttribute failed\n"); grid = -1; return; }
        if (hipOccupancyMaxActiveBlocksPerMultiprocessor(&per_cu, (const void*)mk_fwd, 512, LDS_BYTES) != hipSuccess || per_cu < 1) { fprintf(stderr, "kernel_launch: occupancy query says %d\n", per_cu); per_cu = 1; }
        (void)hipGetLastError();
        grid = cus * 1;
    }
    if (grid < 0) return;
    (void)hipMemsetAsync(d_ws, 0, 16384, stream);
    Args a{};
    for (int i = 0; i < 14; ++i) a.in[i] = (const float*)d_in[i];
    a.out = (float*)d_out; a.ws = (unsigned char*)d_ws;
#if MK_N_LAUNCHES == 1
    a.ph_lo = 0; a.ph_hi = NPH;
    void* kargs[] = {&a};
    hipError_t e = hipLaunchCooperativeKernel((const void*)mk_fwd, dim3(grid), dim3(512), kargs, LDS_BYTES, stream);
    if (e != hipSuccess) fprintf(stderr, "cooperative launch failed: %s (grid %d)\n", hipGetErrorString(e), grid);
#else
    for (int p = 0; p < NPH; ++p) { a.ph_lo = p; a.ph_hi = p + 1; hipLaunchKernelGGL(mk_fwd, dim3(grid), dim3(512), LDS_BYTES, stream, a); }
#endif
}
```

```cpp
#include <hip/hip_runtime.h>
#include <hip/hip_cooperative_groups.h>
#include <cstdio>
#include <cstdint>
namespace cg = cooperative_groups;

#define LAS __attribute__((address_space(3)))
typedef unsigned short bf16_t;
typedef short bf16x8 __attribute__((ext_vector_type(8)));
typedef float f32x4 __attribute__((ext_vector_type(4)));
typedef float f32x2 __attribute__((ext_vector_type(2)));
typedef float f32x16 __attribute__((ext_vector_type(16)));
typedef unsigned u32x4 __attribute__((ext_vector_type(4)));
typedef unsigned u32x2 __attribute__((ext_vector_type(2)));
typedef __bf16 bf16x2_t __attribute__((ext_vector_type(2)));
typedef int i32x4 __attribute__((ext_vector_type(4)));

#ifndef MK_N_LAUNCHES
#define MK_N_LAUNCHES 1
#endif

constexpr int MT = 16384;
constexpr int SEQ = 2048;
constexpr int DM = 2048;
constexpr int NIN = 17408;
constexpr int DH = 1024;
constexpr int NREL = 320;
constexpr int PT = MT + 64;
constexpr float LOG2E = 1.4426950408889634f;
constexpr float QSCALE = 0.125f * LOG2E;
constexpr float EPSN = 1e-6f;
constexpr int NBF = 8 * 1024; constexpr int NI8 = NIN - NBF;

constexpr size_t MiB = 1u << 20;
constexpr size_t WS_WIN = 2 * MiB;
constexpr size_t WS_WBR = 138 * MiB;
constexpr size_t WS_WOUT = 162 * MiB;
constexpr size_t WS_H = 178 * MiB;
constexpr size_t WS_SEG = 242 * MiB;
constexpr size_t WS_GATES = 594 * MiB;
constexpr size_t WS_O = 786 * MiB;
constexpr size_t WS_SGUW = 882 * MiB;
constexpr size_t WS_VT = 884 * MiB;
constexpr size_t WS_VCT = 918 * MiB;
constexpr size_t WS_H8 = 952 * MiB;
constexpr size_t WS_W8 = 984 * MiB;
constexpr size_t WS_HS = 1020 * MiB;
constexpr size_t WS_END = 1021 * MiB;
constexpr size_t WS_COLMAX = 16384;
constexpr size_t SEGB = 32 * MiB;
constexpr size_t WS_MERGED16 = WS_SEG + 4 * SEGB;
constexpr size_t WS_Y = WS_SEG + 6 * SEGB;

constexpr int LDS_BYTES = 163840;

__device__ __forceinline__ unsigned pk2(float lo, float hi) { f32x2 v = {lo, hi}; bf16x2_t b = __builtin_convertvector(v, bf16x2_t); return __builtin_bit_cast(unsigned, b); }
__device__ __forceinline__ unsigned q8x4(float a, float b, float c, float d) {
    const int ia = (int)__builtin_rintf(a), ib = (int)__builtin_rintf(b), ic = (int)__builtin_rintf(c), id = (int)__builtin_rintf(d);
    return (unsigned)(ia & 0xff) | ((unsigned)(ib & 0xff) << 8) | ((unsigned)(ic & 0xff) << 16) | ((unsigned)id << 24); }
__device__ __forceinline__ float bflo(unsigned u) { return __uint_as_float(u << 16); }
__device__ __forceinline__ float bfhi(unsigned u) { return __uint_as_float(u & 0xffff0000u); }
__device__ __forceinline__ float fast_sigmoid(float w) { return __builtin_amdgcn_rcpf(1.0f + __builtin_amdgcn_exp2f(-w * LOG2E)); }
__device__ __forceinline__ float wave_sum(float v) {
#pragma unroll
    for (int o = 1; o < 64; o <<= 1) v += __shfl_xor(v, o);
    return v;
}
#define MFMA32(a, b, c) __builtin_amdgcn_mfma_f32_32x32x16_bf16((a), (b), (c), 0, 0, 0)

namespace pg8 {
constexpr int BM = 256, BK = 64, HALF = 128, HTB = HALF * BK * 2, STAGE_BYTES = 8 * HTB, NXCD = 8, WGM = 8;
__device__ __forceinline__ int lds_byte(int r, int c) { const int st = (r >> 4) * 2 + (c >> 5), rr = r & 15, cc = c & 31, ob = rr * 64 + cc * 2; return st * 1024 + (ob ^ (((ob >> 9) & 1) << 5)); }
__device__ __forceinline__ void stage_rc(int b, int& R, int& C) { const int st = b / 1024, sb = b % 1024, swz = sb ^ (((sb >> 9) & 1) << 5); R = (st >> 1) * 16 + swz / 64; C = (st & 1) * 32 + (swz % 64) / 2; }
__device__ __forceinline__ int perm32(int rho) { const int n = rho >> 4, i = rho & 15; return 8 * (i >> 2) + 4 * n + (i & 3); }

struct Unit { int pm, pn, z; };
struct Gemm { const bf16_t* A; const bf16_t* Bt; int M, N, K; size_t zA, zB; };

template <int NZ> struct TileOrder {
    int nM, nN, nwg, G, c, wgm;
    __device__ void init(int M, int N, int G_, int c_, int wgm_ = WGM) { nM = M / BM; nN = N / BM; nwg = nM * nN; G = G_; c = c_; wgm = wgm_; }
    __device__ bool next(int i, Unit& u) const {
        const int ti = i / NZ; u.z = i - ti * NZ;
        const long L = (long)ti * G + c; if (L >= nwg) return false;
        int wgid = (int)L; { const int q = nwg / NXCD, r = nwg % NXCD, xcd = wgid % NXCD, off = wgid / NXCD; wgid = (xcd < r ? xcd * (q + 1) : r * (q + 1) + (xcd - r) * q) + off; }
        const int nig = wgm * nN, gid = wgid / nig, fm = gid * wgm, gsz = (nM - fm) < wgm ? (nM - fm) : wgm;
        u.pm = fm + ((wgid % nig) % gsz); u.pn = (wgid % nig) / gsz; return true;
    }
};


template <int MODE> __device__ __forceinline__ f32x2 act2(f32x2 v, float sc) {
    if constexpr (MODE == 0) return v * sc;
    if constexpr (MODE == 5) { f32x2 d; d.x = __builtin_amdgcn_exp2f(fminf(v.x, 20.f)); d.y = __builtin_amdgcn_exp2f(fminf(v.y, 20.f)); return d + 1.0f; }
    f32x2 t;
    if constexpr (MODE == 2) { const f32x2 x2 = v * v; t = v * (x2 * (-0.10294325f) + (-2.3022082f)); }
    else t = v * (-LOG2E);
    if constexpr (MODE == 3) { t.x = fminf(t.x, 20.f); t.y = fminf(t.y, 20.f); }
    f32x2 d; d.x = __builtin_amdgcn_exp2f(t.x); d.y = __builtin_amdgcn_exp2f(t.y);
    d = d + 1.0f;
    f32x2 r; r.x = __builtin_amdgcn_rcpf(d.x); r.y = __builtin_amdgcn_rcpf(d.y);
    if constexpr (MODE == 3) return r;
    return v * r;
}
template <int MODE, bool TR, bool I8 = false>
__device__ __forceinline__ void epi_in_tile(const f32x4 (&acc)[2][2][4][2], bf16_t* __restrict__ base, int ldc, int row0, int col0, float sc,
                                            const float* __restrict__ hs = nullptr, const float* __restrict__ cmx = nullptr) {
    f32x4 cs[2][2];
    if constexpr (I8) {
#pragma unroll
        for (int bj = 0; bj < 2; ++bj) { constexpr float kq = (MODE == 5 ? -LOG2E : 1.f) / 127.f; cs[bj][0] = *(const f32x4*)(cmx + bj * HALF) * kq; cs[bj][1] = *(const f32x4*)(cmx + bj * HALF + 4) * kq; }
    }
#pragma unroll
    for (int ai = 0; ai < 2; ++ai)
#pragma unroll
        for (int m = 0; m < 4; ++m) {
            const int row = row0 + ai * HALF + m * 16;
            float rs = 1.f; if constexpr (I8) rs = hs[row];
#pragma unroll
            for (int bj = 0; bj < 2; ++bj) {
                f32x4 a0 = acc[ai][bj][m][0], a1 = acc[ai][bj][m][1];
                if constexpr (I8) { const i32x4 i0 = __builtin_bit_cast(i32x4, a0), i1 = __builtin_bit_cast(i32x4, a1);
                    a0 = (f32x4){(float)i0[0], (float)i0[1], (float)i0[2], (float)i0[3]} * rs * cs[bj][0];
                    a1 = (f32x4){(float)i1[0], (float)i1[1], (float)i1[2], (float)i1[3]} * rs * cs[bj][1]; }
                const f32x2 p0 = act2<MODE>((f32x2){a0[0], a0[1]}, sc), p1 = act2<MODE>((f32x2){a0[2], a0[3]}, sc);
                const f32x2 p2 = act2<MODE>((f32x2){a1[0], a1[1]}, sc), p3 = act2<MODE>((f32x2){a1[2], a1[3]}, sc);
                u32x4 w; w.x = pk2(p0.x, p0.y); w.y = pk2(p1.x, p1.y); w.z = pk2(p2.x, p2.y); w.w = pk2(p3.x, p3.y);
                if constexpr (!TR) {
                    *(u32x4*)(base + (size_t)row * ldc + col0 + bj * HALF) = w;
                } else {
                    bf16_t* tp = base + (size_t)(col0 + bj * HALF) * PT + row;
                    tp[0 * (size_t)PT] = (bf16_t)(w.x & 0xffffu); tp[1 * (size_t)PT] = (bf16_t)(w.x >> 16);
                    tp[2 * (size_t)PT] = (bf16_t)(w.y & 0xffffu); tp[3 * (size_t)PT] = (bf16_t)(w.y >> 16);
                    tp[4 * (size_t)PT] = (bf16_t)(w.z & 0xffffu); tp[5 * (size_t)PT] = (bf16_t)(w.z >> 16);
                    tp[6 * (size_t)PT] = (bf16_t)(w.w & 0xffffu); tp[7 * (size_t)PT] = (bf16_t)(w.w >> 16);
                }
            }
        }
}
struct EpiIn {
    static constexpr bool PERM = true;
    unsigned char* seg;
    bf16_t* gates;
    bf16_t* vt; bf16_t* vct;
    __device__ __forceinline__ bool reset(const Unit&) const { return true; }
    __device__ __forceinline__ void operator()(const f32x4 (&acc)[2][2][4][2], const Unit& u, int wr, int wc, int fr, int fq) const {
        const int colt = u.pn * BM;
        const int row0 = u.pm * BM + wr * 64 + fr;
        const int lc = wc * 32 + 8 * fq;
        const int s = colt >> 10; const int col0 = (colt & 1023) + lc;
        bf16_t* base = (bf16_t*)(seg + (size_t)s * SEGB);
        if (s == 3 || s == 7) epi_in_tile<1, false>(acc, base, DH, row0, col0, 1.f);
        else if (s == 2) epi_in_tile<0, true>(acc, vt, 0, row0, col0, 1.f);
        else epi_in_tile<0, false>(acc, base, DH, row0, col0, s == 0 ? QSCALE : 1.f);
    }
};

struct EpiIn8 {
    static constexpr bool PERM = true;
    unsigned char* seg; bf16_t* gates; bf16_t* vct; const float* hs; const float* colmax;
    __device__ __forceinline__ bool reset(const Unit&) const { return true; }
    __device__ __forceinline__ void operator()(const f32x4 (&acc)[2][2][4][2], const Unit& u, int wr, int wc, int fr, int fq) const {
        const int colt = NBF + u.pn * BM;
        const int row0 = u.pm * BM + wr * 64 + fr;
        const int lc = wc * 32 + 8 * fq;
        const float* cmx = colmax + u.pn * BM + lc;
        if (colt >= 11 * DH) { epi_in_tile<5, false, true>(acc, gates, 3 * DM, row0, colt - 11 * DH + lc, 1.f, hs, cmx); return; }
        const int s = colt >> 10; const int col0 = (colt & 1023) + lc;
        bf16_t* base = (bf16_t*)(seg + (size_t)s * SEGB);
        if (s == 10) epi_in_tile<1, false, true>(acc, base, DH, row0, col0, 1.f, hs, cmx);
        else if (s == 9) epi_in_tile<2, true, true>(acc, vct, 0, row0, col0, 1.f, hs, cmx);
        else epi_in_tile<2, false, true>(acc, base, DH, row0, col0, 1.f, hs, cmx);
    }
};

struct EpiPlain {
    static constexpr bool PERM = true;
    bf16_t* O; int ldc;
    __device__ __forceinline__ bool reset(const Unit&) const { return true; }
    __device__ __forceinline__ void operator()(const f32x4 (&acc)[2][2][4][2], const Unit& u, int wr, int wc, int fr, int fq) const {
        const int row0 = u.pm * BM + wr * 64 + fr, col0 = u.pn * BM + wc * 32 + 8 * fq;
#pragma unroll
        for (int ai = 0; ai < 2; ++ai)
#pragma unroll
            for (int m = 0; m < 4; ++m) { bf16_t* rowp = O + (size_t)(row0 + ai * HALF + m * 16) * ldc + col0;
#pragma unroll
                for (int bj = 0; bj < 2; ++bj) { const f32x4 v0 = acc[ai][bj][m][0], v1 = acc[ai][bj][m][1];
                    u32x4 w; w.x = pk2(v0[0], v0[1]); w.y = pk2(v0[2], v0[3]); w.z = pk2(v1[0], v1[1]); w.w = pk2(v1[2], v1[3]);
                    *(u32x4*)(rowp + bj * HALF) = w; } }
    }
};

struct EpiMerge {
    static constexpr bool PERM = true;
    const bf16_t* __restrict__ gates; bf16_t* __restrict__ out;
    __device__ __forceinline__ bool reset(const Unit& u) const { return u.z == 2; }
    __device__ __forceinline__ void operator()(f32x4 (&acc)[2][2][4][2], const Unit& u, int wr, int wc, int fr, int fq) const {
        const int row0 = u.pm * BM + wr * 64 + fr, col0 = u.pn * BM + wc * 32 + 8 * fq;
        const int z = u.z;
        const bf16_t* gz = gates + (size_t)row0 * (3 * DM) + z * DM + col0;
        if (z < 2) {
            u32x4 gn[2][2][2], gd[2][2][2];
#define MRG_LOAD(b, s) do { _Pragma("unroll") for (int mm = 0; mm < 2; ++mm) _Pragma("unroll") for (int bj = 0; bj < 2; ++bj) { \
                const bf16_t* p = gz + (size_t)(((b) >> 1) * HALF + (2 * ((b) & 1) + mm) * 16) * (3 * DM) + bj * HALF; gn[s][mm][bj] = *(const u32x4*)p; gd[s][mm][bj] = *(const u32x4*)(p + DM); } } while (0)
#define MRG_APPLY(b, s) do { _Pragma("unroll") for (int mm = 0; mm < 2; ++mm) _Pragma("unroll") for (int bj = 0; bj < 2; ++bj) { \
                const u32x4 a = gn[s][mm][bj], d = gd[s][mm][bj]; \
                f32x4& v0 = acc[(b) >> 1][bj][2 * ((b) & 1) + mm][0]; f32x4& v1 = acc[(b) >> 1][bj][2 * ((b) & 1) + mm][1]; \
                v0[0] *= bflo(d.x) * __builtin_amdgcn_rcpf(bflo(a.x)); v0[1] *= bfhi(d.x) * __builtin_amdgcn_rcpf(bfhi(a.x)); \
                v0[2] *= bflo(d.y) * __builtin_amdgcn_rcpf(bflo(a.y)); v0[3] *= bfhi(d.y) * __builtin_amdgcn_rcpf(bfhi(a.y)); \
                v1[0] *= bflo(d.z) * __builtin_amdgcn_rcpf(bflo(a.z)); v1[1] *= bfhi(d.z) * __builtin_amdgcn_rcpf(bfhi(a.z)); \
                v1[2] *= bflo(d.w) * __builtin_amdgcn_rcpf(bflo(a.w)); v1[3] *= bfhi(d.w) * __builtin_amdgcn_rcpf(bfhi(a.w)); } } while (0)
            MRG_LOAD(0, 0); MRG_LOAD(1, 1);
            MRG_APPLY(0, 0); MRG_LOAD(2, 0);
            MRG_APPLY(1, 1); MRG_LOAD(3, 1);
            MRG_APPLY(2, 0);
            MRG_APPLY(3, 1);
#undef MRG_LOAD
#undef MRG_APPLY
        } else {
#pragma unroll
            for (int ai = 0; ai < 2; ++ai) {
                u32x4 gn[4][2];
#pragma unroll
                for (int m = 0; m < 4; ++m)
#pragma unroll
                    for (int bj = 0; bj < 2; ++bj) gn[m][bj] = *(const u32x4*)(gz + (size_t)(ai * HALF + m * 16) * (3 * DM) + bj * HALF);
#pragma unroll
                for (int m = 0; m < 4; ++m)
#pragma unroll
                    for (int bj = 0; bj < 2; ++bj) {
                        const u32x4 a = gn[m][bj];
                        const f32x4 v0 = acc[ai][bj][m][0], v1 = acc[ai][bj][m][1];
                        u32x4 w; w.x = pk2(v0[0] * __builtin_amdgcn_rcpf(bflo(a.x)), v0[1] * __builtin_amdgcn_rcpf(bfhi(a.x))); w.y = pk2(v0[2] * __builtin_amdgcn_rcpf(bflo(a.y)), v0[3] * __builtin_amdgcn_rcpf(bfhi(a.y)));
                        w.z = pk2(v1[0] * __builtin_amdgcn_rcpf(bflo(a.z)), v1[1] * __builtin_amdgcn_rcpf(bfhi(a.z))); w.w = pk2(v1[2] * __builtin_amdgcn_rcpf(bflo(a.w)), v1[3] * __builtin_amdgcn_rcpf(bfhi(a.w)));
                        *(u32x4*)(out + (size_t)(row0 + ai * HALF + m * 16) * DM + col0 + bj * HALF) = w;
                    }
            }
        }
    }
};

template <class Epi, class Sched, bool ALIGN_EPI, bool I8 = false>
__device__ __forceinline__ void gemm_phase(LAS unsigned char* lds, const Gemm g, const Sched& S, const Epi& E) {
    const int tid = threadIdx.x, wid = __builtin_amdgcn_readfirstlane(tid >> 6), lane = tid & 63, wr = wid >> 2, wc = wid & 3, fr = lane & 15, fq = lane >> 4;
    const int K = g.K, nt = K / BK;
    unsigned voffA[2], voffB[2];
#pragma unroll
    for (int i = 0; i < 2; ++i) { int R, C; stage_rc(tid * 16 + i * 8192, R, C); const int Rb = Epi::PERM ? ((R & ~31) + perm32(R & 31)) : R;
        voffA[i] = (unsigned)(R * K + C) * 2u; voffB[i] = (unsigned)(Rb * K + C) * 2u; }
    const size_t kstep = (size_t)(BK * 2);
    const size_t hstep = (size_t)HALF * K * 2;
    const size_t tstep = 2 * hstep;
    const unsigned ldsw = (unsigned)wid * 1024u;
    const int aoff = lds_byte(wr * 64 + fr, fq * 8), boff = lds_byte(wc * 32 + fr, fq * 8);
#define PG8_SA(b, h) (((b) * 2 + (h)) * HTB)
#define PG8_SB(b, h) ((4 + (b) * 2 + (h)) * HTB)
#define PG8_STAGE(bufoff, gbase, voff) do { _Pragma("unroll") for (int _i = 0; _i < 2; ++_i) \
        __builtin_amdgcn_global_load_lds((const unsigned*)((const char*)(gbase) + (voff)[_i]), (LAS unsigned*)(lds + (bufoff) + ldsw + _i * 8192), 16, 0, 0); } while (0)
#define PG8_LDA(dst, b, h) do { _Pragma("unroll") for (int m = 0; m < 4; ++m) _Pragma("unroll") for (int k = 0; k < 2; ++k) dst[m][k] = *(const LAS bf16x8*)(lds + PG8_SA(b, h) + aoff + m * 2048 + k * 1024); } while (0)
#define PG8_LDB(dst, b, h) do { _Pragma("unroll") for (int n = 0; n < 2; ++n) _Pragma("unroll") for (int k = 0; k < 2; ++k) dst[n][k] = *(const LAS bf16x8*)(lds + PG8_SB(b, h) + boff + n * 2048 + k * 1024); } while (0)
#define PG8_MMA(ai, bj, At, Bt) do { __builtin_amdgcn_s_setprio(1); _Pragma("unroll") for (int m = 0; m < 4; ++m) _Pragma("unroll") for (int n = 0; n < 2; ++n) _Pragma("unroll") for (int k = 0; k < 2; ++k) { \
        if constexpr (I8) acc[ai][bj][m][n] = __builtin_bit_cast(f32x4, __builtin_amdgcn_mfma_i32_16x16x64_i8(__builtin_bit_cast(i32x4, Bt[n][k]), __builtin_bit_cast(i32x4, At[m][k]), __builtin_bit_cast(i32x4, acc[ai][bj][m][n]), 0, 0, 0)); \
        else acc[ai][bj][m][n] = __builtin_amdgcn_mfma_f32_16x16x32_bf16(Bt[n][k], At[m][k], acc[ai][bj][m][n], 0, 0, 0); } __builtin_amdgcn_s_setprio(0); } while (0)
#define PG8_WAIT_V(n) asm volatile("s_waitcnt vmcnt(" #n ")" ::: "memory")
#define PG8_WAIT_L(n) asm volatile("s_waitcnt lgkmcnt(" #n ")" ::: "memory")
#define PG8_BAR __builtin_amdgcn_s_barrier()
#define PG8_SCHED __builtin_amdgcn_sched_barrier(0)
    Unit cur, nxt; int ui = 0;
    if (!S.next(0, cur)) return;
    f32x4 acc[2][2][4][2];
#pragma unroll
    for (int a = 0; a < 2; ++a)
#pragma unroll
        for (int b = 0; b < 2; ++b)
#pragma unroll
            for (int m = 0; m < 4; ++m)
#pragma unroll
                for (int n = 0; n < 2; ++n) acc[a][b][m][n] = (f32x4){0.f, 0.f, 0.f, 0.f};
    bf16x8 At[4][2], B0[2][2], B1[2][2];
    const char* cA = (const char*)g.A + (size_t)cur.z * g.zA + (size_t)cur.pm * tstep; const char* cB = (const char*)g.Bt + (size_t)cur.z * g.zB + (size_t)cur.pn * tstep;
    PG8_STAGE(PG8_SB(0, 0), cB, voffB); PG8_STAGE(PG8_SB(0, 1), cB + hstep, voffB); PG8_STAGE(PG8_SA(0, 0), cA, voffA); PG8_STAGE(PG8_SA(0, 1), cA + hstep, voffA);
    if (wr == 1) PG8_BAR;
    PG8_WAIT_V(2); PG8_BAR;
    PG8_STAGE(PG8_SB(1, 0), cB + kstep, voffB); PG8_STAGE(PG8_SA(1, 0), cA + kstep, voffA); PG8_STAGE(PG8_SB(1, 1), cB + hstep + kstep, voffB);
    PG8_WAIT_V(6); PG8_BAR;
    for (;;) {
        const bool has_next = S.next(ui + 1, nxt);
        const char* nA = has_next ? (const char*)g.A + (size_t)nxt.z * g.zA + (size_t)nxt.pm * tstep : cA;
        const char* nB = has_next ? (const char*)g.Bt + (size_t)nxt.z * g.zB + (size_t)nxt.pn * tstep : cB;
        for (int t = 0; t < nt; t += 2) {
            const bool last = (t == nt - 2);
            const char* a1 = cA + (size_t)(t + 1) * kstep;
            const char* a2 = last ? nA : cA + (size_t)(t + 2) * kstep; const char* b2 = last ? nB : cB + (size_t)(t + 2) * kstep;
            const char* a3 = a2 + kstep; const char* b3 = b2 + kstep;
            PG8_LDB(B0, 0, 0); PG8_LDB(B1, 0, 1); PG8_SCHED; PG8_LDA(At, 0, 0); PG8_STAGE(PG8_SA(1, 1), a1 + hstep, voffA);
            PG8_WAIT_V(8); PG8_WAIT_L(0); PG8_BAR; PG8_MMA(0, 0, At, B0); PG8_MMA(0, 1, At, B1); PG8_BAR; PG8_SCHED;
            PG8_LDA(At, 0, 1); PG8_STAGE(PG8_SB(0, 0), b2, voffB); PG8_STAGE(PG8_SB(0, 1), b2 + hstep, voffB); PG8_STAGE(PG8_SA(0, 0), a2, voffA);
            PG8_WAIT_V(8); PG8_WAIT_L(0); PG8_BAR; PG8_MMA(1, 0, At, B0); PG8_MMA(1, 1, At, B1); PG8_BAR; PG8_SCHED;
            PG8_LDB(B0, 1, 0); PG8_LDB(B1, 1, 1); PG8_SCHED; PG8_LDA(At, 1, 0); PG8_STAGE(PG8_SA(0, 1), a2 + hstep, voffA);
            PG8_WAIT_V(8); PG8_WAIT_L(0); PG8_BAR; PG8_MMA(0, 0, At, B0); PG8_MMA(0, 1, At, B1); PG8_BAR; PG8_SCHED;
            PG8_LDA(At, 1, 1); PG8_STAGE(PG8_SB(1, 0), b3, voffB); PG8_STAGE(PG8_SB(1, 1), b3 + hstep, voffB); PG8_STAGE(PG8_SA(1, 0), a3, voffA);
            PG8_WAIT_V(8); PG8_WAIT_L(0); PG8_BAR; PG8_MMA(1, 0, At, B0); PG8_MMA(1, 1, At, B1); PG8_BAR; PG8_SCHED;
        }
        if constexpr (ALIGN_EPI) { if (wr == 0) PG8_BAR; }
        E(acc, cur, wr, wc, fr, fq);
        if (!has_next) break;
        if (E.reset(cur)) {
#pragma unroll
        for (int a = 0; a < 2; ++a)
#pragma unroll
            for (int b = 0; b < 2; ++b)
#pragma unroll
                for (int m = 0; m < 4; ++m)
#pragma unroll
                    for (int n = 0; n < 2; ++n) acc[a][b][m][n] = (f32x4){0.f, 0.f, 0.f, 0.f};
        }
        cur = nxt; cA = nA; cB = nB; ++ui;
        if constexpr (ALIGN_EPI) { if (wr == 1) PG8_BAR; }
    }
    PG8_WAIT_V(0);
    if constexpr (!ALIGN_EPI) { if (wr == 0) PG8_BAR; }
    PG8_BAR;
#undef PG8_SA
#undef PG8_SB
#undef PG8_STAGE
#undef PG8_LDA
#undef PG8_LDB
#undef PG8_MMA
#undef PG8_WAIT_V
#undef PG8_WAIT_L
#undef PG8_BAR
#undef PG8_SCHED
}
}

#define GAS __attribute__((address_space(1)))
#define RLX_AGENT __ATOMIC_RELAXED, __HIP_MEMORY_SCOPE_AGENT
#define XB_TMO      128
#define XB_XCNT(j)  (256  + 64 * (j))
#define XB_XSUB(j)  (1280 + 64 * (j))
#define XB_XGEN(j)  (2304 + 64 * (j))
#define XB_TOP      3328
#define XB_TOPGEN   3392
#define XCD_BAR_WORDS 3456
#define XB_SPIN_CAP (1u << 18)

__device__ __forceinline__ unsigned xb_ld(unsigned* p)              { return __hip_atomic_load(p, __ATOMIC_RELAXED, __HIP_MEMORY_SCOPE_AGENT); }
__device__ __forceinline__ unsigned xb_add(unsigned* p, unsigned v) { return __hip_atomic_fetch_add(p, v, __ATOMIC_RELAXED, __HIP_MEMORY_SCOPE_AGENT); }
__device__ __forceinline__ unsigned xb_xcc_id() { return (unsigned)__builtin_amdgcn_s_getreg((3 << 11) | 20) & 0xFu; }
#define XB_SPIN(cond, bar) do { unsigned _sp = 0; while (cond) { __builtin_amdgcn_s_sleep(1); \
    if ((++_sp & 255u) == 0u) { if (xb_ld(&(bar)[XB_TMO])) break; if (_sp > XB_SPIN_CAP) { atomicAdd(&(bar)[XB_TMO], 1u); break; } } } } while (0)

struct XcdBarrier {
    unsigned* bar; unsigned x;
    volatile LAS unsigned* st;
};

__device__ __forceinline__ XcdBarrier xcd_barrier_post(unsigned* bar, volatile LAS unsigned* st) {
    XcdBarrier b; b.bar = bar; b.x = xb_xcc_id(); b.st = st;
    if (threadIdx.x == 0) (void)xb_add(&bar[XB_XCNT(b.x)], 1u);
    return b;
}
__device__ __forceinline__ void xcd_barrier_complete(unsigned* bar, unsigned x, unsigned& nloc, unsigned& nx) {
    const unsigned G = gridDim.x * gridDim.y * gridDim.z;
    unsigned sum, cnt, mine, sp = 0u;
    for (;;) {
        sum = 0u; cnt = 0u; mine = 0u;
#pragma unroll
        for (unsigned j = 0; j < 16; ++j) { const unsigned c = xb_ld(&bar[XB_XCNT(j)]); sum += c; cnt += (c > 0u) ? 1u : 0u; mine = (j == x) ? c : mine; }
        if (sum == G) break;
        __builtin_amdgcn_s_sleep(1);
        if ((++sp & 255u) == 0u) { if (xb_ld(&bar[XB_TMO])) break; if (sp > XB_SPIN_CAP) { atomicAdd(&bar[XB_TMO], 1u); break; } }
    }
    nloc = mine > 0u ? mine : 1u; nx = cnt > 0u ? cnt : 1u;
}

__device__ __forceinline__ void xcd_barrier(const XcdBarrier& b) {
    asm volatile("s_waitcnt vmcnt(0)" ::: "memory");
    __syncthreads();
    if (threadIdx.x == 0) {
        unsigned* bar = b.bar;
        __builtin_amdgcn_s_waitcnt(0);
        unsigned nloc = b.st[0], nx = b.st[1];
        if (nloc == 0u) { xcd_barrier_complete(bar, b.x, nloc, nx); b.st[0] = nloc; b.st[1] = nx; }
        const unsigned old = xb_add(&bar[XB_XSUB(b.x)], 1u);
        const unsigned gen = old / nloc;
        if (old + 1u == (gen + 1u) * nloc) {
            __builtin_amdgcn_fence(__ATOMIC_RELEASE, "agent");
            asm volatile("s_waitcnt vmcnt(0)" ::: "memory");
            const unsigned og = xb_add(&bar[XB_TOP], 1u);
            const unsigned tg = og / nx;
            if (og + 1u == (tg + 1u) * nx) xb_add(&bar[XB_TOPGEN], 1u);
            else XB_SPIN(xb_ld(&bar[XB_TOPGEN]) == tg, bar);
            __builtin_amdgcn_fence(__ATOMIC_ACQUIRE, "agent");
            xb_add(&bar[XB_XGEN(b.x)], 1u);
            asm volatile("s_waitcnt vmcnt(0)" ::: "memory");
        } else {
            XB_SPIN(xb_ld(&bar[XB_XGEN(b.x)]) == gen, bar);
            __builtin_amdgcn_fence(__ATOMIC_ACQUIRE, "agent");
            asm volatile("s_waitcnt vmcnt(0)" ::: "memory");
        }
    }
    __syncthreads();
}

__device__ __forceinline__ void transpose_item(const float* __restrict__ W, int K, int N, bf16_t* __restrict__ WT, LAS float* scr, int kb, int nb, int lane) {
    const int k0 = 64 * kb, n0 = 32 * nb;
    float tv[32];
#pragma unroll
    for (int i = 0; i < 32; ++i) { const int kk = 2 * i + (lane >> 5); tv[i] = W[(size_t)(k0 + kk) * N + n0 + (lane & 31)]; }
#pragma unroll
    for (int i = 0; i < 32; ++i) { const int kk = 2 * i + (lane >> 5); scr[kk * 33 + (lane & 31)] = tv[i]; }
    asm volatile("s_waitcnt lgkmcnt(0)" ::: "memory");
    const int c = lane & 7;
#pragma unroll
    for (int j = 0; j < 4; ++j) { const int n = (lane >> 3) + 8 * j; const LAS float* s = scr + (8 * c) * 33 + n;
        u32x4 o; o.x = pk2(s[0 * 33], s[1 * 33]); o.y = pk2(s[2 * 33], s[3 * 33]); o.z = pk2(s[4 * 33], s[5 * 33]); o.w = pk2(s[6 * 33], s[7 * 33]);
        *(u32x4*)(WT + (size_t)(n0 + n) * K + k0 + 8 * c) = o; }
    asm volatile("s_waitcnt lgkmcnt(0)" ::: "memory");
}

__device__ __forceinline__ void quant_cols_unit(const float* __restrict__ W, unsigned char* __restrict__ W8, float* __restrict__ colmax, int cb, LAS unsigned char* lds, int tid) {
    const int lane = tid & 63, w = __builtin_amdgcn_readfirstlane(tid >> 6);
    const int n0 = NBF + 32 * cb;
    LAS float* scr = (LAS float*)(lds + w * 16384);
    LAS float* pm = (LAS float*)(lds + 131072);
    float tv[4][32];
#pragma unroll
    for (int q = 0; q < 4; ++q) { const int k0 = 64 * (w + 8 * q);
#pragma unroll
        for (int i = 0; i < 32; ++i) { const int kk = 2 * i + (lane >> 5); tv[q][i] = W[(size_t)(k0 + kk) * NIN + n0 + (lane & 31)]; } }
    float mx = 0.f;
#pragma unroll
    for (int q = 0; q < 4; ++q)
#pragma unroll
        for (int i = 0; i < 32; ++i) mx = fmaxf(mx, fabsf(tv[q][i]));
    mx = fmaxf(mx, __shfl_xor(mx, 32));
    if (lane < 32) pm[w * 32 + lane] = mx;
    __syncthreads();
    float cm = 0.f;
#pragma unroll
    for (int ww = 0; ww < 8; ++ww) cm = fmaxf(cm, pm[ww * 32 + (lane & 31)]);
    if (w == 0 && lane < 32) colmax[n0 - NBF + lane] = cm;
    const float qs = 127.f / fmaxf(cm, 1e-30f);
    const int n = lane >> 1, kh = (lane & 1) * 32;
#pragma unroll
    for (int q = 0; q < 4; ++q) { const int k0 = 64 * (w + 8 * q);
#pragma unroll
        for (int i = 0; i < 32; ++i) { const int kk = 2 * i + (lane >> 5); scr[kk * 33 + (lane & 31)] = tv[q][i] * qs; }
        asm volatile("s_waitcnt lgkmcnt(0)" ::: "memory");
        const LAS float* s = scr + kh * 33 + n;
        u32x4 o0, o1;
        o0.x = q8x4(s[0 * 33], s[1 * 33], s[2 * 33], s[3 * 33]);     o0.y = q8x4(s[4 * 33], s[5 * 33], s[6 * 33], s[7 * 33]);
        o0.z = q8x4(s[8 * 33], s[9 * 33], s[10 * 33], s[11 * 33]);   o0.w = q8x4(s[12 * 33], s[13 * 33], s[14 * 33], s[15 * 33]);
        o1.x = q8x4(s[16 * 33], s[17 * 33], s[18 * 33], s[19 * 33]); o1.y = q8x4(s[20 * 33], s[21 * 33], s[22 * 33], s[23 * 33]);
        o1.z = q8x4(s[24 * 33], s[25 * 33], s[26 * 33], s[27 * 33]); o1.w = q8x4(s[28 * 33], s[29 * 33], s[30 * 33], s[31 * 33]);
        unsigned char* dst = W8 + (size_t)(n0 - NBF + n) * DM + k0 + kh;
        *(u32x4*)dst = o0; *(u32x4*)(dst + 16) = o1;
        asm volatile("s_waitcnt lgkmcnt(0)" ::: "memory");
    }
    __syncthreads();
}

template <bool HAS_Y, bool WRITE_H>
__device__ __forceinline__ void row_pass(const float* __restrict__ xin, const bf16_t* __restrict__ Y, const float* __restrict__ post_g, float* xout,
                                         const float* __restrict__ pre_g, bf16_t* __restrict__ H, unsigned char* __restrict__ H8, float* __restrict__ HS, int gw, int NGW, int lane) {
    for (int row = gw; row < MT; row += NGW) {
        float xv[4][8];
#pragma unroll
        for (int j = 0; j < 4; ++j) { const int col = (j * 64 + lane) * 8; const f32x4 a = *(const f32x4*)(xin + (size_t)row * DM + col), b = *(const f32x4*)(xin + (size_t)row * DM + col + 4);
#pragma unroll
            for (int e = 0; e < 4; ++e) { xv[j][e] = a[e]; xv[j][4 + e] = b[e]; } }
        if constexpr (HAS_Y) {
            float yv[4][8]; float ss = 0.f;
#pragma unroll
            for (int j = 0; j < 4; ++j) { const int col = (j * 64 + lane) * 8; const u32x4 w = *(const u32x4*)(Y + (size_t)row * DM + col);
                yv[j][0] = bflo(w.x); yv[j][1] = bfhi(w.x); yv[j][2] = bflo(w.y); yv[j][3] = bfhi(w.y); yv[j][4] = bflo(w.z); yv[j][5] = bfhi(w.z); yv[j][6] = bflo(w.w); yv[j][7] = bfhi(w.w);
#pragma unroll
                for (int e = 0; e < 8; ++e) ss += yv[j][e] * yv[j][e]; }
            const float r = 1.0f / sqrtf(wave_sum(ss) * (1.0f / DM) + EPSN);
#pragma unroll
            for (int j = 0; j < 4; ++j) { const int col = (j * 64 + lane) * 8; const f32x4 ga = *(const f32x4*)(post_g + col), gb = *(const f32x4*)(post_g + col + 4);
#pragma unroll
                for (int e = 0; e < 4; ++e) { xv[j][e] += yv[j][e] * r * ga[e]; xv[j][4 + e] += yv[j][4 + e] * r * gb[e]; }
                *(f32x4*)(xout + (size_t)row * DM + col) = (f32x4){xv[j][0], xv[j][1], xv[j][2], xv[j][3]};
                *(f32x4*)(xout + (size_t)row * DM + col + 4) = (f32x4){xv[j][4], xv[j][5], xv[j][6], xv[j][7]}; }
        }
        if constexpr (WRITE_H) {
            float ss = 0.f;
#pragma unroll
            for (int j = 0; j < 4; ++j)
#pragma unroll
                for (int e = 0; e < 8; ++e) ss += xv[j][e] * xv[j][e];
            const float r = 1.0f / sqrtf(wave_sum(ss) * (1.0f / DM) + EPSN);
            float amax = 0.f;
#pragma unroll
            for (int j = 0; j < 4; ++j) { const int col = (j * 64 + lane) * 8; const f32x4 ga = *(const f32x4*)(pre_g + col), gb = *(const f32x4*)(pre_g + col + 4);
#pragma unroll
                for (int e = 0; e < 4; ++e) { xv[j][e] *= r * ga[e]; xv[j][4 + e] *= r * gb[e]; amax = fmaxf(amax, fmaxf(fabsf(xv[j][e]), fabsf(xv[j][4 + e]))); }
                u32x4 w; w.x = pk2(xv[j][0], xv[j][1]); w.y = pk2(xv[j][2], xv[j][3]); w.z = pk2(xv[j][4], xv[j][5]); w.w = pk2(xv[j][6], xv[j][7]);
                *(u32x4*)(H + (size_t)row * DM + col) = w; }
#pragma unroll
            for (int o = 1; o < 64; o <<= 1) amax = fmaxf(amax, __shfl_xor(amax, o));
            amax = fmaxf(amax, 1e-20f);
            const float qs = 127.f / amax;
            if (lane == 0) HS[row] = amax * (1.f / 127.f);
#pragma unroll
            for (int j = 0; j < 4; ++j) { const int col = (j * 64 + lane) * 8;
                u32x2 w8; w8.x = q8x4(xv[j][0] * qs, xv[j][1] * qs, xv[j][2] * qs, xv[j][3] * qs); w8.y = q8x4(xv[j][4] * qs, xv[j][5] * qs, xv[j][6] * qs, xv[j][7] * qs);
                *(u32x2*)(H8 + (size_t)row * DM + col) = w8; }
        }
    }
}

constexpr int ATP = 144;
constexpr int ATT_WAVE_LDS = 2 * 64 * ATP;
#define ATT_BAR() asm volatile("s_waitcnt lgkmcnt(0)\n\ts_barrier" ::: "memory")
__device__ __forceinline__ void attn_item(const bf16_t* __restrict__ Q, const bf16_t* __restrict__ Kb, const bf16_t* __restrict__ VT, const bf16_t* __restrict__ GA,
                                          bf16_t* __restrict__ OA, const LAS float* btab, LAS unsigned char* pl  , int b, int c, int h, int half, int lane) {
    const int r = lane & 31, hh = lane >> 5;
    const int rl = lane >> 3, cl = lane & 7;
    const int tokq = b * SEQ + c * 64 + half * 32;
    const int qloc = half * 32 + r;
    const int pr = (r & ~12) | ((r & 4) << 1) | ((r & 8) >> 1);
    const int jmin = c >= 8 ? 0 : 8 - c;
    const int tk0 = b * SEQ + (c - 8 + jmin) * 64;
    const bf16_t* tg = half ? VT + (size_t)(h * 64 + rl) * PT + tk0 + cl * 8 : Kb + (size_t)(tk0 + rl) * DH + h * 64 + cl * 8;
    const size_t rstep = half ? (size_t)8 * PT : (size_t)8 * DH;
    const size_t tstep = half ? (size_t)64 : (size_t)64 * DH;
    const int stoff = (half ? 64 * ATP : 0) + rl * ATP + cl * 16;
    u32x4 tr[8];
#pragma unroll
    for (int i = 0; i < 8; ++i) tr[i] = *(const u32x4*)(tg + i * rstep);
    bf16x8 qf[4];
    { const bf16_t* qp = Q + (size_t)(tokq + r) * DH + h * 64 + 8 * hh;
#pragma unroll
      for (int d0 = 0; d0 < 4; ++d0) qf[d0] = *(const bf16x8*)(qp + d0 * 16); }
    int buf = 0;
#pragma unroll
    for (int i = 0; i < 8; ++i) *(LAS u32x4*)(pl + stoff + 8 * i * ATP) = tr[i];
    tg += (jmin + 1 <= 8) ? tstep : (size_t)0;
#pragma unroll
    for (int i = 0; i < 8; ++i) tr[i] = *(const u32x4*)(tg + i * rstep);
    ATT_BAR();
    f32x16 o0, o1, cinit;
#pragma unroll
    for (int i = 0; i < 16; ++i) { o0[i] = 0.f; o1[i] = 0.f; }
    constexpr float ATT_THR = 8.f;
    float mref = 0.f, lrun = 0.f;
    const float cfar = btab[NREL - 1];
#pragma unroll
    for (int i = 0; i < 16; ++i) cinit[i] = cfar;
    for (int j = jmin; j <= 8; ++j) {
        const LAS unsigned char* kfp = pl + buf * ATT_WAVE_LDS + pr * ATP + 16 * hh;
        const LAS unsigned char* vfp = pl + buf * ATT_WAVE_LDS + 64 * ATP + r * ATP + 16 * hh;
        f32x16 s0, s1;
        if (j <= 3) {
            const bf16x8 k0 = *(const LAS bf16x8*)(kfp), k1 = *(const LAS bf16x8*)(kfp + 32 * ATP);
            s0 = MFMA32(k0, qf[0], cinit); s1 = MFMA32(k1, qf[0], cinit);
        } else {
            const LAS float* bp = btab + (qloc + 64 * (8 - j) + 63 - 8 * hh);
#pragma unroll
            for (int i = 0; i < 16; ++i) {
                const int key = (i & 3) + 4 * ((i >> 2) & 1) + 16 * (i >> 3);
                s0[i] = bp[-key] - mref; s1[i] = bp[-key - 32] - mref;
            }
            const bf16x8 k0 = *(const LAS bf16x8*)(kfp), k1 = *(const LAS bf16x8*)(kfp + 32 * ATP);
            s0 = MFMA32(k0, qf[0], s0); s1 = MFMA32(k1, qf[0], s1);
        }
#pragma unroll
        for (int d0 = 1; d0 < 4; ++d0) {
            const bf16x8 k0 = *(const LAS bf16x8*)(kfp + d0 * 32), k1 = *(const LAS bf16x8*)(kfp + 32 * ATP + d0 * 32);
            s0 = MFMA32(k0, qf[d0], s0); s1 = MFMA32(k1, qf[d0], s1);
        }
        float tmax = fmaxf(s0[0], s1[0]);
#pragma unroll
        for (int i = 1; i < 16; ++i) tmax = fmaxf(tmax, fmaxf(s0[i], s1[i]));
        tmax = fmaxf(tmax, __shfl_xor(tmax, 32));
        if (j == jmin || __any(tmax > ATT_THR)) {
            const float dl = (j == jmin) ? tmax : fmaxf(tmax, 0.f);
            mref += dl;
            const float alpha = (j == jmin) ? 1.f : __builtin_amdgcn_exp2f(-dl);
            lrun *= alpha;
#pragma unroll
            for (int i = 0; i < 16; ++i) { s0[i] -= dl; s1[i] -= dl; o0[i] *= alpha; o1[i] *= alpha; cinit[i] = cfar - mref; }
        }
        float ls = 0.f;
#pragma unroll
        for (int i = 0; i < 16; ++i) { s0[i] = __builtin_amdgcn_exp2f(s0[i]); s1[i] = __builtin_amdgcn_exp2f(s1[i]); ls += s0[i] + s1[i]; }
        lrun += ls;
#pragma unroll
        for (int s = 0; s < 2; ++s) {
            u32x4 pa, pb;
            pa.x = pk2(s0[8 * s + 0], s0[8 * s + 1]); pa.y = pk2(s0[8 * s + 2], s0[8 * s + 3]); pa.z = pk2(s0[8 * s + 4], s0[8 * s + 5]); pa.w = pk2(s0[8 * s + 6], s0[8 * s + 7]);
            pb.x = pk2(s1[8 * s + 0], s1[8 * s + 1]); pb.y = pk2(s1[8 * s + 2], s1[8 * s + 3]); pb.z = pk2(s1[8 * s + 4], s1[8 * s + 5]); pb.w = pk2(s1[8 * s + 6], s1[8 * s + 7]);
            const bf16x8 va0 = *(const LAS bf16x8*)(vfp + 32 * s), va1 = *(const LAS bf16x8*)(vfp + 32 * ATP + 32 * s);
            const bf16x8 vb0 = *(const LAS bf16x8*)(vfp + 64 + 32 * s), vb1 = *(const LAS bf16x8*)(vfp + 32 * ATP + 64 + 32 * s);
            o0 = MFMA32(va0, __builtin_bit_cast(bf16x8, pa), o0); o1 = MFMA32(va1, __builtin_bit_cast(bf16x8, pa), o1);
            o0 = MFMA32(vb0, __builtin_bit_cast(bf16x8, pb), o0); o1 = MFMA32(vb1, __builtin_bit_cast(bf16x8, pb), o1);
        }
        buf ^= 1;
#pragma unroll
        for (int i = 0; i < 8; ++i) *(LAS u32x4*)(pl + buf * ATT_WAVE_LDS + stoff + 8 * i * ATP) = tr[i];
        tg += (j + 2 <= 8) ? tstep : (size_t)0;
#pragma unroll
        for (int i = 0; i < 8; ++i) tr[i] = *(const u32x4*)(tg + i * rstep);
        ATT_BAR();
    }
    const float l = lrun + __shfl_xor(lrun, 32);
    const float inv = 1.0f / l;
    LAS unsigned char* Ot = pl + half * ATT_WAVE_LDS;
#pragma unroll
    for (int g = 0; g < 4; ++g) {
#pragma unroll
        for (int db = 0; db < 2; ++db) {
            const f32x16& o = db ? o1 : o0;
            u32x2 w; w.x = pk2(o[4 * g + 0] * inv, o[4 * g + 1] * inv); w.y = pk2(o[4 * g + 2] * inv, o[4 * g + 3] * inv);
            *(LAS u32x2*)(Ot + r * ATP + (db * 32 + 8 * g + 4 * hh) * 2) = w;
        }
    }
#pragma unroll
    for (int i = 0; i < 4; ++i) {
        const int row = rl + 8 * i;
        const size_t a = (size_t)(tokq + row) * DH + h * 64 + cl * 8;
        const u32x4 gg = *(const u32x4*)(GA + a);
        const u32x4 ov = *(const LAS u32x4*)(Ot + row * ATP + cl * 16);
        u32x4 w; w.x = pk2(bflo(ov.x) * bflo(gg.x), bfhi(ov.x) * bfhi(gg.x)); w.y = pk2(bflo(ov.y) * bflo(gg.y), bfhi(ov.y) * bfhi(gg.y));
        w.z = pk2(bflo(ov.z) * bflo(gg.z), bfhi(ov.z) * bfhi(gg.z)); w.w = pk2(bflo(ov.w) * bflo(gg.w), bfhi(ov.w) * bfhi(gg.w));
        *(u32x4*)(OA + a) = w;
    }
    ATT_BAR();
}
#undef ATT_BAR

__device__ __forceinline__ void unpack8(const u32x4 w, float* v) { v[0] = bflo(w.x); v[1] = bfhi(w.x); v[2] = bflo(w.y); v[3] = bfhi(w.y); v[4] = bflo(w.z); v[5] = bfhi(w.z); v[6] = bflo(w.w); v[7] = bfhi(w.w); }
__device__ __forceinline__ void conv_unit(const bf16_t* __restrict__ BB, const bf16_t* __restrict__ CC, const bf16_t* __restrict__ HB, const bf16_t* __restrict__ GB,
                                          bf16_t* __restrict__ OB, const float* __restrict__ cw, int unit, int tid) {
    const int cgp = tid & 127, sub = tid >> 7, ch = cgp * 8;
    const int t0 = unit * 32 + sub * 8;
    float w0[8], w1[8], w2[8];
#pragma unroll
    for (int e = 0; e < 8; ++e) { w0[e] = cw[ch + e]; w1[e] = cw[DH + ch + e]; w2[e] = cw[2 * DH + ch + e]; }
    float p2[8], p1[8];
#pragma unroll
    for (int e = 0; e < 8; ++e) { p2[e] = 0.f; p1[e] = 0.f; }
    const int tpos = t0 & (SEQ - 1);
    if (tpos >= 2) { float a[8], b[8]; unpack8(*(const u32x4*)(CC + (size_t)(t0 - 2) * DH + ch), a); unpack8(*(const u32x4*)(HB + (size_t)(t0 - 2) * DH + ch), b);
#pragma unroll
        for (int e = 0; e < 8; ++e) p2[e] = a[e] * b[e]; }
    if (tpos >= 1) { float a[8], b[8]; unpack8(*(const u32x4*)(CC + (size_t)(t0 - 1) * DH + ch), a); unpack8(*(const u32x4*)(HB + (size_t)(t0 - 1) * DH + ch), b);
#pragma unroll
        for (int e = 0; e < 8; ++e) p1[e] = a[e] * b[e]; }
#pragma unroll
    for (int i = 0; i < 8; ++i) {
        const size_t off = (size_t)(t0 + i) * DH + ch;
        float a[8], b[8], g1[8], g2[8], o[8];
        unpack8(*(const u32x4*)(CC + off), a); unpack8(*(const u32x4*)(HB + off), b); unpack8(*(const u32x4*)(BB + off), g1); unpack8(*(const u32x4*)(GB + off), g2);
#pragma unroll
        for (int e = 0; e < 8; ++e) { const float cur = a[e] * b[e]; o[e] = g1[e] * (w0[e] * p2[e] + w1[e] * p1[e] + w2[e] * cur) * g2[e]; p2[e] = p1[e]; p1[e] = cur; }
        u32x4 w; w.x = pk2(o[0], o[1]); w.y = pk2(o[2], o[3]); w.z = pk2(o[4], o[5]); w.w = pk2(o[6], o[7]);
        *(u32x4*)(OB + off) = w;
    }
}

template <int tbA, int tbB>
__device__ __forceinline__ void sgu_groups(const bf16_t* __restrict__ VCT, const bf16_t* __restrict__ U, const bf16_t* __restrict__ GC, bf16_t* __restrict__ OC,
                                           const bf16_t* __restrict__ Wbf, const float* __restrict__ spb, const float* __restrict__ lng, const float* __restrict__ lnb,
                                           int tok0, int gh, int cb, int r, int hh, const LAS float* stat, LAS unsigned char* stg, int lane) {
    for (int gi = 0; gi < 4; ++gi) {
        const int g = gh * 4 + gi;
        const int ch = g * 128 + cb * 32 + r;
        const float gg = lng[ch], bb = lnb[ch];
        const bf16_t* ap = VCT + (size_t)ch * PT + tok0 + 8 * hh;
        const bf16_t* wp = Wbf + (size_t)g * 16384 + 8 * hh;
        constexpr int NSB = (tbB + 1) * 2, NSA = (tbA + 1) * 2;
        int so = 0; asm volatile("" : "+v"(so));
        u32x4 raw[NSB]; bf16x8 wB[NSB], wA[NSA];
#pragma unroll
        for (int k = 0; k < NSB; ++k) { raw[k] = *(const u32x4*)(ap + 16 * k); wB[k] = *(const bf16x8*)(wp + (size_t)(tbB * 32 + r) * 128 + 16 * k); }
#pragma unroll
        for (int k = 0; k < NSA; ++k) wA[k] = *(const bf16x8*)(wp + (size_t)(tbA * 32 + r) * 128 + 16 * k);
        f32x16 accA, accB;
#pragma unroll
        for (int i = 0; i < 16; ++i) { accA[i] = 0.f; accB[i] = 0.f; }
#pragma unroll
        for (int k = 0; k < NSB; ++k) {
            float v[8]; unpack8(raw[k], v);
#pragma unroll
            for (int jj = 0; jj < 8; ++jj) { const float mean = stat[(16 * k + 8 * hh + jj) * 2 + so], rstd = stat[(16 * k + 8 * hh + jj) * 2 + 1 + so]; v[jj] = (v[jj] - mean) * rstd * gg + bb; }
            u32x4 af; af.x = pk2(v[0], v[1]); af.y = pk2(v[2], v[3]); af.z = pk2(v[4], v[5]); af.w = pk2(v[6], v[7]);
            accB = MFMA32(__builtin_bit_cast(bf16x8, af), wB[k], accB);
            if (k < NSA) accA = MFMA32(__builtin_bit_cast(bf16x8, af), wA[k < NSA ? k : 0], accA);
        }
#pragma unroll
        for (int which = 0; which < 2; ++which) {
            const int tb = which ? tbB : tbA; const f32x16& acc = which ? accB : accA;
            const float sbv = spb[g * 128 + tb * 32 + r];
#pragma unroll
            for (int q = 0; q < 4; ++q) {
                u32x2 w; w.x = pk2(acc[4 * q + 0] + sbv, acc[4 * q + 1] + sbv); w.y = pk2(acc[4 * q + 2] + sbv, acc[4 * q + 3] + sbv);
                *(LAS u32x2*)(stg + which * 2560 + r * 80 + (8 * q + 4 * hh) * 2) = w;
            }
        }
#pragma unroll
        for (int which = 0; which < 2; ++which) {
            const int tb = which ? tbB : tbA;
#pragma unroll
            for (int i = 0; i < 2; ++i) {
                const int t = (lane >> 2) + 16 * i, ck = lane & 3;
                const size_t a = (size_t)(tok0 + tb * 32 + t) * DH + g * 128 + cb * 32 + ck * 8;
                const u32x4 uu = *(const u32x4*)(U + a), gc = *(const u32x4*)(GC + a);
                const u32x4 mv = *(const LAS u32x4*)(stg + which * 2560 + t * 80 + ck * 16);
                u32x4 o; o.x = pk2(bflo(uu.x) * bflo(mv.x) * bflo(gc.x), bfhi(uu.x) * bfhi(mv.x) * bfhi(gc.x)); o.y = pk2(bflo(uu.y) * bflo(mv.y) * bflo(gc.y), bfhi(uu.y) * bfhi(mv.y) * bfhi(gc.y));
                o.z = pk2(bflo(uu.z) * bflo(mv.z) * bflo(gc.z), bfhi(uu.z) * bfhi(mv.z) * bfhi(gc.z)); o.w = pk2(bflo(uu.w) * bflo(mv.w) * bflo(gc.w), bfhi(uu.w) * bfhi(mv.w) * bfhi(gc.w));
                *(u32x4*)(OC + a) = o;
            }
        }
    }
}

__device__ __forceinline__ void sgu_unit(const bf16_t* __restrict__ VCT, const bf16_t* __restrict__ U, const bf16_t* __restrict__ GC, bf16_t* __restrict__ OC,
                                         const bf16_t* __restrict__ Wbf, const float* __restrict__ spb, const float* __restrict__ lng, const float* __restrict__ lnb,
                                         int b, int n, int gh, LAS unsigned char* lds, int tid) {
    const int lane = tid & 63, w = __builtin_amdgcn_readfirstlane(tid >> 6), r = lane & 31, hh = lane >> 5;
    const int tok0 = b * SEQ + n * 128;
    __syncthreads();
    LAS float* part = (LAS float*)lds;
    LAS float* stat = part + 8 * 128 * 2;
    {
        const int tl = lane & 15, cq = lane >> 4;
        const bf16_t* p = VCT + (size_t)(w * 128 + cq) * PT + tok0 + 8 * tl;
        float sm[8], sq[8];
#pragma unroll
        for (int e = 0; e < 8; ++e) { sm[e] = 0.f; sq[e] = 0.f; }
#pragma unroll 8
        for (int c4 = 0; c4 < 32; ++c4) { float v[8]; unpack8(*(const u32x4*)(p + (size_t)(c4 * 4) * PT), v);
#pragma unroll
            for (int e = 0; e < 8; ++e) { sm[e] += v[e]; sq[e] += v[e] * v[e]; } }
#pragma unroll
        for (int e = 0; e < 8; ++e) { sm[e] += __shfl_xor(sm[e], 16); sm[e] += __shfl_xor(sm[e], 32); sq[e] += __shfl_xor(sq[e], 16); sq[e] += __shfl_xor(sq[e], 32); }
        if (cq == 0) {
#pragma unroll
            for (int e = 0; e < 8; ++e) { part[(w * 128 + 8 * tl + e) * 2 + 0] = sm[e]; part[(w * 128 + 8 * tl + e) * 2 + 1] = sq[e]; }
        }
    }
    __syncthreads();
    if (tid < 128) {
        float S = 0.f, SS = 0.f;
#pragma unroll
        for (int ww = 0; ww < 8; ++ww) { S += part[(ww * 128 + tid) * 2]; SS += part[(ww * 128 + tid) * 2 + 1]; }
        const float mean = S * (1.0f / DH); const float var = fmaxf(SS * (1.0f / DH) - mean * mean, 0.f);
        stat[tid * 2] = mean; stat[tid * 2 + 1] = 1.0f / sqrtf(var + EPSN);
    }
    __syncthreads();
    LAS unsigned char* stg = lds + 16384 + w * 5120;
    if ((w >> 2) == 0) sgu_groups<0, 3>(VCT, U, GC, OC, Wbf, spb, lng, lnb, tok0, gh, w & 3, r, hh, stat, stg, lane);
    else sgu_groups<1, 2>(VCT, U, GC, OC, Wbf, spb, lng, lnb, tok0, gh, w & 3, r, hh, stat, stg, lane);
    __syncthreads();
}

struct Args { const float* in[14]; float* out; unsigned char* ws; int ph_lo, ph_hi; };
constexpr int NPH = 11;

__device__ __forceinline__ void phase_prologue(const Args& args, LAS unsigned char* lds) {
    const int tid = threadIdx.x, lane = tid & 63, wave = __builtin_amdgcn_readfirstlane(tid >> 6);
    const int G = gridDim.x, blk = blockIdx.x, gw = blk * 8 + wave, NGW = G * 8;
    unsigned char* ws = args.ws;
    LAS float* scr = (LAS float*)(lds + wave * 16384);
    for (int cu = blk; cu < 2 * (NI8 / 32); cu += G) { const int l = cu / (NI8 / 32), cb = cu - l * (NI8 / 32);
        quant_cols_unit(args.in[2] + (size_t)l * DM * NIN, ws + WS_W8 + (size_t)l * 18 * MiB, (float*)(ws + WS_COLMAX) + l * NI8, cb, lds, tid); }
    constexpr int I_IN = (DM / 64) * (NBF / 32), I_BR = (DH / 64) * (DM / 32), I_OUT = (DM / 64) * (DM / 32);
    constexpr int PER_L = I_IN + 3 * I_BR + I_OUT;
    for (int it = gw; it < 2 * PER_L; it += NGW) {
        const int l = it / PER_L; int r = it - l * PER_L;
        if (r < I_IN) { transpose_item(args.in[2] + (size_t)l * DM * NIN, DM, NIN, (bf16_t*)(ws + WS_WIN + (size_t)l * 68 * MiB), scr, r / (NBF / 32), r % (NBF / 32), lane); continue; } r -= I_IN;
        if (r < 3 * I_BR) { const int br = r / I_BR; r -= br * I_BR; const float* src = (br == 0 ? args.in[9] : (br == 1 ? args.in[10] : args.in[11])) + (size_t)l * DH * DM;
            transpose_item(src, DH, DM, (bf16_t*)(ws + WS_WBR + (size_t)(l * 3 + br) * 4 * MiB), scr, r / (DM / 32), r % (DM / 32), lane); continue; } r -= 3 * I_BR;
        transpose_item(args.in[12] + (size_t)l * DM * DM, DM, DM, (bf16_t*)(ws + WS_WOUT + (size_t)l * 8 * MiB), scr, r / (DM / 32), r % (DM / 32), lane);
    }
    { bf16_t* wb = (bf16_t*)(ws + WS_SGUW); const float* sp_w = args.in[7];
      for (int e = blk * 512 + tid; e < 2 * 8 * 128 * 128; e += G * 512) { const int t = (e >> 7) & 127, s = e & 127; const unsigned p = pk2(sp_w[e], 0.f); wb[e] = (s <= t) ? (bf16_t)(p & 0xffffu) : (bf16_t)0; } }
    row_pass<false, true>(args.in[0], nullptr, nullptr, nullptr, args.in[1], (bf16_t*)(ws + WS_H), ws + WS_H8, (float*)(ws + WS_HS), gw, NGW, lane);
}

template <int L> __device__ __forceinline__ void phase_in(const Args& args, LAS unsigned char* lds) {
    unsigned char* ws = args.ws;
    {
        pg8::Gemm g{(const bf16_t*)(ws + WS_H), (const bf16_t*)(ws + WS_WIN + (size_t)L * 68 * MiB), MT, NBF, DM, 0, 0};
        pg8::TileOrder<1> S; S.init(MT, NBF, gridDim.x, blockIdx.x);
        pg8::EpiIn E{ws + WS_SEG, (bf16_t*)(ws + WS_GATES), (bf16_t*)(ws + WS_VT), (bf16_t*)(ws + WS_VCT)};
        pg8::gemm_phase<pg8::EpiIn, pg8::TileOrder<1>, true>(lds, g, S, E);
    }
    {
        pg8::Gemm g{(const bf16_t*)(ws + WS_H8), (const bf16_t*)(ws + WS_W8 + (size_t)L * 18 * MiB), MT, NI8, DM / 2, 0, 0};
        pg8::TileOrder<1> S; S.init(MT, NI8, gridDim.x, blockIdx.x);
        pg8::EpiIn8 E{ws + WS_SEG, (bf16_t*)(ws + WS_GATES), (bf16_t*)(ws + WS_VCT), (const float*)(ws + WS_HS), (const float*)(ws + WS_COLMAX) + L * NI8};
        pg8::gemm_phase<pg8::EpiIn8, pg8::TileOrder<1>, true, true>(lds, g, S, E);
    }
}

template <int L> __device__ __forceinline__ void phase_mix(const Args& args, LAS unsigned char* lds) {
    const int tid = threadIdx.x, lane = tid & 63, wave = __builtin_amdgcn_readfirstlane(tid >> 6);
    const int G = gridDim.x, blk = blockIdx.x;
    unsigned char* ws = args.ws;
    const bf16_t* segb = (const bf16_t*)(ws + WS_SEG);
    bf16_t* OA = (bf16_t*)(ws + WS_O);
    constexpr size_t SE = (size_t)MT * DH;
    LAS float* btab = (LAS float*)(lds + 8 * ATT_WAVE_LDS + wave * 1536);
    LAS unsigned char* wl = lds + (wave >> 1) * (2 * ATT_WAVE_LDS);
    int cur_h = -1;
    for (int u = blk; u < 1024 + 512 + 256; u += G) {
        if (u < 1024) {
            const int hg = u & 3, b = (u >> 2) & 7, c = u >> 5;
            const int h = hg * 4 + (wave >> 1), half = wave & 1;
            if (h != cur_h) { const float* rb = args.in[3] + (size_t)(L * 16 + h) * NREL;
#pragma unroll
                for (int i = 0; i < 6; ++i) { const int idx = i * 64 + lane; btab[idx] = rb[idx < NREL ? idx : NREL - 1] * LOG2E; }
                cur_h = h; }
            attn_item(segb, segb + SE, (const bf16_t*)(ws + WS_VT), segb + 3 * SE, OA, btab, wl, b, c, h, half, lane);
        } else if (u < 1536) {
            conv_unit(segb + 4 * SE, segb + 5 * SE, segb + 6 * SE, segb + 7 * SE, OA + SE, args.in[4] + (size_t)L * 3 * DH, u - 1024, tid);
        } else {
            const int su = u - 1536; const int gh = su & 1, n = (su >> 1) & 15, b = su >> 5;
            sgu_unit((const bf16_t*)(ws + WS_VCT), segb + 8 * SE, segb + 10 * SE, OA + 2 * SE, (const bf16_t*)(ws + WS_SGUW) + (size_t)L * 8 * 16384, args.in[8] + (size_t)L * 8 * 128,
                     args.in[5] + (size_t)L * DH, args.in[6] + (size_t)L * DH, b, n, gh, lds, tid);
        }
    }
}

template <int L> __device__ __forceinline__ void phase_br(const Args& args, LAS unsigned char* lds) {
    unsigned char* ws = args.ws;
    pg8::Gemm g{(const bf16_t*)(ws + WS_O), (const bf16_t*)(ws + WS_WBR + (size_t)L * 12 * MiB), MT, DM, DH, (size_t)32 * MiB, (size_t)4 * MiB};
    pg8::TileOrder<3> S; S.init(MT, DM, gridDim.x, blockIdx.x);
    pg8::EpiMerge E{(const bf16_t*)(ws + WS_GATES), (bf16_t*)(ws + WS_MERGED16)};
    pg8::gemm_phase<pg8::EpiMerge, pg8::TileOrder<3>, true>(lds, g, S, E);
}

template <int L> __device__ __forceinline__ void phase_out(const Args& args, LAS unsigned char* lds) {
    unsigned char* ws = args.ws;
    pg8::Gemm g{(const bf16_t*)(ws + WS_MERGED16), (const bf16_t*)(ws + WS_WOUT + (size_t)L * 8 * MiB), MT, DM, DM, 0, 0};
    pg8::TileOrder<1> S; S.init(MT, DM, gridDim.x, blockIdx.x);
    pg8::EpiPlain E{(bf16_t*)(ws + WS_Y), DM};
    pg8::gemm_phase<pg8::EpiPlain, pg8::TileOrder<1>, true>(lds, g, S, E);
}

template <int L> __device__ __forceinline__ void phase_row(const Args& args) {
    const int tid = threadIdx.x, lane = tid & 63, wave = __builtin_amdgcn_readfirstlane(tid >> 6);
    const int gw = blockIdx.x * 8 + wave, NGW = gridDim.x * 8;
    unsigned char* ws = args.ws;
    if (L == 0) row_pass<true, true>(args.in[0], (const bf16_t*)(ws + WS_Y), args.in[13], args.out, args.in[1] + DM, (bf16_t*)(ws + WS_H), ws + WS_H8, (float*)(ws + WS_HS), gw, NGW, lane);
    else row_pass<true, false>(args.out, (const bf16_t*)(ws + WS_Y), args.in[13] + DM, args.out, nullptr, nullptr, nullptr, nullptr, gw, NGW, lane);
}

__global__ void __launch_bounds__(512, 2) mk_fwd(const Args args) {
    extern __shared__ __attribute__((aligned(16))) unsigned char lds_raw[];
    LAS unsigned char* lds = (LAS unsigned char*)lds_raw;
    const int lo = args.ph_lo, hi = args.ph_hi;
    volatile LAS unsigned* bst = (volatile LAS unsigned*)(lds + LDS_BYTES - 64);
    if (threadIdx.x < 2) bst[threadIdx.x] = 0u;
    __syncthreads();
    XcdBarrier xbar; xbar.bar = (unsigned*)args.ws; xbar.x = 0; xbar.st = nullptr;
    if (hi - lo > 1) xbar = xcd_barrier_post((unsigned*)args.ws, bst);
#define IN(k) (lo <= (k) && (k) < hi)
#define SEAM(k) do { if (IN((k) + 1)) xcd_barrier(xbar); } while (0)
    if (hi > NPH) cg::this_grid().sync();
    if (IN(0)) { phase_prologue(args, lds); SEAM(0); }
    if (IN(1)) { phase_in<0>(args, lds); SEAM(1); }
    if (IN(2)) { phase_mix<0>(args, lds); SEAM(2); }
    if (IN(3)) { phase_br<0>(args, lds); SEAM(3); }
    if (IN(4)) { phase_out<0>(args, lds); SEAM(4); }
    if (IN(5)) { phase_row<0>(args); SEAM(5); }
    if (IN(6)) { phase_in<1>(args, lds); SEAM(6); }
    if (IN(7)) { phase_mix<1>(args, lds); SEAM(7); }
    if (IN(8)) { phase_br<1>(args, lds); SEAM(8); }
    if (IN(9)) { phase_out<1>(args, lds); SEAM(9); }
    if (IN(10)) { phase_row<1>(args); }
#undef IN
#undef SEAM
}

extern "C" void kernel_launch(void* const* d_in, const int* in_sizes, int n_in, void* d_out, int out_size, void* d_ws, size_t ws_size, hipStream_t stream) {
    static int grid = 0;
    if (grid == 0) {
        if (n_in != 14 || out_size != MT * DM || ws_size < WS_END) { fprintf(stderr, "kernel_launch: unexpected shapes (n_in %d out %d ws %zu)\n", n_in, out_size, ws_size); grid = -1; return; }
        int dev = 0, cus = 0, per_cu = 0;
        hipGetDevice(&dev);
        hipDeviceGetAttribute(&cus, hipDeviceAttributeMultiprocessorCount, dev);
        if (hipFuncSetAttribute((const void*)mk_fwd, hipFuncAttributeMaxDynamicSharedMemorySize, LDS_BYTES) != hipSuccess) { fprintf(stderr, "kernel_launch: hipFuncSetAttribute failed\n"); grid = -1; return; }
        if (hipOccupancyMaxActiveBlocksPerMultiprocessor(&per_cu, (const void*)mk_fwd, 512, LDS_BYTES) != hipSuccess || per_cu < 1) { fprintf(stderr, "kernel_launch: occupancy query says %d\n", per_cu); per_cu = 1; }
        (void)hipGetLastError();
        grid = cus * 1;
    }
    if (grid < 0) return;
    (void)hipMemsetAsync(d_ws, 0, 16384, stream);
    Args a{};
    for (int i = 0; i < 14; ++i) a.in[i] = (const float*)d_in[i];
    a.out = (float*)d_out; a.ws = (unsigned char*)d_ws;
#if MK_N_LAUNCHES == 1
    a.ph_lo = 0; a.ph_hi = NPH;
    void* kargs[] = {&a};
    hipError_t e = hipLaunchCooperativeKernel((const void*)mk_fwd, dim3(grid), dim3(512), kargs, LDS_BYTES, stream);
    if (e != hipSuccess) fprintf(stderr, "cooperative launch failed: %s (grid %d)\n", hipGetErrorString(e), grid);
#else
    for (int p = 0; p < NPH; ++p) { a.ph_lo = p; a.ph_hi = p + 1; hipLaunchKernelGGL(mk_fwd, dim3(grid), dim3(512), LDS_BYTES, stream, a); }
#endif
}
```
